# Optimizing an MI355X kernel written in HIP

```python
import jax, jax.numpy as jnp
from jax import lax
import numpy as np

D_MODEL = 2048
BATCH = 16
SEQ = 256
DEPTH = 4
DEC_BATCH = 4
DEC_SEQ = 1024
PAST_LEN = 256

GRID_W = 64
ROPE_BASE = 10000.0
EPS = 1e-6
NEG_INF = -1e30
Q_BLOCK = 128
H_A = 8
DK_A = 128
DV_A = 128
CHUNK = 32
H_B = 8
Q_LORA = 512
KV_LORA = 256
NOPE_B = 128
ROPE_B = 64
V_B = 128
H_C = 8
KVH_C = 2
HD_C = 128
WINDOW = 128
N_BRANCH = 3
D_FF = 5504
CONV_W = 3

IN_SIZES = (H_A * DK_A, H_A * DK_A, H_A * DK_A, H_A * DV_A, H_A * DV_A,
            Q_LORA, KV_LORA, ROPE_B,
            H_C * HD_C, KVH_C * HD_C, KVH_C * HD_C,
            N_BRANCH * D_MODEL)
IN_TOTAL = sum(IN_SIZES)
IN_SPLITS = tuple(sum(IN_SIZES[:i + 1]) for i in range(len(IN_SIZES) - 1))

kernel_name = "hybrid_diffusion_hgrn2_mla_swa_step"


def rms_norm(x, w):
    xf = x.astype(jnp.float32)
    y = xf * lax.rsqrt(jnp.mean(xf * xf, axis=-1, keepdims=True) + EPS)
    return y.astype(x.dtype) * w


def modulation(cvec, w_mod, b_mod):
    return (jax.nn.silu(cvec) @ w_mod + b_mod)[:, None, :]


def axial_rope(x):
    n, d = x.shape[1], x.shape[-1]
    rows = n // GRID_W
    row = jnp.repeat(jnp.arange(rows), GRID_W).astype(jnp.float32)
    col = jnp.tile(jnp.arange(GRID_W), rows).astype(jnp.float32)
    half = d // 2
    inv = ROPE_BASE ** (-jnp.arange(0, half, 2, dtype=jnp.float32) / half)

    def rot(xa, pos):
        ang = pos[:, None] * inv[None, :]
        cos = jnp.cos(ang)[:, None, :].astype(x.dtype)
        sin = jnp.sin(ang)[:, None, :].astype(x.dtype)
        x1, x2 = xa[..., :half // 2], xa[..., half // 2:]
        return jnp.concatenate([x1 * cos - x2 * sin, x1 * sin + x2 * cos], axis=-1)

    return jnp.concatenate([rot(x[..., :half], row), rot(x[..., half:], col)], axis=-1)


def softmax_with_sink(s, sink):
    if sink is None:
        return jax.nn.softmax(s, axis=-1)
    sk = sink.astype(jnp.float32)[:, :, None, None]
    m = jnp.maximum(s.max(axis=-1, keepdims=True), sk)
    p = jnp.exp(s - m)
    return p / (p.sum(axis=-1, keepdims=True) + jnp.exp(sk - m))


def dense_attention(q, k, v, sink):
    b, n, g, r, dk = q.shape
    scale = dk ** -0.5
    qb = jnp.moveaxis(q.reshape(b, n // Q_BLOCK, Q_BLOCK, g, r, dk), 1, 0)

    def one_block(qi):
        s = jnp.einsum('bqgrd,bkgd->bgrqk', qi, k).astype(jnp.float32) * scale
        p = softmax_with_sink(s, sink)
        return jnp.einsum('bgrqk,bkgd->bqgrd', p, v)

    out = lax.map(one_block, qb)
    return jnp.moveaxis(out, 0, 1).reshape(b, n, g, r, v.shape[-1])


def window_attention(q, k, v, k_ctx, v_ctx, sink):
    b, n, g, r, d = q.shape
    w = WINDOW
    nb = n // w
    scale = d ** -0.5
    pad = ((0, 0), (w, w), (0, 0), (0, 0))
    kp, vp = jnp.pad(k, pad), jnp.pad(v, pad)

    def band(a):
        return jnp.concatenate([a[:, o * w:o * w + n].reshape(b, nb, w, g, d) for o in range(3)], axis=2)

    kb, vb = band(kp), band(vp)
    qb = q.reshape(b, nb, w, g, r, d)
    s_loc = jnp.einsum('bnqgrd,bnkgd->bngrqk', qb, kb).astype(jnp.float32) * scale
    qpos = jnp.arange(nb)[:, None, None] * w + jnp.arange(w)[None, :, None]
    kpos = jnp.arange(nb)[:, None, None] * w - w + jnp.arange(3 * w)[None, None, :]
    valid = (jnp.abs(qpos - kpos) <= w) & (kpos >= 0) & (kpos < n)
    s_loc = jnp.where(valid[None, :, None, None], s_loc, NEG_INF)
    s_ctx = jnp.einsum('bnqgrd,bkgd->bngrqk', qb, k_ctx).astype(jnp.float32) * scale
    p = softmax_with_sink(jnp.concatenate([s_loc, s_ctx], axis=-1), sink)
    o = (jnp.einsum('bngrqk,bnkgd->bnqgrd', p[..., :3 * w], vb)
         + jnp.einsum('bngrqk,bkgd->bnqgrd', p[..., 3 * w:], v_ctx))
    return o.reshape(b, n, g, r, d)


def hgrn_lower_bounds(lb_param):
    cs = jnp.cumsum(jax.nn.softmax(lb_param.astype(jnp.float32), axis=0), axis=0)
    return cs - cs[0]


def forget_gate(x_f, lb, b, n):
    xf = x_f.astype(jnp.float32)
    f = lb + (1.0 - lb) * jax.nn.sigmoid(xf)
    k = (1.0 - lb) * jax.nn.sigmoid(-xf)
    return jnp.log(f).reshape(b, n, H_A, DK_A), k.reshape(b, n, H_A, DK_A)


def hgrn_scan(q, k, v, logf, s0):
    b, n, h, _ = q.shape
    nc = n // CHUNK

    def to_chunks(a):
        return jnp.moveaxis(a.astype(jnp.float32).reshape(b, nc, CHUNK, h, a.shape[-1]), 1, 0)

    mask = jnp.tril(jnp.ones((CHUNK, CHUNK), dtype=bool))

    def step(s, xs):
        qc, kc, vc, gc = xs
        g_cum = jnp.cumsum(gc, axis=1)
        o_inter = jnp.einsum('bthd,bhdv->bthv', qc * jnp.exp(g_cum), s)
        diff = g_cum[:, :, None] - g_cum[:, None, :]
        decay = jnp.where(mask[None, :, :, None, None], jnp.exp(jnp.minimum(diff, 0.0)), 0.0)
        a = jnp.einsum('bthd,bshd,btshd->bhts', qc, kc, decay)
        o_intra = jnp.einsum('bhts,bshv->bthv', a, vc)
        g_last = g_cum[:, -1]
        s_new = (jnp.exp(g_last)[..., None] * s
                 + jnp.einsum('bshd,bshv->bhdv', kc * jnp.exp(g_last[:, None] - g_cum), vc))
        return s_new, o_inter + o_intra

    s_fin, o = lax.scan(step, s0.astype(jnp.float32), (to_chunks(q), to_chunks(k), to_chunks(v), to_chunks(logf)))
    o = jnp.moveaxis(o, 0, 1).reshape(b, n, h, v.shape[-1])
    return o.astype(q.dtype), s_fin


def mla_kv(ckv, krope, w_ukv):
    b, l, _ = ckv.shape
    kv = (ckv @ w_ukv).reshape(b, l, H_B, NOPE_B + V_B)
    k = jnp.concatenate([kv[..., :NOPE_B], jnp.broadcast_to(krope[:, :, None, :], (b, l, H_B, ROPE_B))], axis=-1)
    return k, kv[..., NOPE_B:]


def token_mixer(h, lw, ctx):
    (w_in, lb, g_norm, g_q, w_uq, g_kv, w_ukv, sink, w_a, w_b, w_c, w_o) = lw
    latent = ctx is not None
    b, n, _ = h.shape
    z = h @ w_in
    (aq, af_fwd, af_bwd, ai, ag, bq, bkv, bkr, cq, ck, cv, gts) = jnp.split(z, IN_SPLITS, axis=-1)

    q_a = aq.reshape(b, n, H_A, DK_A)
    v_a = ai.reshape(b, n, H_A, DV_A)
    logf_f, k_f = forget_gate(af_fwd, lb[0], b, n)
    logf_b, k_b = forget_gate(af_bwd, lb[1], b, n)
    if latent:
        s0_f, s0_b = ctx[0][:, 0], ctx[0][:, 1]
    else:
        s0_f = jnp.zeros((b, H_A, DK_A, DV_A), jnp.float32)
        s0_b = s0_f
    o_f, s_f = hgrn_scan(q_a, k_f, v_a, logf_f, s0_f)
    o_b, s_b = hgrn_scan(q_a[:, ::-1], k_b[:, ::-1], v_a[:, ::-1], logf_b[:, ::-1], s0_b)
    o_a = rms_norm(o_f + o_b[:, ::-1], g_norm).reshape(b, n, H_A * DV_A) * jax.nn.silu(ag)

    q_b = (rms_norm(bq, g_q) @ w_uq).reshape(b, n, H_B, NOPE_B + ROPE_B)
    q_nope, q_rope = q_b[..., :NOPE_B], q_b[..., NOPE_B:]
    ckv = rms_norm(bkv, g_kv)
    krope = bkr
    if latent:
        q_rope = axial_rope(q_rope)
        k_lat, v_lat = mla_kv(ckv, axial_rope(krope[:, :, None])[:, :, 0], w_ukv)
        k_cx, v_cx = mla_kv(ctx[1], ctx[2], w_ukv)
        k_all = jnp.concatenate([k_lat, k_cx], axis=1)
        v_all = jnp.concatenate([v_lat, v_cx], axis=1)
    else:
        k_all, v_all = mla_kv(ckv, krope, w_ukv)
    q_full = jnp.concatenate([q_nope, q_rope], axis=-1)[:, :, :, None]
    o_b = dense_attention(q_full, k_all, v_all, None).reshape(b, n, H_B * V_B)

    q_c = cq.reshape(b, n, H_C, HD_C)
    k_c = ck.reshape(b, n, KVH_C, HD_C)
    v_c = cv.reshape(b, n, KVH_C, HD_C)
    sink_c = sink.reshape(KVH_C, H_C // KVH_C)
    if latent:
        q_c = axial_rope(q_c).reshape(b, n, KVH_C, H_C // KVH_C, HD_C)
        o_c = window_attention(q_c, axial_rope(k_c), v_c, ctx[3], ctx[4], sink_c)
    else:
        o_c = dense_attention(q_c.reshape(b, n, KVH_C, H_C // KVH_C, HD_C), k_c, v_c, sink_c)
    o_c = o_c.reshape(b, n, H_C * HD_C)

    gates = jax.nn.sigmoid(gts.reshape(b, n, N_BRANCH, D_MODEL))
    merged = gates[:, :, 0] * (o_a @ w_a) + gates[:, :, 1] * (o_b @ w_b) + gates[:, :, 2] * (o_c @ w_c)
    out = merged @ w_o
    new_ctx = None if latent else (jnp.stack([s_f, s_b], axis=1), ckv, krope, k_c, v_c)
    return out, new_ctx


def conv_ffn(h, w_up, w_conv, w_down):
    n = h.shape[1]
    u = h @ w_up
    half = CONV_W // 2
    up = jnp.pad(u, ((0, 0), (half, half), (0, 0)))
    u = sum(w_conv[j] * up[:, j:j + n] for j in range(CONV_W))
    a, g = jnp.split(u, 2, axis=-1)
    return (a * jax.nn.gelu(g)) @ w_down


def trunk_layer(x, mod, norms, lw, fw, ctx):
    n_pre_a, n_post_a, n_pre_f, n_post_f = norms
    shift1, scale1, gate1, shift2, scale2, gate2 = jnp.split(mod, 6, axis=-1)
    h = rms_norm(x, n_pre_a) * (1.0 + scale1) + shift1
    y, new_ctx = token_mixer(h, lw, ctx)
    x = x + gate1 * rms_norm(y, n_post_a)
    h = rms_norm(x, n_pre_f) * (1.0 + scale2) + shift2
    x = x + gate2 * rms_norm(conv_ffn(h, *fw), n_post_f)
    return x, new_ctx


def setup_inputs(seed: int = 0) -> dict:
    key = jax.random.key(seed)
    ks = iter(jax.random.split(key, 40))

    def nrm(shape, scale):
        return jax.random.normal(next(ks), shape, jnp.float32) * scale

    def gain(shape):
        return 1.0 + nrm(shape, 0.01)

    d = D_MODEL
    return {
        "x_prompt": nrm((BATCH, SEQ, d), 1.0),
        "x_sample": nrm((DEC_BATCH, DEC_SEQ, d), 1.0),
        "state_hgrn": nrm((DEC_BATCH, DEPTH, 2, H_A, DK_A, DV_A), 0.5),
        "cache_mla_ckv": nrm((DEC_BATCH, DEPTH, PAST_LEN, KV_LORA), 1.0),
        "cache_mla_krope": nrm((DEC_BATCH, DEPTH, PAST_LEN, ROPE_B), 1.0),
        "cache_swa_k": nrm((DEC_BATCH, DEPTH, PAST_LEN, KVH_C, HD_C), 1.0),
        "cache_swa_v": nrm((DEC_BATCH, DEPTH, PAST_LEN, KVH_C, HD_C), 1.0),
        "c": nrm((DEC_BATCH, d), 1.0),
        "c_ctx": nrm((d,), 1.0),
        "w_mod": nrm((DEPTH, d, 6 * d), 0.5 * d ** -0.5),
        "b_mod": nrm((DEPTH, 6 * d), 0.01),
        "norm_pre_attn": gain((DEPTH, d)),
        "norm_post_attn": gain((DEPTH, d)),
        "norm_pre_ffn": gain((DEPTH, d)),
        "norm_post_ffn": gain((DEPTH, d)),
        "w_in": nrm((DEPTH, d, IN_TOTAL), d ** -0.5),
        "hgrn_lb": nrm((DEPTH, 2, H_A * DK_A), 0.5),
        "hgrn_gnorm": gain((DEPTH, DV_A)),
        "mla_gq": gain((DEPTH, Q_LORA)),
        "mla_w_uq": nrm((DEPTH, Q_LORA, H_B * (NOPE_B + ROPE_B)), Q_LORA ** -0.5),
        "mla_gkv": gain((DEPTH, KV_LORA)),
        "mla_w_ukv": nrm((DEPTH, KV_LORA, H_B * (NOPE_B + V_B)), KV_LORA ** -0.5),
        "swa_sink": nrm((DEPTH, H_C), 1.0),
        "w_branch_a": nrm((DEPTH, H_A * DV_A, d), (H_A * DV_A) ** -0.5),
        "w_branch_b": nrm((DEPTH, H_B * V_B, d), (H_B * V_B) ** -0.5),
        "w_branch_c": nrm((DEPTH, H_C * HD_C, d), (H_C * HD_C) ** -0.5),
        "w_out": nrm((DEPTH, d, d), d ** -0.5),
        "ffn_w_up": nrm((DEPTH, d, 2 * D_FF), d ** -0.5),
        "ffn_conv": nrm((DEPTH, CONV_W, 2 * D_FF), CONV_W ** -0.5),
        "ffn_w_down": nrm((DEPTH, D_FF, d), D_FF ** -0.5),
    }


def reference(x_prompt, x_sample, state_hgrn, cache_mla_ckv, cache_mla_krope, cache_swa_k, cache_swa_v,
              c, c_ctx, w_mod, b_mod, norm_pre_attn, norm_post_attn, norm_pre_ffn, norm_post_ffn,
              w_in, hgrn_lb, hgrn_gnorm, mla_gq, mla_w_uq, mla_gkv, mla_w_ukv, swa_sink,
              w_branch_a, w_branch_b, w_branch_c, w_out, ffn_w_up, ffn_conv, ffn_w_down):
    lb_all = hgrn_lower_bounds(hgrn_lb)
    xp, xs = x_prompt, x_sample
    new_hgrn, new_ckv, new_krope, new_k, new_v = [], [], [], [], []
    for l in range(DEPTH):
        lw = (w_in[l], lb_all[l], hgrn_gnorm[l], mla_gq[l], mla_w_uq[l], mla_gkv[l], mla_w_ukv[l],
              swa_sink[l], w_branch_a[l], w_branch_b[l], w_branch_c[l], w_out[l])
        fw = (ffn_w_up[l], ffn_conv[l], ffn_w_down[l])
        norms = (norm_pre_attn[l], norm_post_attn[l], norm_pre_ffn[l], norm_post_ffn[l])
        mod_ctx = modulation(c_ctx[None, :], w_mod[l], b_mod[l])
        xp, ctx_l = trunk_layer(xp, mod_ctx, norms, lw, fw, None)
        new_hgrn.append(ctx_l[0])
        new_ckv.append(ctx_l[1])
        new_krope.append(ctx_l[2])
        new_k.append(ctx_l[3])
        new_v.append(ctx_l[4])
        mod_lat = modulation(c, w_mod[l], b_mod[l])
        cache_l = (state_hgrn[:, l], cache_mla_ckv[:, l], cache_mla_krope[:, l], cache_swa_k[:, l], cache_swa_v[:, l])
        xs, _ = trunk_layer(xs, mod_lat, norms, lw, fw, cache_l)
    return (xp, xs, jnp.stack(new_hgrn, axis=1), jnp.stack(new_ckv, axis=1), jnp.stack(new_krope, axis=1),
            jnp.stack(new_k, axis=1), jnp.stack(new_v, axis=1))
```

```cpp
#include <hip/hip_runtime.h>
#include <cstdio>
#include <cstdint>

#ifndef MK_ONE_LAUNCH
#define MK_ONE_LAUNCH 1
#endif

#define GAS __attribute__((address_space(1)))
#define LAS __attribute__((address_space(3)))
typedef unsigned short bf16;
typedef short bf16x8 __attribute__((ext_vector_type(8)));
typedef float f32x4 __attribute__((ext_vector_type(4)));
typedef float f32x2 __attribute__((ext_vector_type(2)));
typedef unsigned u32x4 __attribute__((ext_vector_type(4)));
typedef unsigned u32x2 __attribute__((ext_vector_type(2)));
typedef GAS unsigned gu32;

constexpr int D = 2048, NL = 4, MC = 4096, MT = 8192, MKV = 9216;
constexpr int NIN = 13632, NINP = 13824, DFF = 5504, NUP = 11008;
constexpr float EPS = 1e-6f;
constexpr float SCALE_B = 0.07216878364870322f;
constexpr float SCALE_C = 0.08838834764831845f;

constexpr size_t OUT_Y = 0, OUT_ST = 16777216, OUT_CKV = OUT_ST + 16777216, OUT_KR = OUT_CKV + 4194304, OUT_K = OUT_KR + 1048576, OUT_V = OUT_K + 4194304, OUT_END = OUT_V + 4194304;

constexpr size_t MiB = 1u << 20;
constexpr size_t WS_CTL = 0, CTL_ZERO_BYTES = 1 * MiB;
constexpr size_t WS_MODP = 2 * MiB;
constexpr size_t WS_MOD = 18 * MiB;
constexpr size_t WS_LB = 19 * MiB;
constexpr size_t WS_ROPE = 19 * MiB + 512 * 1024;
constexpr size_t WS_SSQQ = 20 * MiB;
constexpr size_t WS_SSQKV = 20 * MiB + 512 * 1024;
constexpr size_t WS_SSQX = 21 * MiB;
constexpr size_t WS_XCH = 21 * MiB + 512 * 1024;
constexpr size_t WS_CV1 = 22 * MiB;
constexpr size_t WS_CV2 = 24 * MiB;
constexpr size_t WS_W = 32 * MiB, WL_STRIDE = 141 * MiB;
constexpr size_t WO_IN = 0, WO_UQ = 54 * MiB, WO_UKV = WO_UQ + 3 * MiB / 2, WO_A = WO_UKV + 1 * MiB, WO_B = WO_A + 4 * MiB, WO_C = WO_B + 4 * MiB, WO_O = WO_C + 4 * MiB, WO_UP = WO_O + 8 * MiB, WO_DN = WO_UP + 43 * MiB;
static_assert(WO_DN + (size_t)2048 * DFF * 2 <= WL_STRIDE, "weights per layer");
constexpr size_t WS_BKV = 596 * MiB;
constexpr size_t WS_KR = 614 * MiB;
constexpr size_t WS_KC = 619 * MiB;
constexpr size_t WS_VC = 637 * MiB;
constexpr size_t WS_H = 656 * MiB;
constexpr size_t WS_QA = 688 * MiB;
constexpr size_t WS_LG = 704 * MiB;
constexpr size_t WS_KK = 768 * MiB;
constexpr size_t WS_VA = 800 * MiB;
constexpr size_t WS_AG = 816 * MiB;
constexpr size_t WS_BQ = 832 * MiB;
constexpr size_t WS_QC = 840 * MiB;
constexpr size_t WS_GT = 856 * MiB;
constexpr size_t WS_QF = 952 * MiB;
constexpr size_t WS_KV = 976 * MiB;
constexpr size_t WS_OF = 1012 * MiB;
constexpr size_t WS_OB = 1044 * MiB;
constexpr size_t WS_OA = 1076 * MiB;
constexpr size_t WS_OBB = 1092 * MiB;
constexpr size_t WS_OC = 1108 * MiB;
constexpr size_t WS_MS = 1124 * MiB;
constexpr size_t WS_MG = 1188 * MiB;
constexpr size_t WS_Y = 1220 * MiB;
constexpr size_t WS_HALO = 1220 * MiB;
constexpr size_t WS_U = 688 * MiB;
constexpr size_t WS_ACT = 860 * MiB;
constexpr size_t WS_XB = 1284 * MiB;
constexpr size_t WS_END = 1316 * MiB;
static_assert(WS_U + (size_t)MT * NUP * 2 <= WS_ACT && WS_ACT + (size_t)MT * DFF * 2 <= WS_QF, "ffn overlay");

constexpr int CW_TMO = 0, CW_BAR = 4096, CW_CNT = 16384, CW_SPL = 65536;
constexpr size_t WS_SPL = 704 * MiB;

constexpr int RING_BYTES = 131072, LDSCTL_OFF = RING_BYTES, MISC_OFF = LDSCTL_OFF + 320, HALO_OFF = RING_BYTES + 1024, LDS_BYTES = 147456;

#define RLX_AGENT __ATOMIC_RELAXED, __HIP_MEMORY_SCOPE_AGENT
#define LDS_WAIT() asm volatile("s_waitcnt lgkmcnt(0)" ::: "memory")
#define VM_WAIT() asm volatile("s_waitcnt vmcnt(0)" ::: "memory")
__host__ __device__ __forceinline__ unsigned f2bf(float f) { unsigned u = __builtin_bit_cast(unsigned, f); return (u + 0x7fffu + ((u >> 16) & 1u)) >> 16; }
typedef float f32x2c_t __attribute__((ext_vector_type(2)));
typedef __bf16 bf16x2c_t __attribute__((ext_vector_type(2)));
__device__ __forceinline__ unsigned pk2(float lo, float hi) { const f32x2c_t v = {lo, hi}; const bf16x2c_t b = __builtin_convertvector(v, bf16x2c_t); return __builtin_bit_cast(unsigned, b); }
__device__ __forceinline__ float bf_lo(unsigned u) { return __builtin_bit_cast(float, u << 16); }
__device__ __forceinline__ float bf_hi(unsigned u) { return __builtin_bit_cast(float, u & 0xffff0000u); }
__device__ __forceinline__ float bf2f(bf16 b) { return __builtin_bit_cast(float, (unsigned)b << 16); }
__device__ __forceinline__ float sigmoidf_(float x) { return __builtin_amdgcn_rcpf(1.f + __expf(-x)); }
__device__ __forceinline__ float rsq_(float x) { return __builtin_amdgcn_rsqf(x); }
__device__ __forceinline__ float shx(float v, int mask, int lane) { return __builtin_bit_cast(float, __builtin_amdgcn_ds_bpermute((lane ^ mask) << 2, __builtin_bit_cast(int, v))); }
__device__ __forceinline__ float wave_sum(float v, int lane) {
#pragma unroll
    for (int o = 1; o < 64; o <<= 1) v += shx(v, o, lane);
    return v;
}
__device__ __forceinline__ int tid_now(int wave) { int t; asm volatile("v_mbcnt_lo_u32_b32 %0, -1, 0\n\tv_mbcnt_hi_u32_b32 %0, -1, %0" : "=v"(t)); return wave * 64 + t; }
#define XB_TMO      128
#define XB_XCNT(j)  (256  + 64 * (j))
#define XB_XSUB(j)  (1280 + 64 * (j))
#define XB_XGEN(j)  (2304 + 64 * (j))
#define XB_TOP      3328
#define XB_TOPGEN   3392
#define XCD_BAR_WORDS 3456
#define XB_SPIN_CAP (1u << 22)
__device__ __forceinline__ unsigned xb_ld(unsigned* p)              { return __hip_atomic_load(p, __ATOMIC_RELAXED, __HIP_MEMORY_SCOPE_AGENT); }
__device__ __forceinline__ unsigned xb_add(unsigned* p, unsigned v) { return __hip_atomic_fetch_add(p, v, __ATOMIC_RELAXED, __HIP_MEMORY_SCOPE_AGENT); }
__device__ __forceinline__ unsigned xb_xcc_id() { return (unsigned)__builtin_amdgcn_s_getreg((3 << 11) | 20) & 0xFu; }
#define XB_SPIN(cond, bar) do { unsigned _sp = 0; while (cond) { __builtin_amdgcn_s_sleep(1); \
    if ((++_sp & 255u) == 0u) { if (xb_ld(&(bar)[XB_TMO])) break; if (_sp > XB_SPIN_CAP) { atomicAdd(&(bar)[XB_TMO], 1u); break; } } } } while (0)
struct XcdBarrier { unsigned* bar; unsigned x; volatile LAS unsigned* st; };
__device__ __forceinline__ XcdBarrier xcd_barrier_post(unsigned* bar, volatile LAS unsigned* st) {
    XcdBarrier b; b.bar = bar; b.x = xb_xcc_id(); b.st = st;
    if (threadIdx.x == 0) (void)xb_add(&bar[XB_XCNT(b.x)], 1u);
    return b;
}
__device__ __forceinline__ void xcd_barrier_complete(unsigned* bar, unsigned x, unsigned& nloc, unsigned& nx) {
    const unsigned G = gridDim.x * gridDim.y * gridDim.z;
    unsigned sum, cnt, mine, sp = 0u;
    for (;;) {
        sum = 0u; cnt = 0u; mine = 0u;
#pragma unroll
        for (unsigned j = 0; j < 16; ++j) { const unsigned c = xb_ld(&bar[XB_XCNT(j)]); sum += c; cnt += (c > 0u) ? 1u : 0u; mine = (j == x) ? c : mine; }
        if (sum == G) break;
        __builtin_amdgcn_s_sleep(1);
        if ((++sp & 255u) == 0u) { if (xb_ld(&bar[XB_TMO])) break; if (sp > XB_SPIN_CAP) { atomicAdd(&bar[XB_TMO], 1u); break; } }
    }
    nloc = mine > 0u ? mine : 1u; nx = cnt > 0u ? cnt : 1u;
}
__device__ __forceinline__ void xcd_barrier(const XcdBarrier& b) {
    asm volatile("s_waitcnt vmcnt(0)" ::: "memory");
    __syncthreads();
    if (threadIdx.x == 0) {
        unsigned* bar = b.bar;
        __builtin_amdgcn_s_waitcnt(0);
        unsigned nloc = b.st[0], nx = b.st[1];
        if (nloc == 0u) { xcd_barrier_complete(bar, b.x, nloc, nx); b.st[0] = nloc; b.st[1] = nx; }
        const unsigned old = xb_add(&bar[XB_XSUB(b.x)], 1u);
        const unsigned gen = old / nloc;
        if (old + 1u == (gen + 1u) * nloc) {
            __builtin_amdgcn_fence(__ATOMIC_RELEASE, "agent");
            asm volatile("s_waitcnt vmcnt(0)" ::: "memory");
            const unsigned og = xb_add(&bar[XB_TOP], 1u);
            const unsigned tg = og / nx;
            if (og + 1u == (tg + 1u) * nx) xb_add(&bar[XB_TOPGEN], 1u);
            else XB_SPIN(xb_ld(&bar[XB_TOPGEN]) == tg, bar);
            __builtin_amdgcn_fence(__ATOMIC_ACQUIRE, "agent");
            xb_add(&bar[XB_XGEN(b.x)], 1u);
            asm volatile("s_waitcnt vmcnt(0)" ::: "memory");
        } else {
            XB_SPIN(xb_ld(&bar[XB_XGEN(b.x)]) == gen, bar);
            __builtin_amdgcn_fence(__ATOMIC_ACQUIRE, "agent");
            asm volatile("s_waitcnt vmcnt(0)" ::: "memory");
        }
    }
    __syncthreads();
}

namespace pg8 {
constexpr int BM = 256, BK = 64, HALF = 128, HTB = HALF * BK * 2, NXCD = 8, WGM = 8;
__host__ __device__ __forceinline__ int lds_byte(int r, int c) { const int st = (r >> 4) * 2 + (c >> 5), rr = r & 15, cc = c & 31, ob = rr * 64 + cc * 2; return st * 1024 + (ob ^ (((ob >> 9) & 1) << 5)); }
__host__ __device__ __forceinline__ void stage_rc(int b, int& R, int& C) { const int st = b / 1024, sb = b % 1024, swz = sb ^ (((sb >> 9) & 1) << 5); R = (st >> 1) * 16 + swz / 64; C = (st & 1) * 32 + (swz % 64) / 2; }
__host__ __device__ __forceinline__ int perm32(int rho) { const int n = rho >> 4, i = rho & 15; return 8 * (i >> 2) + 4 * n + (i & 3); }
struct Unit { int pm, pn, sub; };
struct Gemm { const bf16* A; const bf16* Bt; int M, N, K, lda; const bf16* A1; const bf16* Bt1; const bf16* A2; const bf16* Bt2; };
struct StaticOrder {
    static constexpr bool SPLIT = false;
    int nM, nN, nwg, G, c;
    __device__ __forceinline__ void init(int M, int N, int G_, int c_) { nM = M / BM; nN = N / BM; nwg = nM * nN; G = G_; c = c_; }
    __device__ __forceinline__ bool next(int i, Unit& u) const {
        const long L = (long)i * G + c; if (L >= nwg) return false;
        int wgid = (int)L; { const int q = nwg / NXCD, r = nwg % NXCD, xcd = wgid % NXCD, off = wgid / NXCD; wgid = (xcd < r ? xcd * (q + 1) : r * (q + 1) + (xcd - r) * q) + off; }
        const int nig = WGM * nN, gid = wgid / nig, fm = gid * WGM, gsz = (nM - fm) < WGM ? (nM - fm) : WGM;
        u.pm = fm + ((wgid % nig) % gsz); u.pn = (wgid % nig) / gsz; u.sub = 0; return true;
    }
};
struct SplitOrder {
    static constexpr bool SPLIT = true;
    int nM, nN, nwg, G, c, nfull, tail;
    __device__ __forceinline__ void init(int M, int N, int G_, int c_) { nM = M / BM; nN = N / BM; nwg = nM * nN; G = G_; c = c_; nfull = (nwg / G) * G; tail = nwg - nfull; if (2 * tail > G) { nfull = nwg; tail = 0; } }
    __device__ __forceinline__ bool next(int i, Unit& u) const {
        long L = (long)i * G + c; int sub = 0;
        if (L >= nfull) { if (tail == 0 || i != nfull / G || c >= 2 * tail) return false; const int j = (c >= tail) ? c - tail : c; sub = (c >= tail) ? 2 * j + 1 : 2 * j + 2; L = nfull + j; }
        int wgid = (int)L; { const int q = nwg / NXCD, r = nwg % NXCD, xcd = wgid % NXCD, off = wgid / NXCD; wgid = (xcd < r ? xcd * (q + 1) : r * (q + 1) + (xcd - r) * q) + off; }
        const int nig = WGM * nN, gid = wgid / nig, fm = gid * WGM, gsz = (nM - fm) < WGM ? (nM - fm) : WGM;
        u.pm = fm + ((wgid % nig) % gsz); u.pn = (wgid % nig) / gsz; u.sub = sub; return true;
    }
};
template <class Epi, class Ord>
__device__ __forceinline__ void gemm_phase(LAS unsigned char* lds, const Gemm g, const Ord& S, const Epi& E, int wave) {
    constexpr bool SPL = Ord::SPLIT;
    const int tid = tid_now(wave), wid = __builtin_amdgcn_readfirstlane(tid >> 6), lane = tid & 63, wr = wid >> 2, wc = wid & 3, fr = lane & 15, fq = lane >> 4;
    const int K = g.K, nt = K / BK, lda = g.lda;
    unsigned voffA[2], voffB[2];
#pragma unroll
    for (int i = 0; i < 2; ++i) { int R, C; stage_rc(tid * 16 + i * 8192, R, C); const int Rb = (R & ~31) + perm32(R & 31);
        voffA[i] = (unsigned)(R * lda + C) * 2u; voffB[i] = (unsigned)(Rb * K + C) * 2u; }
    const size_t kstep = (size_t)(BK * 2);
    const size_t hstepA = (size_t)HALF * lda * 2, hstepB = (size_t)HALF * K * 2;
    const size_t tstepA = 2 * hstepA, tstepB = 2 * hstepB;
    const unsigned ldsw = (unsigned)wid * 1024u;
    const int aoff = lds_byte(wr * 64 + fr, fq * 8), boff = lds_byte(wc * 32 + fr, fq * 8);
#define PG8_SA(b, h) (((b) * 2 + (h)) * HTB)
#define PG8_SB(b, h) ((4 + (b) * 2 + (h)) * HTB)
#define PG8_STAGE(bufoff, gbase, voff) do { _Pragma("unroll") for (int _i = 0; _i < 2; ++_i) \
        __builtin_amdgcn_global_load_lds((const unsigned*)((const char*)(gbase) + (voff)[_i]), (LAS unsigned*)(lds + (bufoff) + ldsw + _i * 8192), 16, 0, 0); } while (0)
#define PG8_LDA(dst, b, h) do { _Pragma("unroll") for (int m = 0; m < 4; ++m) _Pragma("unroll") for (int k = 0; k < 2; ++k) dst[m][k] = *(const LAS bf16x8*)(lds + PG8_SA(b, h) + aoff + m * 2048 + k * 1024); } while (0)
#define PG8_LDB(dst, b, h) do { _Pragma("unroll") for (int n = 0; n < 2; ++n) _Pragma("unroll") for (int k = 0; k < 2; ++k) dst[n][k] = *(const LAS bf16x8*)(lds + PG8_SB(b, h) + boff + n * 2048 + k * 1024); } while (0)
#define PG8_MMA(ai, bj, At, Bt) do { __builtin_amdgcn_s_setprio(1); _Pragma("unroll") for (int m = 0; m < 4; ++m) _Pragma("unroll") for (int n = 0; n < 2; ++n) _Pragma("unroll") for (int k = 0; k < 2; ++k) \
        acc[ai][bj][m][n] = __builtin_amdgcn_mfma_f32_16x16x32_bf16(Bt[n][k], At[m][k], acc[ai][bj][m][n], 0, 0, 0); __builtin_amdgcn_s_setprio(0); } while (0)
#define PG8_WAIT_V(n) asm volatile("s_waitcnt vmcnt(" #n ")" ::: "memory")
#define PG8_WAIT_L(n) asm volatile("s_waitcnt lgkmcnt(" #n ")" ::: "memory")
#define PG8_BAR __builtin_amdgcn_s_barrier()
#define PG8_SCHED __builtin_amdgcn_sched_barrier(0)
    constexpr int CH = Epi::CHAIN;
    Unit cur, nxt; int ui = 0;
    if (!S.next(0, cur)) return;
    f32x4 acc[2][2][4][2];
#pragma unroll
    for (int a = 0; a < 2; ++a)
#pragma unroll
        for (int b = 0; b < 2; ++b)
#pragma unroll
            for (int m = 0; m < 4; ++m)
#pragma unroll
                for (int n = 0; n < 2; ++n) acc[a][b][m][n] = (f32x4){0.f, 0.f, 0.f, 0.f};
    bf16x8 At[4][2], B0[2][2], B1[2][2];
#define PG8_AP(sub) ((const char*)((CH == 1 || (sub) == 0) ? g.A : ((sub) == 1 ? g.A1 : g.A2)))
#define PG8_BP(sub) ((const char*)((CH == 1 || (sub) == 0) ? g.Bt : ((sub) == 1 ? g.Bt1 : g.Bt2)))
#define PG8_KOFF(u) ((SPL && ((u).sub & 1)) ? (size_t)K : (size_t)0)
    const char* cA = PG8_AP(0) + (size_t)cur.pm * tstepA + PG8_KOFF(cur); const char* cB = PG8_BP(0) + (size_t)cur.pn * tstepB + PG8_KOFF(cur);
    PG8_STAGE(PG8_SB(0, 0), cB, voffB); PG8_STAGE(PG8_SB(0, 1), cB + hstepB, voffB); PG8_STAGE(PG8_SA(0, 0), cA, voffA); PG8_STAGE(PG8_SA(0, 1), cA + hstepA, voffA);
    if (wr == 1) PG8_BAR;
    PG8_WAIT_V(2); PG8_BAR;
    PG8_STAGE(PG8_SB(1, 0), cB + kstep, voffB); PG8_STAGE(PG8_SA(1, 0), cA + kstep, voffA); PG8_STAGE(PG8_SB(1, 1), cB + hstepB + kstep, voffB);
    PG8_WAIT_V(6); PG8_BAR;
    for (;;) {
        const bool has_next = S.next((ui + 1) / CH, nxt); if constexpr (!SPL) nxt.sub = (ui + 1) % CH;
        const char* nA = has_next ? PG8_AP(SPL ? 0 : nxt.sub) + (size_t)nxt.pm * tstepA + PG8_KOFF(nxt) : cA; const char* nB = has_next ? PG8_BP(SPL ? 0 : nxt.sub) + (size_t)nxt.pn * tstepB + PG8_KOFF(nxt) : cB;
        const int ntc = (SPL && cur.sub) ? (nt >> 1) : nt;
        for (int t = 0; t < ntc; t += 2) {
            const bool last = (t == ntc - 2);
            const char* a1 = cA + (size_t)(t + 1) * kstep;
            const char* a2 = last ? nA : cA + (size_t)(t + 2) * kstep; const char* b2 = last ? nB : cB + (size_t)(t + 2) * kstep;
            const char* a3 = a2 + kstep; const char* b3 = b2 + kstep;
            PG8_LDB(B0, 0, 0); PG8_LDB(B1, 0, 1); PG8_SCHED; PG8_LDA(At, 0, 0); PG8_STAGE(PG8_SA(1, 1), a1 + hstepA, voffA);
            PG8_WAIT_V(8); PG8_WAIT_L(0); PG8_BAR; PG8_MMA(0, 0, At, B0); PG8_MMA(0, 1, At, B1); PG8_BAR; PG8_SCHED;
            PG8_LDA(At, 0, 1); PG8_STAGE(PG8_SB(0, 0), b2, voffB); PG8_STAGE(PG8_SB(0, 1), b2 + hstepB, voffB); PG8_STAGE(PG8_SA(0, 0), a2, voffA);
            PG8_WAIT_V(8); PG8_WAIT_L(0); PG8_BAR; PG8_MMA(1, 0, At, B0); PG8_MMA(1, 1, At, B1); PG8_BAR; PG8_SCHED;
            PG8_LDB(B0, 1, 0); PG8_LDB(B1, 1, 1); PG8_SCHED; PG8_LDA(At, 1, 0); PG8_STAGE(PG8_SA(0, 1), a2 + hstepA, voffA);
            PG8_WAIT_V(8); PG8_WAIT_L(0); PG8_BAR; PG8_MMA(0, 0, At, B0); PG8_MMA(0, 1, At, B1); PG8_BAR; PG8_SCHED;
            PG8_LDA(At, 1, 1); PG8_STAGE(PG8_SB(1, 0), b3, voffB); PG8_STAGE(PG8_SB(1, 1), b3 + hstepB, voffB); PG8_STAGE(PG8_SA(1, 0), a3, voffA);
            PG8_WAIT_V(8); PG8_WAIT_L(0); PG8_BAR; PG8_MMA(1, 0, At, B0); PG8_MMA(1, 1, At, B1); PG8_BAR; PG8_SCHED;
        }
        if (wr == 0) PG8_BAR;
        if constexpr (SPL) {
            if (cur.sub & 1) E.put_partial(acc, cur, wave);
            else { if (cur.sub) E.get_partial(acc, cur, wave); E(acc, cur, wr, wc, fr, fq); }
        } else if constexpr (!Epi::AFTER_DRAIN) E(acc, cur, wr, wc, fr, fq);
        if (!has_next) break;
        if (CH == 1 || cur.sub == CH - 1) {
#pragma unroll
        for (int a = 0; a < 2; ++a)
#pragma unroll
            for (int b = 0; b < 2; ++b)
#pragma unroll
                for (int m = 0; m < 4; ++m)
#pragma unroll
                    for (int n = 0; n < 2; ++n) acc[a][b][m][n] = (f32x4){0.f, 0.f, 0.f, 0.f};
        }
        cur = nxt; cA = nA; cB = nB; ++ui;
        if (wr == 1) PG8_BAR;
    }
    PG8_WAIT_V(0);
    PG8_BAR;
    if constexpr (Epi::AFTER_DRAIN) E.fused(acc, cur, wr, wc, fr, fq, lds, tid);
#undef PG8_AP
#undef PG8_BP
#undef PG8_KOFF
#undef PG8_SA
#undef PG8_SB
#undef PG8_STAGE
#undef PG8_LDA
#undef PG8_LDB
#undef PG8_MMA
#undef PG8_WAIT_V
#undef PG8_WAIT_L
#undef PG8_BAR
#undef PG8_SCHED
}
}
using pg8::Unit;

struct Args { const float* in[30]; float* out; unsigned char* ws; int ph_lo, ph_hi, use_bar, pad; };
#define CAS __attribute__((address_space(4)))
typedef const CAS Args* ArgP;

__device__ __forceinline__ int src_win(int n) {
    const int t = n >> 8, g = n & 255;
    if (t < 20) return n;
    if (t < 22) return 5120 + (n - 20 * 256);
    if (t == 22) return 5632 + g;
    if (t < 28) { const int half = g >> 7, hd = (g >> 6) & 1, part = (g >> 5) & 1, i = g & 31; const int base = (t < 27) ? 5952 + (t - 23) * 256 : 6976; return base + hd * 128 + part * 64 + half * 32 + i; }
    if (t == 28) return 7232 + g;
    if (t < 53) return 7488 + (n - 29 * 256);
    { const int half = g >> 7, r = g & 127; if (r >= 32) return -1; const int part = r >> 4, i = r & 15; return 5888 + part * 32 + half * 16 + i; }
}
__device__ __forceinline__ int src_uq(int n) {
    const int t = n >> 8, g = n & 255;
    if (t < 4) { const int hd = n >> 7, d = n & 127; return hd * 192 + d; }
    const int half = g >> 7, hl = (g >> 5) & 3, part = (g >> 4) & 1, i = g & 15; const int hd = (t - 4) * 4 + hl;
    return hd * 192 + 128 + part * 32 + half * 16 + i;
}
__device__ __forceinline__ int src_ukv(int n) { const int v = n >> 10, r = n & 1023, hd = r >> 7, d = r & 127; return hd * 256 + v * 128 + d; }
__device__ __forceinline__ int src_up(int n) { const int j = n >> 8, g = n & 255; return (g < 128) ? 128 * j + g : DFF + 128 * j + (g - 128); }

typedef short s16x4p __attribute__((ext_vector_type(4)));
typedef short v4i16p __attribute__((ext_vector_type(4)));
__device__ __forceinline__ unsigned cvtpk_p(float lo, float hi) { return pk2(lo, hi); }
struct TDesc { const float* W; const float* fold; bf16* WT; int K, Nsrc, map, k0, n0; };
constexpr int J_IN = 32 * (NINP / 64), J_UQ = 8 * 24, J_UKV = 4 * 32, J_BR = 16 * 32, J_O = 32 * 32, J_UP = 32 * (NUP / 64), J_DN = (DFF / 64) * 32;
constexpr int J_L = J_IN + J_UQ + J_UKV + 3 * J_BR + J_O + J_UP + J_DN;
__device__ __forceinline__ TDesc t_desc(ArgP a, unsigned char* ws, int it) {
    const int l = it / J_L; int r = it % J_L; unsigned char* wl = ws + WS_W + (size_t)l * WL_STRIDE;
    TDesc d; d.fold = nullptr; int N;
    if (r < J_IN) { d.W = a->in[15] + (size_t)l * D * NIN; d.K = D; d.Nsrc = NIN; N = NINP; d.WT = (bf16*)(wl + WO_IN); d.map = 1; }
    else if ((r -= J_IN) < J_UQ) { d.W = a->in[19] + (size_t)l * 512 * 1536; d.K = 512; d.Nsrc = 1536; N = 1536; d.WT = (bf16*)(wl + WO_UQ); d.map = 2; d.fold = a->in[18] + l * 512; }
    else if ((r -= J_UQ) < J_UKV) { d.W = a->in[21] + (size_t)l * 256 * 2048; d.K = 256; d.Nsrc = 2048; N = 2048; d.WT = (bf16*)(wl + WO_UKV); d.map = 3; d.fold = a->in[20] + l * 256; }
    else if ((r -= J_UKV) < J_BR) { d.W = a->in[23] + (size_t)l * 1024 * 2048; d.K = 1024; d.Nsrc = 2048; N = 2048; d.WT = (bf16*)(wl + WO_A); d.map = 0; }
    else if ((r -= J_BR) < J_BR) { d.W = a->in[24] + (size_t)l * 1024 * 2048; d.K = 1024; d.Nsrc = 2048; N = 2048; d.WT = (bf16*)(wl + WO_B); d.map = 0; }
    else if ((r -= J_BR) < J_BR) { d.W = a->in[25] + (size_t)l * 1024 * 2048; d.K = 1024; d.Nsrc = 2048; N = 2048; d.WT = (bf16*)(wl + WO_C); d.map = 0; }
    else if ((r -= J_BR) < J_O) { d.W = a->in[26] + (size_t)l * 2048 * 2048; d.K = 2048; d.Nsrc = 2048; N = 2048; d.WT = (bf16*)(wl + WO_O); d.map = 0; }
    else if ((r -= J_O) < J_UP) { d.W = a->in[27] + (size_t)l * 2048 * NUP; d.K = 2048; d.Nsrc = NUP; N = NUP; d.WT = (bf16*)(wl + WO_UP); d.map = 4; }
    else { r -= J_UP; d.W = a->in[29] + (size_t)l * DFF * 2048; d.K = DFF; d.Nsrc = 2048; N = 2048; d.WT = (bf16*)(wl + WO_DN); d.map = 0; }
    const int nblk = N / 64; d.k0 = 64 * (r / nblk); d.n0 = 64 * (r % nblk);
    return d;
}
__device__ __forceinline__ void t_load(const TDesc& d, f32x4 (&v)[16], int lane) {
    const int kk = lane >> 4, n = d.n0 + 4 * (lane & 15);
    int sc; if (d.map == 0) sc = n; else if (d.map == 1) sc = src_win(n); else if (d.map == 2) sc = src_uq(n); else if (d.map == 3) sc = src_ukv(n); else sc = src_up(n);
    const float* p = d.W + (size_t)(d.k0 + kk) * d.Nsrc + (sc < 0 ? 0 : sc);
#pragma unroll
    for (int i = 0; i < 16; ++i) { f32x4 x = *(const f32x4*)(p + (size_t)(4 * i) * d.Nsrc); if (sc < 0) x = (f32x4){0.f, 0.f, 0.f, 0.f}; if (d.fold) x = x * d.fold[d.k0 + 4 * i + kk]; v[i] = x; }
}
__device__ __forceinline__ void t_store(const TDesc& d, const f32x4 (&v)[16], LAS unsigned char* scr, int lane) {
    const int kk = lane >> 4, n4 = lane & 15, g = lane >> 4, i16 = lane & 15, q = i16 >> 2, p = i16 & 3;
#pragma unroll
    for (int i = 0; i < 16; ++i) { u32x2 w; w.x = cvtpk_p(v[i].x, v[i].y); w.y = cvtpk_p(v[i].z, v[i].w); *(LAS u32x2*)(scr + (4 * i + kk) * 144 + 8 * n4) = w; }
#pragma unroll
    for (int j = 0; j < 8; ++j) { const int nb = j >> 1, k8 = 4 * (j & 1) + g;
        LAS unsigned char* p0 = scr + (8 * k8 + q) * 144 + (16 * nb + 4 * p) * 2;
        const s16x4p v0 = __builtin_bit_cast(s16x4p, __builtin_amdgcn_ds_read_tr16_b64_v4i16((LAS v4i16p*)p0));
        const s16x4p v1 = __builtin_bit_cast(s16x4p, __builtin_amdgcn_ds_read_tr16_b64_v4i16((LAS v4i16p*)(p0 + 4 * 144)));
        const bf16x8 o = (bf16x8){v0.x, v0.y, v0.z, v0.w, v1.x, v1.y, v1.z, v1.w};
        *(bf16x8*)(d.WT + (size_t)(d.n0 + 16 * nb + i16) * d.K + d.k0 + 8 * k8) = o; }
}

__device__ __forceinline__ void phase_prologue(ArgP a, LAS unsigned char* lds, int wave) {
    const int tidn = tid_now(wave), lane = tidn & 63;
    LAS unsigned char* scr = lds + wave * 9216;
    const int gw = blockIdx.x * 8 + wave, NGW = gridDim.x * 8;
    unsigned char* ws = a->ws;
    for (int it = gw; it < NL * 16 * 48; it += NGW) {
        const int l = it / 768, r = it % 768, kc = r / 48, jb = r % 48;
        const float* W = a->in[9] + (size_t)l * D * 12288 + (size_t)(kc * 128) * 12288 + jb * 256 + lane * 4;
        f32x4 acc[5];
#pragma unroll
        for (int s = 0; s < 5; ++s) acc[s] = (f32x4){0.f, 0.f, 0.f, 0.f};
        for (int k = 0; k < 128; ++k) {
            const f32x4 w = *(const f32x4*)(W + (size_t)k * 12288);
            const int kk = kc * 128 + k;
#pragma unroll
            for (int s = 0; s < 5; ++s) { const float cv = (s == 0) ? a->in[8][kk] : a->in[7][(s - 1) * D + kk]; const float sv = cv * sigmoidf_(cv); acc[s] += w * sv; }
        }
        float* P = (float*)(ws + WS_MODP) + ((size_t)(l * 16 + kc) * 5) * 12288 + jb * 256 + lane * 4;
#pragma unroll
        for (int s = 0; s < 5; ++s) *(f32x4*)(P + (size_t)s * 12288) = acc[s];
    }
    {
        const int NT = NL * J_L; int it = gw; TDesc dA, dB; f32x4 A[16], B[16];
        if (it < NT) { dA = t_desc(a, ws, it); t_load(dA, A, lane); }
        while (it < NT) {
            const int nx = it + NGW; const bool more = nx < NT;
            if (more) { dB = t_desc(a, ws, nx); t_load(dB, B, lane); }
            t_store(dA, A, scr, lane);
            if (more) { dA = dB;
#pragma unroll
                for (int i = 0; i < 16; ++i) A[i] = B[i]; }
            it = nx;
        }
    }
    const int gt = blockIdx.x * 512 + tidn, NGT = gridDim.x * 512;
    for (int i = gt; i < 2048; i += NGT) {
        float v[4], mx = -1e30f;
#pragma unroll
        for (int l = 0; l < 4; ++l) { v[l] = a->in[16][l * 2048 + i]; mx = fmaxf(mx, v[l]); }
        float e[4], s = 0.f;
#pragma unroll
        for (int l = 0; l < 4; ++l) { e[l] = expf(v[l] - mx); s += e[l]; }
        float cs = 0.f; float* LB = (float*)(ws + WS_LB);
        LB[i] = 0.f;
#pragma unroll
        for (int l = 1; l < 4; ++l) { cs += e[l] / s; LB[l * 2048 + i] = cs; }
    }
    for (int i = gt; i < 64 * 32; i += NGT) { const int pos = i >> 5, j = i & 31; const float inv = powf(10000.f, -(float)(2 * j) / 64.f); const float ang = (float)pos * inv;
        float* R = (float*)(ws + WS_ROPE); R[i] = cosf(ang); R[2048 + i] = sinf(ang); }
    for (int i = gt; i < 64 * 16; i += NGT) { const int pos = i >> 4, j = i & 15; const float inv = powf(10000.f, -(float)(2 * j) / 32.f); const float ang = (float)pos * inv;
        float* R = (float*)(ws + WS_ROPE) + 4096; R[i] = cosf(ang); R[1024 + i] = sinf(ang); }
    for (int i = gt; i < 4 * 4 * 256 * 32; i += NGT) {
        const int c = (i & 31) * 8, t = (i >> 5) & 255, l = (i >> 13) & 3, b = i >> 15; const size_t row = 8192 + b * 256 + t, src = (size_t)i * 8, dst = ((size_t)l * MKV + row) * 256 + c;
        const f32x4 g0 = *(const f32x4*)(a->in[20] + l * 256 + c), g1 = *(const f32x4*)(a->in[20] + l * 256 + c + 4);
        const f32x4 k0 = *(const f32x4*)(a->in[3] + src), k1 = *(const f32x4*)(a->in[3] + src + 4);
        { u32x4 w; w.x = pk2(k0.x / g0.x, k0.y / g0.y); w.y = pk2(k0.z / g0.z, k0.w / g0.w); w.z = pk2(k1.x / g1.x, k1.y / g1.y); w.w = pk2(k1.z / g1.z, k1.w / g1.w); *(u32x4*)((bf16*)(ws + WS_BKV) + dst) = w; }
        { const f32x4 v0 = *(const f32x4*)(a->in[5] + src), v1 = *(const f32x4*)(a->in[5] + src + 4); u32x4 w; w.x = pk2(v0.x, v0.y); w.y = pk2(v0.z, v0.w); w.z = pk2(v1.x, v1.y); w.w = pk2(v1.z, v1.w); *(u32x4*)((bf16*)(ws + WS_KC) + dst) = w; }
        { const f32x4 v0 = *(const f32x4*)(a->in[6] + src), v1 = *(const f32x4*)(a->in[6] + src + 4); u32x4 w; w.x = pk2(v0.x, v0.y); w.y = pk2(v0.z, v0.w); w.z = pk2(v1.x, v1.y); w.w = pk2(v1.z, v1.w); *(u32x4*)((bf16*)(ws + WS_VC) + dst) = w; }
    }
    for (int i = gt; i < 1024 * 4; i += NGT) ((float*)(ws + WS_SSQKV))[8192 * 4 + i] = 64.f * (1.f - EPS);
    for (int i = gt; i < 4 * 4 * 256 * 8; i += NGT) {
        const int c = (i & 7) * 8, t = (i >> 3) & 255, l = (i >> 11) & 3, b = i >> 13; const size_t row = 8192 + b * 256 + t;
        const f32x4 v0 = *(const f32x4*)(a->in[4] + (size_t)i * 8), v1 = *(const f32x4*)(a->in[4] + (size_t)i * 8 + 4);
        u32x4 w; w.x = pk2(v0.x, v0.y); w.y = pk2(v0.z, v0.w); w.z = pk2(v1.x, v1.y); w.w = pk2(v1.z, v1.w); *(u32x4*)((bf16*)(ws + WS_KR) + ((size_t)l * MKV + row) * 64 + c) = w;
    }
}
__device__ __forceinline__ void phase_modreduce(ArgP a, int wave) {
    const int gt = blockIdx.x * 512 + tid_now(wave), NGT = gridDim.x * 512;
    for (int i4 = gt; i4 < NL * 5 * 12288 / 4; i4 += NGT) {
        const int i = i4 * 4, j = i % 12288, s = (i / 12288) % 5, l = i / (5 * 12288);
        f32x4 v = *(const f32x4*)(a->in[10] + l * 12288 + j);
        const float* P = (const float*)(a->ws + WS_MODP) + ((size_t)(l * 16) * 5 + s) * 12288 + j;
#pragma unroll
        for (int kc = 0; kc < 16; ++kc) v += *(const f32x4*)(P + (size_t)kc * 5 * 12288);
        *(f32x4*)((float*)(a->ws + WS_MOD) + i) = v;
    }
}

__device__ __forceinline__ int mod_sel(int m) { return (m < MC) ? 0 : 1 + ((m - MC) >> 10); }
__device__ __forceinline__ const float* x_input_row(ArgP a, int m) { return (m < MC) ? a->in[0] + (size_t)m * D : a->in[1] + (size_t)(m - MC) * D; }

__device__ __forceinline__ void phase_h0(ArgP a, int wave) {
    const int tidn = tid_now(wave), lane = tidn & 63;
    const int gw = blockIdx.x * 8 + wave, NGW = gridDim.x * 8;
    unsigned char* ws = a->ws;
    const float* MOD = (const float*)(ws + WS_MOD);
    for (int m = gw; m < MT; m += NGW) {
        const int sl = mod_sel(m); const float* xr = x_input_row(a, m); const float* mod = MOD + (size_t)sl * 12288; bf16* ho = (bf16*)(ws + WS_H) + (size_t)m * D;
        f32x4 x[8]; float sq = 0.f;
#pragma unroll
        for (int j = 0; j < 8; ++j) { x[j] = *(const f32x4*)(xr + lane * 4 + 256 * j); sq += (x[j].x * x[j].x + x[j].y * x[j].y) + (x[j].z * x[j].z + x[j].w * x[j].w); }
        const float rs = rsq_(wave_sum(sq, lane) * (1.f / D) + EPS);
#pragma unroll
        for (int j = 0; j < 8; ++j) { const f32x4 h = (x[j] * rs) * (*(const f32x4*)(a->in[11] + lane * 4 + 256 * j) * (*(const f32x4*)(mod + D + lane * 4 + 256 * j) + 1.f)) + *(const f32x4*)(mod + lane * 4 + 256 * j);
            u32x2 o; o.x = pk2(h.x, h.y); o.y = pk2(h.z, h.w); *(u32x2*)(ho + lane * 4 + 256 * j) = o; }
    }
}

__device__ __forceinline__ float gelu_tanh(float x) { const float u = 0.7978845608028654f * (x + 0.044715f * x * x * x); return x * sigmoidf_(2.f * u); }
__device__ __forceinline__ void st8bf(bf16* p, const f32x4 v0, const f32x4 v1) { u32x4 w; w.x = pk2(v0.x, v0.y); w.y = pk2(v0.z, v0.w); w.z = pk2(v1.x, v1.y); w.w = pk2(v1.z, v1.w); *(u32x4*)p = w; }

#define ROWV() f32x4 V[2][2]; _Pragma("unroll") for (int bj_ = 0; bj_ < 2; ++bj_) _Pragma("unroll") for (int n_ = 0; n_ < 2; ++n_) V[bj_][n_] = acc[ai][bj_][m][n_];
struct EpiWin {
    static constexpr bool AFTER_DRAIN = false; static constexpr int CHAIN = 1;
    unsigned char* ws; float* out; int l;
    __device__ __forceinline__ void operator()(const f32x4 (&acc)[2][2][4][2], const Unit& u, int wr, int wc, int fr, int fq) const {
        { int ln_; asm volatile("v_mbcnt_lo_u32_b32 %0, -1, 0\n\tv_mbcnt_hi_u32_b32 %0, -1, %0" : "=v"(ln_)); fr = ln_ & 15; fq = ln_ >> 4; }
        const int l = this->l;
        const int t = u.pn, row0 = u.pm * 256 + wr * 64 + fr, cl = wc * 32 + 8 * fq;
        const bool ctx = u.pm < 16;
        if (t < 4) {
            bf16* O = (bf16*)(ws + WS_QA);
#pragma unroll
            for (int ai = 0; ai < 2; ++ai)
#pragma unroll
                for (int m = 0; m < 4; ++m) { asm volatile("" ::: "memory"); const unsigned r = (unsigned)(row0 + ai * 128 + m * 16); ROWV();
#pragma unroll
                    for (int bj = 0; bj < 2; ++bj) st8bf(O + r * 1024 + t * 256 + bj * 128 + cl, V[bj][0], V[bj][1]); }
        } else if (t < 12) {
            const int cb = (t - 4) * 256;
            const float* LB = (const float*)(ws + WS_LB) + l * 2048;
            bf16* LG = (bf16*)(ws + WS_LG); bf16* KK = (bf16*)(ws + WS_KK);
#pragma unroll
            for (int bj = 0; bj < 2; ++bj) {
                const int c0 = cb + bj * 128 + cl;
                const f32x4 lb0 = *(const f32x4*)(LB + c0), lb1 = *(const f32x4*)(LB + c0 + 4);
#pragma unroll
                for (int ai = 0; ai < 2; ++ai)
#pragma unroll
                    for (int m = 0; m < 4; ++m) { asm volatile("" ::: "memory"); const unsigned r = (unsigned)(row0 + ai * 128 + m * 16); ROWV();
                        f32x4 lg[2];
#pragma unroll
                        for (int n = 0; n < 2; ++n) { const f32x4 lb = n ? lb1 : lb0; const f32x4 x = V[bj][n];
#pragma unroll
                            for (int e = 0; e < 4; ++e) { const float sg = sigmoidf_(x[e]); const float f = lb[e] + (1.f - lb[e]) * sg; lg[n][e] = __logf(f); } }
                        st8bf(LG + r * 2048 + c0, lg[0], lg[1]);
                        }
            }
        } else if (t < 16) {
            bf16* O = (bf16*)(ws + WS_VA);
#pragma unroll
            for (int ai = 0; ai < 2; ++ai)
#pragma unroll
                for (int m = 0; m < 4; ++m) { asm volatile("" ::: "memory"); const unsigned r = (unsigned)(row0 + ai * 128 + m * 16); ROWV();
#pragma unroll
                    for (int bj = 0; bj < 2; ++bj) st8bf(O + r * 1024 + (t - 12) * 256 + bj * 128 + cl, V[bj][0], V[bj][1]); }
        } else if (t < 20) {
            bf16* O = (bf16*)(ws + WS_AG);
#pragma unroll
            for (int ai = 0; ai < 2; ++ai)
#pragma unroll
                for (int m = 0; m < 4; ++m) { asm volatile("" ::: "memory"); const unsigned r = (unsigned)(row0 + ai * 128 + m * 16); ROWV();
#pragma unroll
                    for (int bj = 0; bj < 2; ++bj) { f32x4 v0 = V[bj][0], v1 = V[bj][1];
#pragma unroll
                        for (int e = 0; e < 4; ++e) { v0[e] = v0[e] * sigmoidf_(v0[e]); v1[e] = v1[e] * sigmoidf_(v1[e]); }
                        st8bf(O + r * 1024 + (t - 16) * 256 + bj * 128 + cl, v0, v1); } }
        } else if (t < 23) {
            const bool isq = t < 22;
            bf16* O = isq ? (bf16*)(ws + WS_BQ) : (bf16*)(ws + WS_BKV) + (size_t)l * MKV * 256;
            const int ld = isq ? 512 : 256, cb = isq ? (t - 20) * 256 : 0;
            float* SS = isq ? (float*)(ws + WS_SSQQ) : (float*)(ws + WS_SSQKV);
#pragma unroll
            for (int ai = 0; ai < 2; ++ai)
#pragma unroll
                for (int m = 0; m < 4; ++m) { asm volatile("" ::: "memory"); const unsigned r = (unsigned)(row0 + ai * 128 + m * 16); ROWV(); float s = 0.f;
#pragma unroll
                    for (int bj = 0; bj < 2; ++bj) { const f32x4 v0 = V[bj][0], v1 = V[bj][1];
                        s += (v0.x * v0.x + v0.y * v0.y) + (v0.z * v0.z + v0.w * v0.w) + (v1.x * v1.x + v1.y * v1.y) + (v1.z * v1.z + v1.w * v1.w);
                        st8bf(O + r * ld + cb + bj * 128 + cl, v0, v1);
                        if (!isq && ctx) { float* oc = out + OUT_CKV + (((r >> 8) * 4 + l) * 256 + (r & 255)) * 256 + bj * 128 + cl; *(f32x4*)oc = v0; *(f32x4*)(oc + 4) = v1; } }
                    s += shx(s, 16, fq * 16 + fr); s += shx(s, 32, fq * 16 + fr);
                    if (fq == 0) { if (isq) SS[r * 8 + (t - 20) * 4 + wc] = s; else SS[r * 4 + wc] = s; } }
        } else if (t < 28) {
            const bool isq = t < 27;
            const float* CS = (const float*)(ws + WS_ROPE);
            const int hd = wc >> 1, part = wc & 1, i0 = 8 * fq;
            const int ncol = hd * 128 + part * 64 + i0;
            bf16* O = isq ? (bf16*)(ws + WS_QC) : (bf16*)(ws + WS_KC) + (size_t)l * MKV * 256;
            const int ld = isq ? 1024 : 256, cb = isq ? (t - 23) * 256 : 0;
            const float qs = isq ? SCALE_C * 1.4426950408889634f : 1.f;
#pragma unroll
            for (int ai = 0; ai < 2; ++ai)
#pragma unroll
                for (int m = 0; m < 4; ++m) { asm volatile("" ::: "memory"); const unsigned r = (unsigned)(row0 + ai * 128 + m * 16); ROWV();
                    f32x4 o1[2], o2[2];
                    if (ctx) { o1[0] = V[0][0]; o1[1] = V[0][1]; o2[0] = V[1][0]; o2[1] = V[1][1]; }
                    else { const int tt = ((int)r - MC) & 1023; const int pos = part ? (tt & 63) : (tt >> 6);
#pragma unroll
                        for (int n = 0; n < 2; ++n) { const f32x4 c = *(const f32x4*)(CS + pos * 32 + i0 + 4 * n), s = *(const f32x4*)(CS + 2048 + pos * 32 + i0 + 4 * n);
                            const f32x4 x1 = V[0][n], x2 = V[1][n]; o1[n] = x1 * c - x2 * s; o2[n] = x1 * s + x2 * c; } }
                    if (!isq && ctx) { float* oc = out + OUT_K + (((r >> 8) * 4 + l) * 256 + (r & 255)) * 256 + ncol; *(f32x4*)oc = o1[0]; *(f32x4*)(oc + 4) = o1[1]; *(f32x4*)(oc + 32) = o2[0]; *(f32x4*)(oc + 36) = o2[1]; }
                    st8bf(O + r * ld + cb + ncol, o1[0] * qs, o1[1] * qs); st8bf(O + r * ld + cb + ncol + 32, o2[0] * qs, o2[1] * qs); }
        } else if (t == 28) {
            bf16* O = (bf16*)(ws + WS_VC) + (size_t)l * MKV * 256;
#pragma unroll
            for (int ai = 0; ai < 2; ++ai)
#pragma unroll
                for (int m = 0; m < 4; ++m) { asm volatile("" ::: "memory"); const unsigned r = (unsigned)(row0 + ai * 128 + m * 16); ROWV();
#pragma unroll
                    for (int bj = 0; bj < 2; ++bj) { st8bf(O + r * 256 + bj * 128 + cl, V[bj][0], V[bj][1]);
                        if (ctx) { float* oc = out + OUT_V + (((r >> 8) * 4 + l) * 256 + (r & 255)) * 256 + bj * 128 + cl; *(f32x4*)oc = V[bj][0]; *(f32x4*)(oc + 4) = V[bj][1]; } } }
        } else if (t < 53) {
            unsigned char* O = ws + WS_GT;
#pragma unroll
            for (int ai = 0; ai < 2; ++ai)
#pragma unroll
                for (int m = 0; m < 4; ++m) { asm volatile("" ::: "memory"); const unsigned r = (unsigned)(row0 + ai * 128 + m * 16); ROWV();
                    u32x4 w4 = (u32x4){0u, 0u, 0u, 0u};
#pragma unroll
                    for (int bj = 0; bj < 2; ++bj) { f32x4 v0 = V[bj][0], v1 = V[bj][1];
#pragma unroll
                        for (int e = 0; e < 4; ++e) { v0[e] = 255.f * sigmoidf_(v0[e]); v1[e] = 255.f * sigmoidf_(v1[e]); }
                        unsigned wx = 0u, wy = 0u;
#pragma unroll
                        for (int e = 0; e < 4; ++e) { wx = __builtin_amdgcn_cvt_pk_u8_f32(v0[e], e, wx); wy = __builtin_amdgcn_cvt_pk_u8_f32(v1[e], e, wy); }
                        if (bj == 0) { w4.x = wx; w4.y = wy; } else { w4.z = wx; w4.w = wy; } }
                    *(u32x4*)(O + r * 6144 + (t - 29) * 256 + 2 * cl) = w4; }
        } else {
            if (wc == 0) {
                const float* CS = (const float*)(ws + WS_ROPE) + 4096;
                const int part = fq >> 1, i0 = 8 * (fq & 1); const int ncol = part * 32 + i0;
                bf16* O = (bf16*)(ws + WS_KR) + (size_t)l * MKV * 64;
#pragma unroll
                for (int ai = 0; ai < 2; ++ai)
#pragma unroll
                    for (int m = 0; m < 4; ++m) { asm volatile("" ::: "memory"); const unsigned r = (unsigned)(row0 + ai * 128 + m * 16); ROWV();
                        f32x4 o1[2], o2[2];
                        if (ctx) { o1[0] = V[0][0]; o1[1] = V[0][1]; o2[0] = V[1][0]; o2[1] = V[1][1]; }
                        else { const int tt = ((int)r - MC) & 1023; const int pos = part ? (tt & 63) : (tt >> 6);
#pragma unroll
                            for (int n = 0; n < 2; ++n) { const f32x4 c = *(const f32x4*)(CS + pos * 16 + i0 + 4 * n), s = *(const f32x4*)(CS + 1024 + pos * 16 + i0 + 4 * n);
                                const f32x4 x1 = V[0][n], x2 = V[1][n]; o1[n] = x1 * c - x2 * s; o2[n] = x1 * s + x2 * c; } }
                        if (ctx) { float* oc = out + OUT_KR + (((r >> 8) * 4 + l) * 256 + (r & 255)) * 64 + ncol; *(f32x4*)oc = o1[0]; *(f32x4*)(oc + 4) = o1[1]; *(f32x4*)(oc + 16) = o2[0]; *(f32x4*)(oc + 20) = o2[1]; }
                        st8bf(O + r * 64 + ncol, o1[0], o1[1]); st8bf(O + r * 64 + ncol + 16, o2[0], o2[1]); }
            }
        }
    }
};

struct EpiUq {
    static constexpr bool AFTER_DRAIN = false; static constexpr int CHAIN = 1;
    unsigned char* ws;
    __device__ __forceinline__ void operator()(const f32x4 (&acc)[2][2][4][2], const Unit& u, int wr, int wc, int fr, int fq) const {
        { int ln_; asm volatile("v_mbcnt_lo_u32_b32 %0, -1, 0\n\tv_mbcnt_hi_u32_b32 %0, -1, %0" : "=v"(ln_)); fr = ln_ & 15; fq = ln_ >> 4; }
        const int t = u.pn, row0 = u.pm * 256 + wr * 64 + fr, cl = wc * 32 + 8 * fq; const bool ctx = u.pm < 16;
        const float* SS = (const float*)(ws + WS_SSQQ); bf16* O = (bf16*)(ws + WS_QF);
        const float* CS = (const float*)(ws + WS_ROPE) + 4096;
        float rsv[2][4];
#pragma unroll
        for (int ai = 0; ai < 2; ++ai)
#pragma unroll
            for (int m = 0; m < 4; ++m) { const unsigned r = (unsigned)(row0 + ai * 128 + m * 16); const f32x4 s0 = *(const f32x4*)(SS + r * 8), s1 = *(const f32x4*)(SS + r * 8 + 4);
                rsv[ai][m] = (SCALE_B * 1.4426950408889634f) * rsq_(((s0.x + s0.y) + (s0.z + s0.w) + (s1.x + s1.y) + (s1.z + s1.w)) * (1.f / 512.f) + EPS); }
#pragma unroll
        for (int ai = 0; ai < 2; ++ai)
#pragma unroll
            for (int m = 0; m < 4; ++m) { asm volatile("" ::: "memory"); const unsigned r = (unsigned)(row0 + ai * 128 + m * 16);
                const float rs = rsv[ai][m];
                if (t < 4) {
#pragma unroll
                    for (int bj = 0; bj < 2; ++bj) { const int hd = t * 2 + bj; st8bf(O + r * 1536 + hd * 192 + cl, acc[ai][bj][m][0] * rs, acc[ai][bj][m][1] * rs); }
                } else {
                    const int hd = (t - 4) * 4 + wc, part = fq >> 1, i0 = 8 * (fq & 1); const int ncol = hd * 192 + 128 + part * 32 + i0;
                    f32x4 o1[2], o2[2];
                    if (ctx) { o1[0] = acc[ai][0][m][0]; o1[1] = acc[ai][0][m][1]; o2[0] = acc[ai][1][m][0]; o2[1] = acc[ai][1][m][1]; }
                    else { const int tt = ((int)r - MC) & 1023; const int pos = part ? (tt & 63) : (tt >> 6);
#pragma unroll
                        for (int n = 0; n < 2; ++n) { const f32x4 c = *(const f32x4*)(CS + pos * 16 + i0 + 4 * n), s = *(const f32x4*)(CS + 1024 + pos * 16 + i0 + 4 * n);
                            const f32x4 x1 = acc[ai][0][m][n], x2 = acc[ai][1][m][n]; o1[n] = x1 * c - x2 * s; o2[n] = x1 * s + x2 * c; } }
                    st8bf(O + r * 1536 + ncol, o1[0] * rs, o1[1] * rs); st8bf(O + r * 1536 + ncol + 16, o2[0] * rs, o2[1] * rs);
                }
            }
    }
};

struct EpiKv {
    static constexpr bool AFTER_DRAIN = false; static constexpr int CHAIN = 1;
    unsigned char* ws;
    __device__ __forceinline__ void operator()(const f32x4 (&acc)[2][2][4][2], const Unit& u, int wr, int wc, int fr, int fq) const {
        { int ln_; asm volatile("v_mbcnt_lo_u32_b32 %0, -1, 0\n\tv_mbcnt_hi_u32_b32 %0, -1, %0" : "=v"(ln_)); fr = ln_ & 15; fq = ln_ >> 4; }
        const int row0 = u.pm * 256 + wr * 64 + fr, cl = wc * 32 + 8 * fq;
        const float* SS = (const float*)(ws + WS_SSQKV); bf16* O = (bf16*)(ws + WS_KV);
        float rsv[2][4];
#pragma unroll
        for (int ai = 0; ai < 2; ++ai)
#pragma unroll
            for (int m = 0; m < 4; ++m) { const unsigned r = (unsigned)(row0 + ai * 128 + m * 16); const f32x4 s0 = *(const f32x4*)(SS + r * 4);
                rsv[ai][m] = rsq_(((s0.x + s0.y) + (s0.z + s0.w)) * (1.f / 256.f) + EPS); }
#pragma unroll
        for (int ai = 0; ai < 2; ++ai)
#pragma unroll
            for (int m = 0; m < 4; ++m) { asm volatile("" ::: "memory"); const unsigned r = (unsigned)(row0 + ai * 128 + m * 16);
                const float rs = rsv[ai][m];
#pragma unroll
                for (int bj = 0; bj < 2; ++bj) st8bf(O + r * 2048 + u.pn * 256 + bj * 128 + cl, acc[ai][bj][m][0] * rs, acc[ai][bj][m][1] * rs); }
    }
};

struct EpiBranch {
    static constexpr bool AFTER_DRAIN = false; static constexpr int CHAIN = 3;
    unsigned char* ws;
    __device__ __forceinline__ void operator()(f32x4 (&acc)[2][2][4][2], const Unit& u, int wr, int wc, int fr, int fq) const {
        { int ln_; asm volatile("v_mbcnt_lo_u32_b32 %0, -1, 0\n\tv_mbcnt_hi_u32_b32 %0, -1, %0" : "=v"(ln_)); fr = ln_ & 15; fq = ln_ >> 4; }
        const int row0 = u.pm * 256 + wr * 64 + fr, cl = wc * 32 + 8 * fq;
        const unsigned char* G = ws + WS_GT; bf16* O = (bf16*)(ws + WS_MG);
        const int sub = u.sub;
#pragma unroll
        for (int ai = 0; ai < 2; ++ai) { asm volatile("" ::: "memory");
            u32x4 ga4[4], gb4[4];
#pragma unroll
            for (int m = 0; m < 4; ++m) { const unsigned r = (unsigned)(row0 + ai * 128 + m * 16); const int c16 = u.pn * 256 + 2 * cl;
                ga4[m] = *(const u32x4*)(G + r * 6144 + sub * 2048 + c16);
                gb4[m] = (sub < 2) ? *(const u32x4*)(G + r * 6144 + (sub + 1) * 2048 + c16) : (u32x4){0u, 0u, 0u, 0u}; }
#pragma unroll
            for (int m = 0; m < 4; ++m)
#pragma unroll
                for (int bj = 0; bj < 2; ++bj) { const unsigned r = (unsigned)(row0 + ai * 128 + m * 16); const int c = u.pn * 256 + bj * 128 + cl;
                    const u32x2 a4 = bj ? (u32x2){ga4[m].z, ga4[m].w} : (u32x2){ga4[m].x, ga4[m].y}, b4 = bj ? (u32x2){gb4[m].z, gb4[m].w} : (u32x2){gb4[m].x, gb4[m].y};
#define UB_(w, k) ((float)(((w) >> (8 * (k))) & 0xffu))
                    float s[8] = {UB_(a4.x, 0), UB_(a4.x, 1), UB_(a4.x, 2), UB_(a4.x, 3), UB_(a4.y, 0), UB_(a4.y, 1), UB_(a4.y, 2), UB_(a4.y, 3)};
#pragma unroll
                    for (int e = 0; e < 8; ++e) s[e] = fmaxf(s[e], 255e-6f);
                    if (sub < 2) { const float d[8] = {UB_(b4.x, 0), UB_(b4.x, 1), UB_(b4.x, 2), UB_(b4.x, 3), UB_(b4.y, 0), UB_(b4.y, 1), UB_(b4.y, 2), UB_(b4.y, 3)};
#pragma unroll
                        for (int e = 0; e < 8; ++e) s[e] *= __builtin_amdgcn_rcpf(fmaxf(d[e], 255e-6f)); }
                    else {
#pragma unroll
                        for (int e = 0; e < 8; ++e) s[e] *= (1.f / 255.f); }
#undef UB_
                    f32x4 v0 = acc[ai][bj][m][0], v1 = acc[ai][bj][m][1];
                    v0.x *= s[0]; v0.y *= s[1]; v0.z *= s[2]; v0.w *= s[3]; v1.x *= s[4]; v1.y *= s[5]; v1.z *= s[6]; v1.w *= s[7];
                    if (sub < 2) { acc[ai][bj][m][0] = v0; acc[ai][bj][m][1] = v1; }
                    else st8bf(O + r * 2048 + c, v0, v1); } }
    }
};

struct EpiF32 {
    static constexpr bool AFTER_DRAIN = false; static constexpr int CHAIN = 1;
    float* O; int ld;
    __device__ __forceinline__ void operator()(const f32x4 (&acc)[2][2][4][2], const Unit& u, int wr, int wc, int fr, int fq) const {
        { int ln_; asm volatile("v_mbcnt_lo_u32_b32 %0, -1, 0\n\tv_mbcnt_hi_u32_b32 %0, -1, %0" : "=v"(ln_)); fr = ln_ & 15; fq = ln_ >> 4; }
        const int row0 = u.pm * 256 + wr * 64 + fr, cl = wc * 32 + 8 * fq;
#pragma unroll
        for (int ai = 0; ai < 2; ++ai)
#pragma unroll
            for (int m = 0; m < 4; ++m) { asm volatile("" ::: "memory"); const unsigned r = (unsigned)(row0 + ai * 128 + m * 16);
#pragma unroll
                for (int bj = 0; bj < 2; ++bj) { float* p = O + r * ld + u.pn * 256 + bj * 128 + cl; *(f32x4*)p = acc[ai][bj][m][0]; *(f32x4*)(p + 4) = acc[ai][bj][m][1]; } }
    }
};
struct EpiBf {
    static constexpr bool AFTER_DRAIN = false; static constexpr int CHAIN = 1;
    bf16* O; int ld;
    __device__ __forceinline__ void operator()(const f32x4 (&acc)[2][2][4][2], const Unit& u, int wr, int wc, int fr, int fq) const {
        { int ln_; asm volatile("v_mbcnt_lo_u32_b32 %0, -1, 0\n\tv_mbcnt_hi_u32_b32 %0, -1, %0" : "=v"(ln_)); fr = ln_ & 15; fq = ln_ >> 4; }
        const int row0 = u.pm * 256 + wr * 64 + fr, cl = wc * 32 + 8 * fq;
#pragma unroll
        for (int ai = 0; ai < 2; ++ai)
#pragma unroll
            for (int m = 0; m < 4; ++m) { asm volatile("" ::: "memory"); const unsigned r = (unsigned)(row0 + ai * 128 + m * 16);
#pragma unroll
                for (int bj = 0; bj < 2; ++bj) st8bf(O + r * ld + u.pn * 256 + bj * 128 + cl, acc[ai][bj][m][0], acc[ai][bj][m][1]); }
    }
};

__device__ __forceinline__ float dpp_prev(float x) { return __builtin_bit_cast(float, __builtin_amdgcn_update_dpp(0, __builtin_bit_cast(int, x), 0x121, 0xf, 0xf, false)); }
__device__ __forceinline__ float dpp_next(float x) { return __builtin_bit_cast(float, __builtin_amdgcn_update_dpp(0, __builtin_bit_cast(int, x), 0x12f, 0xf, 0xf, false)); }
__device__ __forceinline__ float dpp_up(float e, float x) { return __builtin_bit_cast(float, __builtin_amdgcn_update_dpp(__builtin_bit_cast(int, e), __builtin_bit_cast(int, x), 0x111, 0xf, 0xf, false)); }
__device__ __forceinline__ float dpp_dn(float e, float x) { return __builtin_bit_cast(float, __builtin_amdgcn_update_dpp(__builtin_bit_cast(int, e), __builtin_bit_cast(int, x), 0x101, 0xf, 0xf, false)); }
struct EpiUp {
    static constexpr bool AFTER_DRAIN = false; static constexpr int CHAIN = 1;
    unsigned char* ws; const float* cw; LAS unsigned char* hl; int l;
    __device__ __forceinline__ void put_partial(const f32x4 (&acc)[2][2][4][2], const Unit& u, int wave) const {
        const int tid = tid_now(wave), j = (u.sub - 1) >> 1;
        float* P = (float*)(ws + WS_SPL) + (size_t)j * 65536 + tid * 4;
#pragma unroll
        for (int ai = 0; ai < 2; ++ai)
#pragma unroll
            for (int bj = 0; bj < 2; ++bj)
#pragma unroll
                for (int m = 0; m < 4; ++m)
#pragma unroll
                    for (int n = 0; n < 2; ++n) *(f32x4*)(P + (((ai * 2 + bj) * 4 + m) * 2 + n) * 2048) = acc[ai][bj][m][n];
        asm volatile("s_waitcnt vmcnt(0)" ::: "memory");
        __syncthreads();
        if (tid == 0) { __builtin_amdgcn_fence(__ATOMIC_RELEASE, "agent"); asm volatile("s_waitcnt vmcnt(0)" ::: "memory"); __hip_atomic_store((unsigned*)ws + CW_SPL + l * 128 + j, 1u, RLX_AGENT); }
    }
    __device__ __forceinline__ void get_partial(f32x4 (&acc)[2][2][4][2], const Unit& u, int wave) const {
        const int tid = tid_now(wave), j = (u.sub - 1) >> 1;
        if (tid == 0) { unsigned* f = (unsigned*)ws + CW_SPL + l * 128 + j; unsigned sp = 0; while (__hip_atomic_load(f, RLX_AGENT) == 0u) { __builtin_amdgcn_s_sleep(1); if (++sp > (1u << 22)) break; }
            __builtin_amdgcn_fence(__ATOMIC_ACQUIRE, "agent"); asm volatile("s_waitcnt vmcnt(0)" ::: "memory"); }
        __syncthreads();
        const float* P = (const float*)(ws + WS_SPL) + (size_t)j * 65536 + tid * 4;
#pragma unroll
        for (int ai = 0; ai < 2; ++ai) { f32x4 p[2][4][2];
#pragma unroll
            for (int bj = 0; bj < 2; ++bj)
#pragma unroll
                for (int m = 0; m < 4; ++m)
#pragma unroll
                    for (int n = 0; n < 2; ++n) p[bj][m][n] = *(const f32x4*)(P + (((ai * 2 + bj) * 4 + m) * 2 + n) * 2048);
#pragma unroll
            for (int bj = 0; bj < 2; ++bj)
#pragma unroll
                for (int m = 0; m < 4; ++m)
#pragma unroll
                    for (int n = 0; n < 2; ++n) acc[ai][bj][m][n] += p[bj][m][n]; }
    }
    __device__ __forceinline__ void operator()(const f32x4 (&acc)[2][2][4][2], const Unit& u, int wr, int wc, int fr, int fq) const {
        { int ln_; asm volatile("v_mbcnt_lo_u32_b32 %0, -1, 0\n\tv_mbcnt_hi_u32_b32 %0, -1, %0" : "=v"(ln_)); fr = ln_ & 15; fq = ln_ >> 4; }
        const int cl = wc * 32 + 8 * fq;
        LAS f32x4* HL = (LAS f32x4*)hl;
#pragma unroll
        for (int ai = 0; ai < 2; ++ai) {
            if (fr == 0) {
#pragma unroll
                for (int bj = 0; bj < 2; ++bj)
#pragma unroll
                    for (int n = 0; n < 2; ++n) HL[((((ai * 2 + wr) * 4 + wc) * 2 + 0) * 4 + fq) * 4 + bj * 2 + n] = acc[ai][bj][0][n]; }
            if (fr == 15) {
#pragma unroll
                for (int bj = 0; bj < 2; ++bj)
#pragma unroll
                    for (int n = 0; n < 2; ++n) HL[((((ai * 2 + wr) * 4 + wc) * 2 + 1) * 4 + fq) * 4 + bj * 2 + n] = acc[ai][bj][3][n]; }
        }
        if (u.pm >= 16) {
            bf16* HU = (bf16*)(ws + WS_HALO) + (size_t)(u.pm - 16) * 4 * NUP + u.pn * 256 + cl;
            if (wr == 0 && fr < 2) {
#pragma unroll
                for (int bj = 0; bj < 2; ++bj) st8bf(HU + (size_t)fr * NUP + bj * 128, acc[0][bj][0][0], acc[0][bj][0][1]); }
            if (wr == 1 && fr >= 14) {
#pragma unroll
                for (int bj = 0; bj < 2; ++bj) st8bf(HU + (size_t)(fr - 12) * NUP + bj * 128, acc[1][bj][3][0], acc[1][bj][3][1]); }
        }
        asm volatile("s_waitcnt lgkmcnt(0)" ::: "memory");
        __builtin_amdgcn_s_barrier();
        bf16* ACT = (bf16*)(ws + WS_ACT);
        LAS u32x2* KEEP = (LAS u32x2*)(hl - HALO_OFF + 3 * 16384) + (wr * 4 + wc) * 64 + (fq * 16 + fr);
#pragma unroll
        for (int ai = 0; ai < 2; ++ai) {
#pragma unroll
            for (int n = 0; n < 2; ++n) { asm volatile("" ::: "memory");
                f32x4 wa[3], wg[3];
#pragma unroll
                for (int tap = 0; tap < 3; ++tap) { const float* p = cw + tap * NUP + u.pn * 128 + cl + 4 * n; wa[tap] = *(const f32x4*)p; wg[tap] = *(const f32x4*)(p + DFF); }
                f32x4 top[2], bot[2];
#pragma unroll
                for (int bj = 0; bj < 2; ++bj) {
                    const int tsrc = (wr == 1) ? (ai * 2 + 0) : 1;
                    const int bsrc = (wr == 0) ? (ai * 2 + 1) : 2;
                    const f32x4 tv = HL[(((tsrc * 4 + wc) * 2 + 1) * 4 + fq) * 4 + bj * 2 + n], bv = HL[(((bsrc * 4 + wc) * 2 + 0) * 4 + fq) * 4 + bj * 2 + n];
                    top[bj] = (wr == 1 || ai == 1) ? tv : (f32x4){0.f, 0.f, 0.f, 0.f};
                    bot[bj] = (wr == 0 || ai == 0) ? bv : (f32x4){0.f, 0.f, 0.f, 0.f}; }
#pragma unroll
                for (int m = 0; m < 4; ++m) { asm volatile("" ::: "memory");
                    const unsigned r = (unsigned)(u.pm * 256 + ai * 128 + wr * 64 + m * 16 + fr);
                    f32x4 res;
#pragma unroll
                    for (int e = 0; e < 4; ++e) {
                        float v[2];
#pragma unroll
                        for (int bj = 0; bj < 2; ++bj) {
                            const float x = acc[ai][bj][m][n][e];
                            const float pe_ = (m == 0) ? top[bj][e] : dpp_prev(acc[ai][bj][m == 0 ? 0 : m - 1][n][e]);
                            const float ne_ = (m == 3) ? bot[bj][e] : dpp_next(acc[ai][bj][m == 3 ? 3 : m + 1][n][e]);
                            const float up = dpp_up(pe_, x), dn = dpp_dn(ne_, x);
                            const float w0 = bj ? wg[0][e] : wa[0][e], w1 = bj ? wg[1][e] : wa[1][e], w2 = bj ? wg[2][e] : wa[2][e];
                            v[bj] = w0 * up + w1 * x + w2 * dn; }
                        res[e] = v[0] * gelu_tanh(v[1]); }
                    u32x2 o; o.x = cvtpk_p(res.x, res.y); o.y = cvtpk_p(res.z, res.w);
                    if (n == 0) KEEP[m * 512] = o;
                    else { const u32x2 k0 = KEEP[m * 512]; const u32x4 o4 = (u32x4){k0.x, k0.y, o.x, o.y}; *(u32x4*)(ACT + r * DFF + u.pn * 128 + cl) = o4; } }
            }
        }
        __builtin_amdgcn_s_barrier();
    }
};
__device__ __forceinline__ void conv_fixup(ArgP a, int l, int pm, int wave) {
    if (pm < 16) return;
    const int tid = tid_now(wave); const int tl = pm - 16;
    const bf16* HU = (const bf16*)(a->ws + WS_HALO); bf16* ACT = (bf16*)(a->ws + WS_ACT); const float* CW = a->in[28] + (size_t)l * 3 * NUP;
    for (int it = tid; it < 2 * (DFF / 8); it += 512) {
        const int which = it / (DFF / 8), c = (it % (DFF / 8)) * 8; const int j = c >> 7, i = c & 127;
        if (which == 0 ? ((tl & 3) == 0) : ((tl & 3) == 3)) continue;
        const bf16* r0 = which == 0 ? HU + ((size_t)(tl - 1) * 4 + 3) * NUP : HU + ((size_t)tl * 4 + 2) * NUP;
        const bf16* r1 = which == 0 ? HU + ((size_t)tl * 4 + 0) * NUP : HU + ((size_t)tl * 4 + 3) * NUP;
        const bf16* r2 = which == 0 ? HU + ((size_t)tl * 4 + 1) * NUP : HU + ((size_t)(tl + 1) * 4 + 0) * NUP;
        const bf16* rr[3] = {r0, r1, r2};
        f32x4 ra0 = (f32x4){0.f, 0.f, 0.f, 0.f}, ra1 = ra0, rg0 = ra0, rg1 = ra0;
#pragma unroll
        for (int tap = 0; tap < 3; ++tap) { const u32x4 xa = *(const u32x4*)(rr[tap] + 256 * j + i), xg = *(const u32x4*)(rr[tap] + 256 * j + i + 128);
            const float* p = CW + tap * NUP + c; const f32x4 wa0 = *(const f32x4*)p, wa1 = *(const f32x4*)(p + 4), wg0 = *(const f32x4*)(p + DFF), wg1 = *(const f32x4*)(p + DFF + 4);
            ra0 += wa0 * (f32x4){bf_lo(xa.x), bf_hi(xa.x), bf_lo(xa.y), bf_hi(xa.y)}; ra1 += wa1 * (f32x4){bf_lo(xa.z), bf_hi(xa.z), bf_lo(xa.w), bf_hi(xa.w)};
            rg0 += wg0 * (f32x4){bf_lo(xg.x), bf_hi(xg.x), bf_lo(xg.y), bf_hi(xg.y)}; rg1 += wg1 * (f32x4){bf_lo(xg.z), bf_hi(xg.z), bf_lo(xg.w), bf_hi(xg.w)}; }
        u32x4 o; o.x = pk2(ra0.x * gelu_tanh(rg0.x), ra0.y * gelu_tanh(rg0.y)); o.y = pk2(ra0.z * gelu_tanh(rg0.z), ra0.w * gelu_tanh(rg0.w));
        o.z = pk2(ra1.x * gelu_tanh(rg1.x), ra1.y * gelu_tanh(rg1.y)); o.w = pk2(ra1.z * gelu_tanh(rg1.z), ra1.w * gelu_tanh(rg1.w));
        *(u32x4*)(ACT + (size_t)(pm * 256 + (which ? 255 : 0)) * DFF + c) = o;
    }
    asm volatile("s_waitcnt vmcnt(0)" ::: "memory");
    __syncthreads();
}

#define RLX_AG __ATOMIC_RELAXED, __HIP_MEMORY_SCOPE_AGENT
__device__ __forceinline__ void panel_exchange(LAS float* P, LAS float* R, unsigned* X, unsigned* cnt, int pm, int pn, int tid) {
    if (tid < 256) { const f32x4 p = *(const LAS f32x4*)(P + tid * 4); const float tot = (p.x + p.y) + (p.z + p.w);
        __hip_atomic_store(X + ((size_t)(pm * 256 + tid)) * 8 + pn, __builtin_bit_cast(unsigned, tot), RLX_AG); }
    asm volatile("s_waitcnt vmcnt(0)" ::: "memory");
    __syncthreads();
    if (tid == 0) { (void)__hip_atomic_fetch_add(cnt, 1u, RLX_AG);
        unsigned sp = 0; while (__hip_atomic_load(cnt, RLX_AG) < 8u) { __builtin_amdgcn_s_sleep(1); if (++sp > (1u << 22)) break; } }
    __syncthreads();
    if (tid < 256) { float tot = 0.f;
#pragma unroll
        for (int j = 0; j < 8; ++j) tot += __builtin_bit_cast(float, __hip_atomic_load(X + ((size_t)(pm * 256 + tid)) * 8 + j, RLX_AG));
        R[tid] = rsq_(tot * (1.f / D) + EPS); }
    __syncthreads();
}
template <int WHICH, bool XF32>
struct EpiResid {
    static constexpr bool AFTER_DRAIN = true; static constexpr int CHAIN = 1;
    unsigned char* ws; float* out; const float* xin0; const float* xin1; const float* npost; const float* nnext; int l; int mk_next;
    __device__ __forceinline__ void operator()(const f32x4 (&acc)[2][2][4][2], const Unit& u, int wr, int wc, int fr, int fq) const {}
    __device__ __forceinline__ void fused(f32x4 (&acc)[2][2][4][2], const Unit& u, int wr, int wc, int fr, int fq, LAS unsigned char* lds, int tid) const {
        { int ln_; asm volatile("v_mbcnt_lo_u32_b32 %0, -1, 0\n\tv_mbcnt_hi_u32_b32 %0, -1, %0" : "=v"(ln_)); fr = ln_ & 15; fq = ln_ >> 4; tid = (wr * 4 + wc) * 64 + ln_; }
        LAS float* P = (LAS float*)lds; LAS float* R = (LAS float*)(lds + 4096);
        const int lr0 = wr * 64 + fr, cl = wc * 32 + 8 * fq, ln = fq * 16 + fr;
#pragma unroll
        for (int ai = 0; ai < 2; ++ai)
#pragma unroll
            for (int m = 0; m < 4; ++m) { float sq = 0.f;
#pragma unroll
                for (int bj = 0; bj < 2; ++bj)
#pragma unroll
                    for (int n = 0; n < 2; ++n) { const f32x4 v = acc[ai][bj][m][n]; sq += (v.x * v.x + v.y * v.y) + (v.z * v.z + v.w * v.w); }
                sq += shx(sq, 16, ln); sq += shx(sq, 32, ln);
                if (fq == 0) P[(ai * 128 + lr0 + m * 16) * 4 + wc] = sq; }
        __syncthreads();
        unsigned* X = (unsigned*)(ws + WS_XCH) + (size_t)(WHICH * 2) * MT * 8;
        unsigned* cnt = (unsigned*)(ws + WS_CTL) + CW_CNT + (((l * 2 + WHICH) * 2) * 32 + u.pm) * 64;
        const int sel = (u.pm < 16) ? 0 : 1 + ((u.pm - 16) >> 2);
        const float* MODL = (const float*)(ws + WS_MOD) + (size_t)(l * 5 + sel) * 12288;
        const unsigned cb = (unsigned)(u.pn * 256 + cl);
        const bf16* XB = (const bf16*)(ws + WS_XB);
        u32x4 xraw[4][2];
#pragma unroll
        for (int m = 0; m < 4; ++m)
#pragma unroll
            for (int bj = 0; bj < 2; ++bj) xraw[m][bj] = (u32x4){0u, 0u, 0u, 0u};
        if constexpr (!XF32) {
#pragma unroll
            for (int m = 0; m < 4; ++m) { const unsigned r = (unsigned)(u.pm * 256 + lr0 + m * 16);
#pragma unroll
                for (int bj = 0; bj < 2; ++bj) xraw[m][bj] = *(const u32x4*)(XB + r * D + cb + bj * 128); } }
        panel_exchange(P, R, X, cnt, u.pm, u.pn, tid);
        {
        f32x4 gw[2][2];
#pragma unroll
        for (int bj = 0; bj < 2; ++bj)
#pragma unroll
            for (int n = 0; n < 2; ++n) gw[bj][n] = *(const f32x4*)(MODL + (WHICH ? 5 : 2) * D + cb + (bj * 128 + 4 * n)) * *(const f32x4*)(npost + cb + (bj * 128 + 4 * n));
#pragma unroll
        for (int ai = 0; ai < 2; ++ai) { asm volatile("" ::: "memory");
            f32x4 xa[4][2][2];
            if constexpr (XF32) {
#pragma unroll
                for (int m = 0; m < 4; ++m) { const size_t r = (size_t)u.pm * 256 + ai * 128 + lr0 + m * 16; const float* xr = ((r < (size_t)MC) ? xin0 + r * D : xin1 + (r - MC) * D) + cb;
#pragma unroll
                    for (int bj = 0; bj < 2; ++bj)
#pragma unroll
                        for (int n = 0; n < 2; ++n) xa[m][bj][n] = *(const f32x4*)(xr + (bj * 128 + 4 * n)); }
            } else {
                if (ai == 1) {
#pragma unroll
                    for (int m = 0; m < 4; ++m) { const unsigned r = (unsigned)(u.pm * 256 + 128 + lr0 + m * 16);
#pragma unroll
                        for (int bj = 0; bj < 2; ++bj) xraw[m][bj] = *(const u32x4*)(XB + r * D + cb + bj * 128); } }
#pragma unroll
                for (int m = 0; m < 4; ++m)
#pragma unroll
                    for (int bj = 0; bj < 2; ++bj) { const u32x4 w = xraw[m][bj];
                        xa[m][bj][0] = (f32x4){bf_lo(w.x), bf_hi(w.x), bf_lo(w.y), bf_hi(w.y)}; xa[m][bj][1] = (f32x4){bf_lo(w.z), bf_hi(w.z), bf_lo(w.w), bf_hi(w.w)}; } }
#pragma unroll
            for (int m = 0; m < 4; ++m) { const int lr = ai * 128 + lr0 + m * 16; const float rs = R[lr]; float sq = 0.f;
#pragma unroll
                for (int bj = 0; bj < 2; ++bj)
#pragma unroll
                    for (int n = 0; n < 2; ++n) { const f32x4 xn = xa[m][bj][n] + gw[bj][n] * (acc[ai][bj][m][n] * rs); acc[ai][bj][m][n] = xn;
                        sq += (xn.x * xn.x + xn.y * xn.y) + (xn.z * xn.z + xn.w * xn.w); }
                sq += shx(sq, 16, ln); sq += shx(sq, 32, ln);
                if (fq == 0) P[lr * 4 + wc] = sq; } }
        }
        if (!mk_next) {
#pragma unroll
            for (int ai = 0; ai < 2; ++ai)
#pragma unroll
                for (int m = 0; m < 4; ++m) { const size_t r = (size_t)u.pm * 256 + ai * 128 + lr0 + m * 16; float* orow = out + r * D + cb;
#pragma unroll
                    for (int bj = 0; bj < 2; ++bj)
#pragma unroll
                        for (int n = 0; n < 2; ++n) *(f32x4*)(orow + (bj * 128 + 4 * n)) = acc[ai][bj][m][n]; }
            return; }
        const float* MODN = (const float*)(ws + WS_MOD) + (size_t)((WHICH ? l + 1 : l) * 5 + sel) * 12288;
        f32x4 va[2][2], vb[2][2], sh[2][2];
#pragma unroll
        for (int bj = 0; bj < 2; ++bj)
#pragma unroll
            for (int n = 0; n < 2; ++n) { const unsigned c = cb + (unsigned)(bj * 128 + 4 * n);
                va[bj][n] = *(const f32x4*)(nnext + c); vb[bj][n] = *(const f32x4*)(MODN + (WHICH ? 1 : 4) * D + c); sh[bj][n] = *(const f32x4*)(MODN + (WHICH ? 0 : 3) * D + c); }
        __syncthreads();
        panel_exchange(P, R, X + (size_t)MT * 8, cnt + 32 * 64, u.pm, u.pn, tid);
        f32x4 vv[2][2];
#pragma unroll
        for (int bj = 0; bj < 2; ++bj)
#pragma unroll
            for (int n = 0; n < 2; ++n) vv[bj][n] = va[bj][n] * (vb[bj][n] + 1.f);
        bf16* H = (bf16*)(ws + WS_H); bf16* XO = (bf16*)(ws + WS_XB);
#pragma unroll
        for (int ai = 0; ai < 2; ++ai)
#pragma unroll
            for (int m = 0; m < 4; ++m) { const int lr = ai * 128 + lr0 + m * 16; const unsigned r = (unsigned)(u.pm * 256 + lr); const float rs = R[lr];
#pragma unroll
                for (int bj = 0; bj < 2; ++bj) {
                    st8bf(XO + r * D + cb + bj * 128, acc[ai][bj][m][0], acc[ai][bj][m][1]);
                    st8bf(H + r * D + cb + bj * 128, (acc[ai][bj][m][0] * rs) * vv[bj][0] + sh[bj][0], (acc[ai][bj][m][1] * rs) * vv[bj][1] + sh[bj][1]); } }
        __syncthreads();
    }
};

__device__ __forceinline__ void job_ckv_norm(ArgP a, int l, int wave) {
    const int tidn = tid_now(wave), lane = tidn & 63;
    const int gw = blockIdx.x * 8 + wave, NGW = gridDim.x * 8;
    const float* SS = (const float*)(a->ws + WS_SSQKV);
    const f32x4 g = *(const f32x4*)(a->in[20] + l * 256 + lane * 4);
    for (int m = gw; m < MC; m += NGW) {
        const f32x4 s0 = *(const f32x4*)(SS + (size_t)m * 4); const float rs = rsq_(((s0.x + s0.y) + (s0.z + s0.w)) * (1.f / 256.f) + EPS);
        float* p = a->out + OUT_CKV + ((size_t)((m >> 8) * 4 + l) * 256 + (m & 255)) * 256 + lane * 4;
        *(f32x4*)p = *(const f32x4*)p * rs * g;
    }
}

typedef short s16x4 __attribute__((ext_vector_type(4)));
typedef short v4i16_t __attribute__((ext_vector_type(4)));
constexpr float LOG2E = 1.4426950408889634f;
__device__ __forceinline__ unsigned k_swz(unsigned ob) { return ob ^ (((ob >> 9) & 1u) << 5); }
__device__ __forceinline__ unsigned offb(unsigned row, unsigned ch) { return 256u * row + 16u * (ch ^ (((row & 3u) << 2) | ((row >> 2) & 3u))); }
__device__ __forceinline__ unsigned cvtpk(float lo, float hi) { return pk2(lo, hi); }

template <int DK>
__device__ __forceinline__ void attn_stage_load(u32x4 (&kr)[DK / 64], u32x4 (&vr)[2], const bf16* K1, int ldk1, const bf16* K2, int ldk2, const bf16* V, int ldv, int row0, int tid) {
#pragma unroll
    for (int i = 0; i < DK / 64; ++i) { const int c = tid + 512 * i, key = c / (DK / 8), ch = c % (DK / 8);
        if (DK == 128 || ch < 16) kr[i] = *(const u32x4*)(K1 + (unsigned)((row0 + key) * ldk1 + ch * 8)); else kr[i] = *(const u32x4*)(K2 + (unsigned)((row0 + key) * ldk2 + (ch - 16) * 8)); }
#pragma unroll
    for (int i = 0; i < 2; ++i) { const int c = tid + 512 * i, row = c >> 4, ch = c & 15; vr[i] = *(const u32x4*)(V + (unsigned)((row0 + row) * ldv + ch * 8)); }
}
template <int DK>
__device__ __forceinline__ void attn_stage_store(LAS unsigned char* kb, LAS unsigned char* vb, const u32x4 (&kr)[DK / 64], const u32x4 (&vr)[2], int tid) {
#pragma unroll
    for (int i = 0; i < DK / 64; ++i) { const int c = tid + 512 * i, key = c / (DK / 8), ch = c % (DK / 8);
        const int w = key & 31, lr = (key & 32) + ((w >> 2) & 1) * 16 + (w >> 3) * 4 + (w & 3);
        *(LAS u32x4*)(kb + ((lr >> 4) * (DK / 32) + (ch >> 2)) * 1024 + k_swz((unsigned)((lr & 15) * 64 + (ch & 3) * 16))) = kr[i]; }
#pragma unroll
    for (int i = 0; i < 2; ++i) { const int c = tid + 512 * i, row = c >> 4, ch = c & 15; *(LAS u32x4*)(vb + offb((unsigned)row, (unsigned)ch)) = vr[i]; }
}
template <int DK>
__device__ __forceinline__ void attn_unit(LAS unsigned char* lds, int wave, int tid, const bf16* Q, int ldq, const bf16* K1, int ldk1, const bf16* K2, int ldk2, const bf16* V, int ldv,
                                          int s0_row, int s0_tiles, int s1_row, int s1_tiles, bool masked, int qpos0, int kpos0, float sink2, bool has_sink, bf16* O, int ldo) {
    constexpr int KS = DK / 32, KBYTES = 64 * DK * 2, BUF = KBYTES + 16384;
    const int lane = tid & 63, g = lane >> 4, i = lane & 15, q = i >> 2, p = i & 3;
    bf16x8 qf[KS];
    { const bf16* qp = Q + (size_t)(16 * wave + i) * ldq + g * 8;
#pragma unroll
      for (int ks = 0; ks < KS; ++ks) qf[ks] = *(const bf16x8*)(qp + ks * 32); }
    const unsigned koff = k_swz((unsigned)(i * 64 + g * 16));
    unsigned voff[2], vsw[2];
#pragma unroll
    for (int h = 0; h < 2; ++h) { voff[h] = 256u * (unsigned)(8 * g + 4 * h + q) + 8u * (unsigned)(p & 1); vsw[h] = (unsigned)((q << 2) | ((2 * g + h) & 3)); }
    f32x4 o[8];
#pragma unroll
    for (int d = 0; d < 8; ++d) o[d] = (f32x4){0.f, 0.f, 0.f, 0.f};
    float mrun = has_sink ? sink2 : -1e30f, lsum = (has_sink && g == 0) ? 1.f : 0.f;
    const int nt = s0_tiles + s1_tiles, tq = qpos0 + 16 * wave + i;
    u32x4 kr[2][DK / 64], vr[2][2];
    attn_stage_load<DK>(kr[0], vr[0], K1, ldk1, K2, ldk2, V, ldv, s0_row, tid);
    attn_stage_store<DK>(lds, lds + KBYTES, kr[0], vr[0], tid);
    { const int rown = 1 < s0_tiles ? s0_row + 64 : s1_row + 64 * (1 - s0_tiles); attn_stage_load<DK>(kr[1], vr[1], K1, ldk1, K2, ldk2, V, ldv, rown, tid); }
    asm volatile("s_waitcnt lgkmcnt(0)" ::: "memory"); __builtin_amdgcn_s_barrier();
    for (int t2 = 0; t2 < nt; t2 += 2) {
#pragma unroll
      for (int par = 0; par < 2; ++par) {
        const int t = t2 + par;
        if (t + 2 < nt) { const int tn = t + 2; const int rown = tn < s0_tiles ? s0_row + 64 * tn : s1_row + 64 * (tn - s0_tiles); attn_stage_load<DK>(kr[par], vr[par], K1, ldk1, K2, ldk2, V, ldv, rown, tid); }
        LAS unsigned char* kb = lds + par * BUF; LAS unsigned char* vb = kb + KBYTES;
        f32x4 s[2][2];
        constexpr int KQB = (KS <= 4) ? 2 : 1;
        bf16x8 kq[KQB][KS];
#define ATT_LOADK(blk, dst) _Pragma("unroll") for (int ks = 0; ks < KS; ++ks) dst[ks] = *(const LAS bf16x8*)(kb + ((blk) * KS + ks) * 1024 + koff)
        if (KQB == 2) { ATT_LOADK(0, kq[0]); }
#pragma unroll
        for (int bq = 0; bq < 4; ++bq) {
            if (KQB == 2) { if (bq < 3) { ATT_LOADK(bq + 1, kq[(bq + 1) & (KQB - 1)]); } } else { ATT_LOADK(bq, kq[0]); }
            __builtin_amdgcn_sched_barrier(0);
            f32x4 acc = (f32x4){0.f, 0.f, 0.f, 0.f};
#pragma unroll
            for (int ks = 0; ks < KS; ++ks) acc = __builtin_amdgcn_mfma_f32_16x16x32_bf16(kq[bq & (KQB - 1)][ks], qf[ks], acc, 0, 0, 0);
            s[bq >> 1][bq & 1] = acc;
            __builtin_amdgcn_sched_barrier(0);
        }
#undef ATT_LOADK
        bf16x8 vq[1][8];
#define ATT_LOADV(kh_, dst) _Pragma("unroll") for (int d = 0; d < 8; ++d) { \
            const s16x4 v0_ = __builtin_bit_cast(s16x4, __builtin_amdgcn_ds_read_tr16_b64_v4i16((LAS v4i16_t*)(vb + (kh_) * 8192 + voff[0] + 16u * ((unsigned)(2 * d + (p >> 1)) ^ vsw[0])))); \
            const s16x4 v1_ = __builtin_bit_cast(s16x4, __builtin_amdgcn_ds_read_tr16_b64_v4i16((LAS v4i16_t*)(vb + (kh_) * 8192 + voff[1] + 16u * ((unsigned)(2 * d + (p >> 1)) ^ vsw[1])))); \
            dst[d] = (bf16x8){v0_.x, v0_.y, v0_.z, v0_.w, v1_.x, v1_.y, v1_.z, v1_.w}; }
        if (KS <= 4) { ATT_LOADV(0, vq[0]); }
        __builtin_amdgcn_sched_barrier(0);
        if (masked && t < s0_tiles) { const int kp = kpos0 + 64 * t + 8 * g;
#pragma unroll
            for (int kh = 0; kh < 2; ++kh)
#pragma unroll
                for (int hi = 0; hi < 2; ++hi)
#pragma unroll
                    for (int e = 0; e < 4; ++e) { const int d = tq - (kp + 32 * kh + 4 * hi + e); if (d > 128 || d < -128) s[kh][hi][e] = -1e30f; } }
        float tm = fmaxf(fmaxf(fmaxf(s[0][0].x, s[0][0].y), fmaxf(s[0][0].z, s[0][0].w)), fmaxf(fmaxf(s[0][1].x, s[0][1].y), fmaxf(s[0][1].z, s[0][1].w)));
        tm = fmaxf(tm, fmaxf(fmaxf(fmaxf(s[1][0].x, s[1][0].y), fmaxf(s[1][0].z, s[1][0].w)), fmaxf(fmaxf(s[1][1].x, s[1][1].y), fmaxf(s[1][1].z, s[1][1].w))));
        tm = fmaxf(tm, shx(tm, 16, lane)); tm = fmaxf(tm, shx(tm, 32, lane));
        const float mnew = fmaxf(mrun, tm), alpha = __builtin_amdgcn_exp2f(mrun - mnew); mrun = mnew;
        float ps = 0.f; bf16x8 pf[2];
#pragma unroll
        for (int kh = 0; kh < 2; ++kh) { float pv[8];
#pragma unroll
            for (int hi = 0; hi < 2; ++hi)
#pragma unroll
                for (int e = 0; e < 4; ++e) { const float pe = __builtin_amdgcn_exp2f(s[kh][hi][e] - mnew); pv[hi * 4 + e] = pe; ps += pe; }
            u32x4 w; w.x = cvtpk(pv[0], pv[1]); w.y = cvtpk(pv[2], pv[3]); w.z = cvtpk(pv[4], pv[5]); w.w = cvtpk(pv[6], pv[7]); pf[kh] = __builtin_bit_cast(bf16x8, w); }
        lsum = lsum * alpha + ps;
#pragma unroll
        for (int d = 0; d < 8; ++d) o[d] = o[d] * alpha;
        if (KS > 4) { ATT_LOADV(0, vq[0]); __builtin_amdgcn_sched_barrier(0); }
#pragma unroll
        for (int d = 0; d < 8; ++d) o[d] = __builtin_amdgcn_mfma_f32_16x16x32_bf16(vq[0][d], pf[0], o[d], 0, 0, 0);
        __builtin_amdgcn_sched_barrier(0);
        ATT_LOADV(1, vq[0]);
        __builtin_amdgcn_sched_barrier(0);
#pragma unroll
        for (int d = 0; d < 8; ++d) o[d] = __builtin_amdgcn_mfma_f32_16x16x32_bf16(vq[0][d], pf[1], o[d], 0, 0, 0);
#undef ATT_LOADV
        if (t + 1 < nt) attn_stage_store<DK>(lds + (1 - par) * BUF, lds + (1 - par) * BUF + KBYTES, kr[1 - par], vr[1 - par], tid);
        asm volatile("s_waitcnt lgkmcnt(0)" ::: "memory"); __builtin_amdgcn_s_barrier();
      }
    }
    lsum += shx(lsum, 16, lane); lsum += shx(lsum, 32, lane);
    const float inv = 1.f / lsum;
    const int lane_e = tid_now(wave) & 63;
    bf16* op = O + (unsigned)((16 * wave + (lane_e & 15)) * ldo + 4 * (lane_e >> 4));
#pragma unroll
    for (int d = 0; d < 8; ++d) { u32x2 w; w.x = cvtpk(o[d].x * inv, o[d].y * inv); w.y = cvtpk(o[d].z * inv, o[d].w * inv); *(u32x2*)(op + 16 * d) = w; }
}
__device__ __forceinline__ void job_attn_c(ArgP a, int l, LAS unsigned char* lds, int wave, int u_first, int u_end, int u_stride) {
    const int tid = tid_now(wave); unsigned char* ws = a->ws;
    const bf16* Q = (const bf16*)(ws + WS_QC); const bf16* K = (const bf16*)(ws + WS_KC) + (size_t)l * MKV * 256; const bf16* V = (const bf16*)(ws + WS_VC) + (size_t)l * MKV * 256;
    bf16* O = (bf16*)(ws + WS_OC);
    for (int u = u_first; u < u_end; u += u_stride) {
        int h, m0, s0r, s0t, s1r, s1t, qp, kp; bool mk;
        if (u < 256) { const int b = u >> 6, qb = u & 7; h = (u >> 3) & 7; const int lo = qb * 128 - 128 < 0 ? 0 : qb * 128 - 128, hi = qb * 128 + 256 > 1024 ? 1024 : qb * 128 + 256;
            m0 = MC + b * 1024 + qb * 128; s0r = MC + b * 1024 + lo; s0t = (hi - lo) >> 6; s1r = MT + b * 256; s1t = 4; mk = true; qp = qb * 128; kp = lo; }
        else { const int v = u - 256, b = v >> 4, qb = v & 1; h = (v >> 1) & 7; m0 = b * 256 + qb * 128; s0r = b * 256; s0t = 4; s1r = 0; s1t = 0; mk = false; qp = 0; kp = 0; }
        const int kg = h >> 2;
        attn_unit<128>(lds, wave, tid, Q + (size_t)m0 * 1024 + h * 128, 1024, K + kg * 128, 256, nullptr, 0, V + kg * 128, 256, s0r, s0t, s1r, s1t, mk, qp, kp,
                       a->in[22][l * 8 + h] * LOG2E, true, O + (size_t)m0 * 1024 + h * 128, 1024);
    }
}
__device__ __forceinline__ void job_attn_b(ArgP a, int l, LAS unsigned char* lds, int wave) {
    const int tid = tid_now(wave); unsigned char* ws = a->ws;
    const bf16* Q = (const bf16*)(ws + WS_QF); const bf16* KV = (const bf16*)(ws + WS_KV); const bf16* KR = (const bf16*)(ws + WS_KR) + (size_t)l * MKV * 64;
    bf16* O = (bf16*)(ws + WS_OBB);
    for (int u = blockIdx.x; u < 512; u += gridDim.x) {
        int h, m0, s0r, s0t, s1r, s1t;
        if (u < 256) { const int b = u >> 6, qb = u & 7; h = (u >> 3) & 7; m0 = MC + b * 1024 + qb * 128; s0r = MC + b * 1024; s0t = 16; s1r = MT + b * 256; s1t = 4; }
        else { const int v = u - 256, b = v >> 4, qb = v & 1; h = (v >> 1) & 7; m0 = b * 256 + qb * 128; s0r = b * 256; s0t = 4; s1r = 0; s1t = 0; }
        attn_unit<192>(lds, wave, tid, Q + (size_t)m0 * 1536 + h * 192, 1536, KV + h * 128, 2048, KR, 64, KV + 1024 + h * 128, 2048, s0r, s0t, s1r, s1t, false, 0, 0, 0.f, false,
                       O + (size_t)m0 * 1024 + h * 128, 1024);
    }
}
constexpr int SC_QG = 0, SC_KG = 8192, SC_KD = 16384, SC_VV = 24576, SC_EL = 32768, SC_SEG = 33280, SC_BUF = 38912;
__device__ __forceinline__ bf16x8 tr2(LAS unsigned char* p0, LAS unsigned char* p1) {
    const s16x4 v0 = __builtin_bit_cast(s16x4, __builtin_amdgcn_ds_read_tr16_b64_v4i16((LAS v4i16_t*)p0));
    const s16x4 v1 = __builtin_bit_cast(s16x4, __builtin_amdgcn_ds_read_tr16_b64_v4i16((LAS v4i16_t*)p1));
    return (bf16x8){v0.x, v0.y, v0.z, v0.w, v1.x, v1.y, v1.z, v1.w};
}
struct ScanRegs { unsigned lg[4]; unsigned qv[4]; u32x4 vv; };
__device__ __forceinline__ void scan_stage_load(ScanRegs& R, const bf16* LG, const bf16* KK, const bf16* QA, const bf16* VA, int m0, int n, int dir, int h, int c, int wave, int lane, int tid) {
#pragma unroll
    for (int tt = 0; tt < 4; ++tt) { const int j = 32 * c + 4 * wave + tt; const size_t m = m0 + (dir ? n - 1 - j : j);
        R.lg[tt] = *(const unsigned*)(LG + m * 2048 + dir * 1024 + h * 128 + 2 * lane);
        R.qv[tt] = *(const unsigned*)(QA + m * 1024 + h * 128 + 2 * lane); }
    { const int j = 32 * c + (tid >> 4); const size_t m = m0 + (dir ? n - 1 - j : j); R.vv = *(const u32x4*)(VA + m * 1024 + h * 128 + (tid & 15) * 8); }
}
__device__ __forceinline__ void scan_stage_finish(const ScanRegs& R, LAS unsigned char* buf, int wave, int lane, int tid) {
    f32x2 cs[4]; cs[0] = (f32x2){bf_lo(R.lg[0]), bf_hi(R.lg[0])}; cs[1] = cs[0] + (f32x2){bf_lo(R.lg[1]), bf_hi(R.lg[1])}; cs[2] = cs[1] + (f32x2){bf_lo(R.lg[2]), bf_hi(R.lg[2])}; cs[3] = cs[2] + (f32x2){bf_lo(R.lg[3]), bf_hi(R.lg[3])};
    LAS f32x2* SEG = (LAS f32x2*)(buf + SC_SEG);
    SEG[wave * 64 + lane] = cs[3];
    asm volatile("s_waitcnt lgkmcnt(0)" ::: "memory"); __builtin_amdgcn_s_barrier();
    f32x2 pre = (f32x2){0.f, 0.f}, tot = (f32x2){0.f, 0.f};
#pragma unroll
    for (int s = 0; s < 8; ++s) { const f32x2 v = SEG[s * 64 + lane]; tot += v; if (s < wave) pre += v; }
#pragma unroll
    for (int tt = 0; tt < 4; ++tt) { const int j = 4 * wave + tt; const f32x2 G = pre + cs[tt];
        const float e0 = __expf(G.x), e1 = __expf(G.y), i0 = __expf(fminf(-G.x, 80.f)), i1 = __expf(fminf(-G.y, 80.f)), d0 = __expf(tot.x - G.x), d1 = __expf(tot.y - G.y);
        const float k0 = 1.f - __expf(bf_lo(R.lg[tt])), k1 = 1.f - __expf(bf_hi(R.lg[tt])), q0 = bf_lo(R.qv[tt]), q1 = bf_hi(R.qv[tt]);
        const unsigned o = offb((unsigned)j, (unsigned)(lane >> 2)) + 4u * (unsigned)(lane & 3);
        *(LAS unsigned*)(buf + SC_QG + o) = cvtpk(q0 * e0, q1 * e1);
        *(LAS unsigned*)(buf + SC_KG + o) = cvtpk(k0 * i0, k1 * i1);
        *(LAS unsigned*)(buf + SC_KD + o) = cvtpk(k0 * d0, k1 * d1); }
    *(LAS u32x4*)(buf + SC_VV + offb((unsigned)(tid >> 4), (unsigned)(tid & 15))) = R.vv;
    if (wave == 0) ((LAS f32x2*)(buf + SC_EL))[lane] = (f32x2){__expf(tot.x), __expf(tot.y)};
    asm volatile("s_waitcnt lgkmcnt(0)" ::: "memory"); __builtin_amdgcn_s_barrier();
}
__device__ __forceinline__ void scan_item(ArgP a, int l, int item, LAS unsigned char* lds, int wave, int tid) {
    const int lane = tid & 63, g = lane >> 4, i = lane & 15, q = i >> 2, p = i & 3;
    const int dir = item & 1, h = (item >> 1) & 7, sq = item >> 4;
    const bool lat = sq >= 16; const int n = lat ? 1024 : 256; const int m0 = lat ? MC + (sq - 16) * 1024 : sq * 256; const int nc = n >> 5;
    unsigned char* ws = a->ws;
    const bf16* QA = (const bf16*)(ws + WS_QA); const bf16* KK = (const bf16*)(ws + WS_KK); const bf16* VA = (const bf16*)(ws + WS_VA); const bf16* LG = (const bf16*)(ws + WS_LG);
    bf16* OO = (bf16*)(ws + (dir ? WS_OB : WS_OF));
    f32x4 S[8];
    if (lat) { const float* s0 = a->in[2] + ((((size_t)(sq - 16) * 4 + l) * 2 + dir) * 8 + h) * 16384 + 16 * wave + i;
#pragma unroll
        for (int aa = 0; aa < 8; ++aa)
#pragma unroll
            for (int e = 0; e < 4; ++e) S[aa][e] = s0[(16 * aa + 4 * g + e) * 128]; }
    else {
#pragma unroll
        for (int aa = 0; aa < 8; ++aa) S[aa] = (f32x4){0.f, 0.f, 0.f, 0.f}; }
    ScanRegs R0, R1;
    scan_stage_load(R0, LG, KK, QA, VA, m0, n, dir, h, 0, wave, lane, tid);
    scan_stage_load(R1, LG, KK, QA, VA, m0, n, dir, h, 1, wave, lane, tid);
    scan_stage_finish(R0, lds, wave, lane, tid);
    unsigned rro[2][4];
#pragma unroll
    for (int b = 0; b < 2; ++b)
#pragma unroll
        for (int ks = 0; ks < 4; ++ks) rro[b][ks] = offb((unsigned)(16 * b + i), (unsigned)(4 * ks + g));
    for (int c2 = 0; c2 < nc; c2 += 2) {
#pragma unroll
      for (int par = 0; par < 2; ++par) {
        const int c = c2 + par;
        const bool more = c + 1 < nc;
        if (c + 2 < nc) { if (par == 0) scan_stage_load(R0, LG, KK, QA, VA, m0, n, dir, h, c + 2, wave, lane, tid); else scan_stage_load(R1, LG, KK, QA, VA, m0, n, dir, h, c + 2, wave, lane, tid); }
        LAS unsigned char* buf = lds + par * SC_BUF;
        f32x4 at[2][2];
#pragma unroll
        for (int sb = 0; sb < 2; ++sb)
#pragma unroll
            for (int tb = 0; tb < 2; ++tb) at[sb][tb] = (f32x4){0.f, 0.f, 0.f, 0.f};
        { bf16x8 kf[4][2], qf[4][2];
#pragma unroll
          for (int ks = 0; ks < 4; ++ks)
#pragma unroll
              for (int b = 0; b < 2; ++b) { kf[ks][b] = *(const LAS bf16x8*)(buf + SC_KG + rro[b][ks]); qf[ks][b] = *(const LAS bf16x8*)(buf + SC_QG + rro[b][ks]); }
          __builtin_amdgcn_sched_barrier(0);
#pragma unroll
          for (int ks = 0; ks < 4; ++ks)
#pragma unroll
              for (int sb = 0; sb < 2; ++sb)
#pragma unroll
                  for (int tb = 0; tb < 2; ++tb) at[sb][tb] = __builtin_amdgcn_mfma_f32_16x16x32_bf16(kf[ks][sb], qf[ks][tb], at[sb][tb], 0, 0, 0); }
        bf16x8 pb[2];
#pragma unroll
        for (int tb = 0; tb < 2; ++tb) { float v[8];
#pragma unroll
            for (int sb = 0; sb < 2; ++sb)
#pragma unroll
                for (int e = 0; e < 4; ++e) v[sb * 4 + e] = (16 * sb + 4 * g + e > 16 * tb + i) ? 0.f : at[sb][tb][e];
            u32x4 w; w.x = cvtpk(v[0], v[1]); w.y = cvtpk(v[2], v[3]); w.z = cvtpk(v[4], v[5]); w.w = cvtpk(v[6], v[7]); pb[tb] = __builtin_bit_cast(bf16x8, w); }
        f32x4 ot[2];
        u32x4 qb[4][2];
        const bf16x8 vfi = tr2(buf + SC_VV + offb((unsigned)(4 * g + q), (unsigned)(2 * wave + (p >> 1))) + 8 * (p & 1), buf + SC_VV + offb((unsigned)(16 + 4 * g + q), (unsigned)(2 * wave + (p >> 1))) + 8 * (p & 1));
#pragma unroll
        for (int ks = 0; ks < 4; ++ks)
#pragma unroll
            for (int tb = 0; tb < 2; ++tb) {
                const u32x2 b0 = *(const LAS u32x2*)(buf + SC_QG + offb((unsigned)(16 * tb + i), (unsigned)(4 * ks + (g >> 1))) + 8 * (g & 1));
                const u32x2 b1 = *(const LAS u32x2*)(buf + SC_QG + offb((unsigned)(16 * tb + i), (unsigned)(4 * ks + 2 + (g >> 1))) + 8 * (g & 1));
                qb[ks][tb] = (u32x4){b0.x, b0.y, b1.x, b1.y}; }
        __builtin_amdgcn_sched_barrier(0);
#pragma unroll
        for (int tb = 0; tb < 2; ++tb) ot[tb] = __builtin_amdgcn_mfma_f32_16x16x32_bf16(vfi, pb[tb], (f32x4){0.f, 0.f, 0.f, 0.f}, 0, 0, 0);
#pragma unroll
        for (int ks = 0; ks < 4; ++ks) {
            u32x4 w; w.x = cvtpk(S[2 * ks].x, S[2 * ks].y); w.y = cvtpk(S[2 * ks].z, S[2 * ks].w); w.z = cvtpk(S[2 * ks + 1].x, S[2 * ks + 1].y); w.w = cvtpk(S[2 * ks + 1].z, S[2 * ks + 1].w);
            const bf16x8 sa = __builtin_bit_cast(bf16x8, w);
#pragma unroll
            for (int tb = 0; tb < 2; ++tb) ot[tb] = __builtin_amdgcn_mfma_f32_16x16x32_bf16(sa, __builtin_bit_cast(bf16x8, qb[ks][tb]), ot[tb], 0, 0, 0); }
        bf16x8 kdf[8]; f32x4 el[8];
        const bf16x8 vfu = tr2(buf + SC_VV + offb((unsigned)(8 * g + q), (unsigned)(2 * wave + (p >> 1))) + 8 * (p & 1), buf + SC_VV + offb((unsigned)(8 * g + 4 + q), (unsigned)(2 * wave + (p >> 1))) + 8 * (p & 1));
#pragma unroll
        for (int aa = 0; aa < 8; ++aa) { el[aa] = *(const LAS f32x4*)(buf + SC_EL + (16 * aa + 4 * g) * 4);
            kdf[aa] = tr2(buf + SC_KD + offb((unsigned)(8 * g + q), (unsigned)(2 * aa + (p >> 1))) + 8 * (p & 1), buf + SC_KD + offb((unsigned)(8 * g + 4 + q), (unsigned)(2 * aa + (p >> 1))) + 8 * (p & 1)); }
        __builtin_amdgcn_sched_barrier(0);
#pragma unroll
        for (int tb = 0; tb < 2; ++tb) { const int j = 32 * c + 16 * tb + i; const size_t m = m0 + (dir ? n - 1 - j : j);
            u32x2 w2; w2.x = cvtpk(ot[tb].x, ot[tb].y); w2.y = cvtpk(ot[tb].z, ot[tb].w); *(u32x2*)(OO + m * 1024 + h * 128 + 16 * wave + 4 * g) = w2; }
#pragma unroll
        for (int aa = 0; aa < 8; ++aa) S[aa] = __builtin_amdgcn_mfma_f32_16x16x32_bf16(kdf[aa], vfu, S[aa] * el[aa], 0, 0, 0);
        if (more) { if (par == 0) scan_stage_finish(R1, lds + SC_BUF, wave, lane, tid); else scan_stage_finish(R0, lds, wave, lane, tid); }
      }
    }
    if (!lat) { float* so = a->out + OUT_ST + ((((size_t)sq * 4 + l) * 2 + dir) * 8 + h) * 16384 + 16 * wave + i;
#pragma unroll
        for (int aa = 0; aa < 8; ++aa)
#pragma unroll
            for (int e = 0; e < 4; ++e) so[(16 * aa + 4 * g + e) * 128] = S[aa][e]; }
    __syncthreads();
}
__device__ __forceinline__ void job_oa_post(ArgP a, int l, int wave) {
    const int tidn = tid_now(wave), lane = tidn & 63;
    const int gw = blockIdx.x * 8 + wave, NGW = gridDim.x * 8;
    const bf16* OF = (const bf16*)(a->ws + WS_OF); const bf16* OB = (const bf16*)(a->ws + WS_OB); const bf16* AG = (const bf16*)(a->ws + WS_AG); bf16* O = (bf16*)(a->ws + WS_OA);
    const float* gn = a->in[17] + l * 128 + (lane & 7) * 16;
    for (int m = gw; m < MT; m += NGW) {
        const size_t o = (size_t)m * 1024 + lane * 16; f32x4 v[4]; float s = 0.f;
#pragma unroll
        for (int j = 0; j < 4; ++j) { const u32x2 fa = *(const u32x2*)(OF + o + 4 * j), fb = *(const u32x2*)(OB + o + 4 * j); v[j] = (f32x4){bf_lo(fa.x) + bf_lo(fb.x), bf_hi(fa.x) + bf_hi(fb.x), bf_lo(fa.y) + bf_lo(fb.y), bf_hi(fa.y) + bf_hi(fb.y)}; s += (v[j].x * v[j].x + v[j].y * v[j].y) + (v[j].z * v[j].z + v[j].w * v[j].w); }
        s += shx(s, 1, lane); s += shx(s, 2, lane); s += shx(s, 4, lane);
        const float rs = rsq_(s * (1.f / 128.f) + EPS);
        const u32x4 g0 = *(const u32x4*)(AG + o), g1 = *(const u32x4*)(AG + o + 8);
        const unsigned gg[8] = {g0.x, g0.y, g0.z, g0.w, g1.x, g1.y, g1.z, g1.w};
        unsigned ow[8];
#pragma unroll
        for (int j = 0; j < 4; ++j) { const f32x4 w = *(const f32x4*)(gn + 4 * j); const f32x4 r = v[j] * rs * w;
            ow[2 * j] = pk2(r.x * bf_lo(gg[2 * j]), r.y * bf_hi(gg[2 * j])); ow[2 * j + 1] = pk2(r.z * bf_lo(gg[2 * j + 1]), r.w * bf_hi(gg[2 * j + 1])); }
        *(u32x4*)(O + o) = (u32x4){ow[0], ow[1], ow[2], ow[3]}; *(u32x4*)(O + o + 8) = (u32x4){ow[4], ow[5], ow[6], ow[7]};
    }
}
constexpr int PH_PER_LAYER = 7, PH_PRE = 3, PH_TOTAL = PH_PRE + NL * PH_PER_LAYER;
__global__ void __launch_bounds__(512, 2) mega(Args args) {
    extern __shared__ __attribute__((aligned(16))) unsigned char lds_raw[];
    LAS unsigned char* lds = (LAS unsigned char*)lds_raw;
    const int tid = threadIdx.x, lane = tid & 63, wave = __builtin_amdgcn_readfirstlane(tid >> 6);
    volatile LAS unsigned* MISC = (volatile LAS unsigned*)(lds + MISC_OFF);
    for (int u = tid; u < (LDS_BYTES - LDSCTL_OFF) / 4; u += 512) ((LAS unsigned*)(lds + LDSCTL_OFF))[u] = 0u;
    __syncthreads();
    unsigned* barw = (unsigned*)(args.ws + WS_CTL) + CW_BAR;
    XcdBarrier bar; bar.bar = barw; bar.x = 0; bar.st = nullptr;
    if (args.use_bar) bar = xcd_barrier_post(barw, MISC + 8);
    const int lo = args.ph_lo, hi = args.ph_hi;
#ifndef PHMASK
#define PHMASK 0xFFFF
#endif
#define EN(j) ((PHMASK >> (j)) & 1)
#ifndef P2MASK
#define P2MASK 0xFF
#endif
#define P2EN(j) ((P2MASK >> (j)) & 1)
#ifndef DUPMASK
#define DUPMASK 0
#endif
#define REP(j) for (int rep_ = 0; rep_ < 1 + ((DUPMASK >> (j)) & 1); ++rep_)
#define IN(k) (lo <= (k) && (k) < hi)
#define SEAM(k) do { if (IN((k) + 1)) xcd_barrier(bar); } while (0)
    const int G = gridDim.x, bx = blockIdx.x;
#define LAUNDER(p) asm volatile("" : "+s"(p))

    if (EN(0) && IN(0)) { ArgP ap = (ArgP)__builtin_amdgcn_kernarg_segment_ptr(); LAUNDER(ap); REP(0) { phase_prologue(ap, lds, wave); } SEAM(0); }
    if (EN(1) && IN(1)) { ArgP ap = (ArgP)__builtin_amdgcn_kernarg_segment_ptr(); LAUNDER(ap); REP(1) { phase_modreduce(ap, wave); } SEAM(1); }
    if (EN(2) && IN(2)) { ArgP ap = (ArgP)__builtin_amdgcn_kernarg_segment_ptr(); LAUNDER(ap); REP(2) { phase_h0(ap, wave); } SEAM(2); }

    for (int l = 0; l < NL; ++l) {
        const int pb = PH_PRE + l * PH_PER_LAYER;
        if (EN(3) && IN(pb + 0)) { ArgP ap = (ArgP)__builtin_amdgcn_kernarg_segment_ptr(); LAUNDER(ap); unsigned char* ws = ap->ws; unsigned char* wl = ws + WS_W + (size_t)l * WL_STRIDE; float* outp = ap->out; REP(3) {
            pg8::Gemm g{(const bf16*)(ws + WS_H), (const bf16*)(wl + WO_IN), MT, NINP, D, D, nullptr, nullptr, nullptr, nullptr}; int bxl = bx, Gl = G; asm volatile("" : "+s"(bxl), "+s"(Gl)); pg8::StaticOrder S; S.init(MT, NINP, Gl, bxl);
            EpiWin E{ws, outp, l}; pg8::gemm_phase(lds, g, S, E, wave);
            }
            SEAM(pb + 0);
        }
        if (EN(4) && IN(pb + 1)) { ArgP ap = (ArgP)__builtin_amdgcn_kernarg_segment_ptr(); LAUNDER(ap); unsigned char* ws = ap->ws; unsigned char* wl = ws + WS_W + (size_t)l * WL_STRIDE; float* outp = ap->out; REP(4) {
            if (bx >= 64) { const int cb = bx - 64, GB = G - 64;
                if (P2EN(0)) { pg8::Gemm g{(const bf16*)(ws + WS_BQ), (const bf16*)(wl + WO_UQ), MT, 1536, 512, 512, nullptr, nullptr, nullptr, nullptr}; pg8::StaticOrder S; S.init(MT, 1536, GB, cb); EpiUq E{ws}; pg8::gemm_phase(lds, g, S, E, wave); }
                LAUNDER(ap); ws = ap->ws; wl = ws + WS_W + (size_t)l * WL_STRIDE;
                if (P2EN(1)) { pg8::Gemm g{(const bf16*)(ws + WS_BKV) + (size_t)l * MKV * 256, (const bf16*)(wl + WO_UKV), MKV, 2048, 256, 256, nullptr, nullptr, nullptr, nullptr}; pg8::StaticOrder S; S.init(MKV, 2048, GB, cb); EpiKv E{ws}; pg8::gemm_phase(lds, g, S, E, wave); }
                __syncthreads();
                LAUNDER(ap);
                if (P2EN(3)) { scan_item(ap, l, cb, lds, wave, tid_now(wave)); if (cb >= 96 && cb < 160) scan_item(ap, l, 192 + (cb - 96), lds, wave, tid_now(wave)); }
                __syncthreads();
                LAUNDER(ap);
            } else {
                if (P2EN(3)) scan_item(ap, l, 256 + bx, lds, wave, tid_now(wave));
            }
            __syncthreads();
            LAUNDER(ap);
            if (P2EN(2) && rep_ == 0) job_ckv_norm(ap, l, wave);
            }
            SEAM(pb + 1);
        }
        if (EN(5) && IN(pb + 2)) { ArgP ap = (ArgP)__builtin_amdgcn_kernarg_segment_ptr(); LAUNDER(ap); unsigned char* ws = ap->ws; unsigned char* wl = ws + WS_W + (size_t)l * WL_STRIDE; float* outp = ap->out; REP(5) {
            job_attn_c(ap, l, lds, wave, bx, 512, G);
            LAUNDER(ap);
            job_attn_b(ap, l, lds, wave);
            LAUNDER(ap);
            job_oa_post(ap, l, wave);
            }
            SEAM(pb + 2);
        }
        if (EN(6) && IN(pb + 3)) { ArgP ap = (ArgP)__builtin_amdgcn_kernarg_segment_ptr(); LAUNDER(ap); unsigned char* ws = ap->ws; unsigned char* wl = ws + WS_W + (size_t)l * WL_STRIDE; float* outp = ap->out; REP(6) {
            pg8::StaticOrder S; S.init(MT, D, G, bx);
            { pg8::Gemm g{(const bf16*)(ws + WS_OA), (const bf16*)(wl + WO_A), MT, D, 1024, 1024, (const bf16*)(ws + WS_OBB), (const bf16*)(wl + WO_B), (const bf16*)(ws + WS_OC), (const bf16*)(wl + WO_C)}; EpiBranch E{ws}; pg8::gemm_phase(lds, g, S, E, wave); }
            }
            SEAM(pb + 3);
        }
        if (EN(7) && IN(pb + 4)) { ArgP ap = (ArgP)__builtin_amdgcn_kernarg_segment_ptr(); LAUNDER(ap); unsigned char* ws = ap->ws; unsigned char* wl = ws + WS_W + (size_t)l * WL_STRIDE; float* outp = ap->out;
            pg8::Gemm g{(const bf16*)(ws + WS_MG), (const bf16*)(wl + WO_O), MT, D, D, D, nullptr, nullptr, nullptr, nullptr}; pg8::StaticOrder S; S.init(MT, D, G, bx);
            const float* x0 = (l == 0) ? ap->in[0] : outp; const float* x1 = (l == 0) ? ap->in[1] : outp + (size_t)MC * D;
            if (l == 0) { EpiResid<0, true> E{ws, outp, x0, x1, ap->in[12] + l * D, ap->in[13] + l * D, l, 1}; pg8::gemm_phase(lds, g, S, E, wave); }
            else { EpiResid<0, false> E{ws, outp, x0, x1, ap->in[12] + l * D, ap->in[13] + l * D, l, 1}; pg8::gemm_phase(lds, g, S, E, wave); }
            SEAM(pb + 4);
        }
        if (EN(9) && IN(pb + 5)) { ArgP ap = (ArgP)__builtin_amdgcn_kernarg_segment_ptr(); LAUNDER(ap); unsigned char* ws = ap->ws; unsigned char* wl = ws + WS_W + (size_t)l * WL_STRIDE; float* outp = ap->out; REP(9) {
            pg8::Gemm g{(const bf16*)(ws + WS_H), (const bf16*)(wl + WO_UP), MT, NUP, D, D, nullptr, nullptr, nullptr, nullptr}; pg8::SplitOrder S; S.init(MT, NUP, G, bx);
            EpiUp E{ws, ap->in[28] + (size_t)l * 3 * NUP, lds + HALO_OFF, l}; pg8::gemm_phase(lds, g, S, E, wave);
            }
            SEAM(pb + 5);
        }
        if (EN(11) && IN(pb + 6)) { ArgP ap = (ArgP)__builtin_amdgcn_kernarg_segment_ptr(); LAUNDER(ap); unsigned char* ws = ap->ws; unsigned char* wl = ws + WS_W + (size_t)l * WL_STRIDE; float* outp = ap->out;
            pg8::Gemm g{(const bf16*)(ws + WS_ACT), (const bf16*)(wl + WO_DN), MT, D, DFF, DFF, nullptr, nullptr, nullptr, nullptr}; pg8::StaticOrder S; S.init(MT, D, G, bx);
            { Unit u0; if (S.next(0, u0)) conv_fixup(ap, l, u0.pm, wave); }
            LAUNDER(ap); ws = ap->ws; wl = ws + WS_W + (size_t)l * WL_STRIDE; outp = ap->out;
            const int nx = (l < NL - 1) ? 1 : 0;
            EpiResid<1, false> E{ws, outp, outp, outp + (size_t)MC * D, ap->in[14] + l * D, ap->in[11] + (nx ? l + 1 : l) * D, l, nx}; pg8::gemm_phase(lds, g, S, E, wave);
            if (l < NL - 1) SEAM(pb + 6);
        }
    }
#undef IN
#undef SEAM
}

extern "C" void kernel_launch(void* const* d_in, const int* in_sizes, int n_in, void* d_out, int out_size, void* d_ws, size_t ws_size, hipStream_t stream) {
    static int grid = 0;
    if (grid == 0) {
        if (n_in != 30 || (size_t)out_size != OUT_END || ws_size < WS_END) { fprintf(stderr, "kernel_launch: unexpected sizes n_in %d out %d ws %zu\n", n_in, out_size, ws_size); grid = -1; return; }
        int dev = 0, cus = 0, per_cu = 0;
        if (hipGetDevice(&dev) != hipSuccess || hipDeviceGetAttribute(&cus, hipDeviceAttributeMultiprocessorCount, dev) != hipSuccess) { grid = -1; return; }
        if (hipFuncSetAttribute((const void*)mega, hipFuncAttributeMaxDynamicSharedMemorySize, LDS_BYTES) != hipSuccess) { fprintf(stderr, "kernel_launch: hipFuncSetAttribute failed\n"); grid = -1; return; }
        if (hipOccupancyMaxActiveBlocksPerMultiprocessor(&per_cu, (const void*)mega, 512, LDS_BYTES) != hipSuccess || per_cu < 1) fprintf(stderr, "kernel_launch: occupancy query reports %d\n", per_cu);
        (void)hipGetLastError();
        grid = cus;
    }
    if (grid < 0) return;
    (void)hipMemsetAsync((char*)d_ws + WS_CTL, 0, CTL_ZERO_BYTES, stream);
    Args a{};
    for (int i = 0; i < 30; ++i) a.in[i] = (const float*)d_in[i];
    a.out = (float*)d_out; a.ws = (unsigned char*)d_ws; a.pad = 0;
#if MK_ONE_LAUNCH
    a.ph_lo = 0; a.ph_hi = PH_TOTAL; a.use_bar = 1;
    hipLaunchKernelGGL(mega, dim3(grid), dim3(512), LDS_BYTES, stream, a);
#else
    a.use_bar = 0;
    for (int p = 0; p < PH_TOTAL; ++p) { a.ph_lo = p; a.ph_hi = p + 1; hipLaunchKernelGGL(mega, dim3(grid), dim3(512), LDS_BYTES, stream, a); }
#endif
}
```

```cpp
#include <hip/hip_runtime.h>
#include <cstdio>
#include <cstdint>

#ifndef MK_ONE_LAUNCH
#define MK_ONE_LAUNCH 1
#endif

#define GAS __attribute__((address_space(1)))
#define LAS __attribute__((address_space(3)))
typedef unsigned short bf16;
typedef short bf16x8 __attribute__((ext_vector_type(8)));
typedef float f32x4 __attribute__((ext_vector_type(4)));
typedef float f32x2 __attribute__((ext_vector_type(2)));
typedef unsigned u32x4 __attribute__((ext_vector_type(4)));
typedef unsigned u32x2 __attribute__((ext_vector_type(2)));
typedef GAS unsigned gu32;

constexpr int D = 2048, NL = 4, MC = 4096, MT = 8192, MKV = 9216;
constexpr int NIN = 13632, NINP = 13824, DFF = 5504, NUP = 11008;
constexpr float EPS = 1e-6f;
constexpr float SCALE_B = 0.07216878364870322f;
constexpr float SCALE_C = 0.08838834764831845f;

constexpr size_t OUT_Y = 0, OUT_ST = 16777216, OUT_CKV = OUT_ST + 16777216, OUT_KR = OUT_CKV + 4194304, OUT_K = OUT_KR + 1048576, OUT_V = OUT_K + 4194304, OUT_END = OUT_V + 4194304;

constexpr size_t MiB = 1u << 20;
constexpr size_t WS_CTL = 0, CTL_ZERO_BYTES = 1 * MiB;
constexpr size_t WS_MODP = 2 * MiB;
constexpr size_t WS_MOD = 18 * MiB;
constexpr size_t WS_LB = 19 * MiB;
constexpr size_t WS_ROPE = 19 * MiB + 512 * 1024;
constexpr size_t WS_SSQQ = 20 * MiB;
constexpr size_t WS_SSQKV = 20 * MiB + 512 * 1024;
constexpr size_t WS_SSQX = 21 * MiB;
constexpr size_t WS_XCH = 21 * MiB + 512 * 1024;
constexpr size_t WS_CV1 = 22 * MiB;
constexpr size_t WS_CV2 = 24 * MiB;
constexpr size_t WS_W = 32 * MiB, WL_STRIDE = 141 * MiB;
constexpr size_t WO_IN = 0, WO_UQ = 54 * MiB, WO_UKV = WO_UQ + 3 * MiB / 2, WO_A = WO_UKV + 1 * MiB, WO_B = WO_A + 4 * MiB, WO_C = WO_B + 4 * MiB, WO_O = WO_C + 4 * MiB, WO_UP = WO_O + 8 * MiB, WO_DN = WO_UP + 43 * MiB;
static_assert(WO_DN + (size_t)2048 * DFF * 2 <= WL_STRIDE, "weights per layer");
constexpr size_t WS_BKV = 596 * MiB;
constexpr size_t WS_KR = 614 * MiB;
constexpr size_t WS_KC = 619 * MiB;
constexpr size_t WS_VC = 637 * MiB;
constexpr size_t WS_H = 656 * MiB;
constexpr size_t WS_QA = 688 * MiB;
constexpr size_t WS_LG = 704 * MiB;
constexpr size_t WS_KK = 768 * MiB;
constexpr size_t WS_VA = 800 * MiB;
constexpr size_t WS_AG = 816 * MiB;
constexpr size_t WS_BQ = 832 * MiB;
constexpr size_t WS_QC = 840 * MiB;
constexpr size_t WS_GT = 856 * MiB;
constexpr size_t WS_QF = 952 * MiB;
constexpr size_t WS_KV = 976 * MiB;
constexpr size_t WS_OF = 1012 * MiB;
constexpr size_t WS_OB = 1044 * MiB;
constexpr size_t WS_OA = 1076 * MiB;
constexpr size_t WS_OBB = 1092 * MiB;
constexpr size_t WS_OC = 1108 * MiB;
constexpr size_t WS_MS = 1124 * MiB;
constexpr size_t WS_MG = 1188 * MiB;
constexpr size_t WS_Y = 1220 * MiB;
constexpr size_t WS_HALO = 1220 * MiB;
constexpr size_t WS_U = 688 * MiB;
constexpr size_t WS_ACT = 860 * MiB;
constexpr size_t WS_XB = 1284 * MiB;
constexpr size_t WS_END = 1316 * MiB;
static_assert(WS_U + (size_t)MT * NUP * 2 <= WS_ACT && WS_ACT + (size_t)MT * DFF * 2 <= WS_QF, "ffn overlay");

constexpr int CW_TMO = 0, CW_BAR = 4096, CW_CNT = 16384, CW_SPL = 65536;
constexpr size_t WS_SPL = 704 * MiB;

constexpr int RING_BYTES = 131072, LDSCTL_OFF = RING_BYTES, MISC_OFF = LDSCTL_OFF + 320, HALO_OFF = RING_BYTES + 1024, LDS_BYTES = 147456;

#define RLX_AGENT __ATOMIC_RELAXED, __HIP_MEMORY_SCOPE_AGENT
#define LDS_WAIT() asm volatile("s_waitcnt lgkmcnt(0)" ::: "memory")
#define VM_WAIT() asm volatile("s_waitcnt vmcnt(0)" ::: "memory")
__host__ __device__ __forceinline__ unsigned f2bf(float f) { unsigned u = __builtin_bit_cast(unsigned, f); return (u + 0x7fffu + ((u >> 16) & 1u)) >> 16; }
typedef float f32x2c_t __attribute__((ext_vector_type(2)));
typedef __bf16 bf16x2c_t __attribute__((ext_vector_type(2)));
__device__ __forceinline__ unsigned pk2(float lo, float hi) { const f32x2c_t v = {lo, hi}; const bf16x2c_t b = __builtin_convertvector(v, bf16x2c_t); return __builtin_bit_cast(unsigned, b); }
__device__ __forceinline__ float bf_lo(unsigned u) { return __builtin_bit_cast(float, u << 16); }
__device__ __forceinline__ float bf_hi(unsigned u) { return __builtin_bit_cast(float, u & 0xffff0000u); }
__device__ __forceinline__ float bf2f(bf16 b) { return __builtin_bit_cast(float, (unsigned)b << 16); }
__device__ __forceinline__ float sigmoidf_(float x) { return __builtin_amdgcn_rcpf(1.f + __expf(-x)); }
__device__ __forceinline__ float rsq_(float x) { return __builtin_amdgcn_rsqf(x); }
__device__ __forceinline__ float shx(float v, int mask, int lane) { return __builtin_bit_cast(float, __builtin_amdgcn_ds_bpermute((lane ^ mask) << 2, __builtin_bit_cast(int, v))); }
__device__ __forceinline__ float wave_sum(float v, int lane) {
#pragma unroll
    for (int o = 1; o < 64; o <<= 1) v += shx(v, o, lane);
    return v;
}
__device__ __forceinline__ int tid_now(int wave) { int t; asm volatile("v_mbcnt_lo_u32_b32 %0, -1, 0\n\tv_mbcnt_hi_u32_b32 %0, -1, %0" : "=v"(t)); return wave * 64 + t; }
#define XB_TMO      128
#define XB_XCNT(j)  (256  + 64 * (j))
#define XB_XSUB(j)  (1280 + 64 * (j))
#define XB_XGEN(j)  (2304 + 64 * (j))
#define XB_TOP      3328
#define XB_TOPGEN   3392
#define XCD_BAR_WORDS 3456
#define XB_SPIN_CAP (1u << 22)
__device__ __forceinline__ unsigned xb_ld(unsigned* p)              { return __hip_atomic_load(p, __ATOMIC_RELAXED, __HIP_MEMORY_SCOPE_AGENT); }
__device__ __forceinline__ unsigned xb_add(unsigned* p, unsigned v) { return __hip_atomic_fetch_add(p, v, __ATOMIC_RELAXED, __HIP_MEMORY_SCOPE_AGENT); }
__device__ __forceinline__ unsigned xb_xcc_id() { return (unsigned)__builtin_amdgcn_s_getreg((3 << 11) | 20) & 0xFu; }
#define XB_SPIN(cond, bar) do { unsigned _sp = 0; while (cond) { __builtin_amdgcn_s_sleep(1); \
    if ((++_sp & 255u) == 0u) { if (xb_ld(&(bar)[XB_TMO])) break; if (_sp > XB_SPIN_CAP) { atomicAdd(&(bar)[XB_TMO], 1u); break; } } } } while (0)
struct XcdBarrier { unsigned* bar; unsigned x; volatile LAS unsigned* st; };
__device__ __forceinline__ XcdBarrier xcd_barrier_post(unsigned* bar, volatile LAS unsigned* st) {
    XcdBarrier b; b.bar = bar; b.x = xb_xcc_id(); b.st = st;
    if (threadIdx.x == 0) (void)xb_add(&bar[XB_XCNT(b.x)], 1u);
    return b;
}
__device__ __forceinline__ void xcd_barrier_complete(unsigned* bar, unsigned x, unsigned& nloc, unsigned& nx) {
    const unsigned G = gridDim.x * gridDim.y * gridDim.z;
    unsigned sum, cnt, mine, sp = 0u;
    for (;;) {
        sum = 0u; cnt = 0u; mine = 0u;
#pragma unroll
        for (unsigned j = 0; j < 16; ++j) { const unsigned c = xb_ld(&bar[XB_XCNT(j)]); sum += c; cnt += (c > 0u) ? 1u : 0u; mine = (j == x) ? c : mine; }
        if (sum == G) break;
        __builtin_amdgcn_s_sleep(1);
        if ((++sp & 255u) == 0u) { if (xb_ld(&bar[XB_TMO])) break; if (sp > XB_SPIN_CAP) { atomicAdd(&bar[XB_TMO], 1u); break; } }
    }
    nloc = mine > 0u ? mine : 1u; nx = cnt > 0u ? cnt : 1u;
}
__device__ __forceinline__ void xcd_barrier(const XcdBarrier& b) {
    asm volatile("s_waitcnt vmcnt(0)" ::: "memory");
    __syncthreads();
    if (threadIdx.x == 0) {
        unsigned* bar = b.bar;
        __builtin_amdgcn_s_waitcnt(0);
        unsigned nloc = b.st[0], nx = b.st[1];
        if (nloc == 0u) { xcd_barrier_complete(bar, b.x, nloc, nx); b.st[0] = nloc; b.st[1] = nx; }
        const unsigned old = xb_add(&bar[XB_XSUB(b.x)], 1u);
        const unsigned gen = old / nloc;
        if (old + 1u == (gen + 1u) * nloc) {
            __builtin_amdgcn_fence(__ATOMIC_RELEASE, "agent");
            asm volatile("s_waitcnt vmcnt(0)" ::: "memory");
            const unsigned og = xb_add(&bar[XB_TOP], 1u);
            const unsigned tg = og / nx;
            if (og + 1u == (tg + 1u) * nx) xb_add(&bar[XB_TOPGEN], 1u);
            else XB_SPIN(xb_ld(&bar[XB_TOPGEN]) == tg, bar);
            __builtin_amdgcn_fence(__ATOMIC_ACQUIRE, "agent");
            xb_add(&bar[XB_XGEN(b.x)], 1u);
            asm volatile("s_waitcnt vmcnt(0)" ::: "memory");
        } else {
            XB_SPIN(xb_ld(&bar[XB_XGEN(b.x)]) == gen, bar);
            __builtin_amdgcn_fence(__ATOMIC_ACQUIRE, "agent");
            asm volatile("s_waitcnt vmcnt(0)" ::: "memory");
        }
    }
    __syncthreads();
}

namespace pg8 {
constexpr int BM = 256, BK = 64, HALF = 128, HTB = HALF * BK * 2, NXCD = 8, WGM = 8;
__host__ __device__ __forceinline__ int lds_byte(int r, int c) { const int st = (r >> 4) * 2 + (c >> 5), rr = r & 15, cc = c & 31, ob = rr * 64 + cc * 2; return st * 1024 + (ob ^ (((ob >> 9) & 1) << 5)); }
__host__ __device__ __forceinline__ void stage_rc(int b, int& R, int& C) { const int st = b / 1024, sb = b % 1024, swz = sb ^ (((sb >> 9) & 1) << 5); R = (st >> 1) * 16 + swz / 64; C = (st & 1) * 32 + (swz % 64) / 2; }
__host__ __device__ __forceinline__ int perm32(int rho) { const int n = rho >> 4, i = rho & 15; return 8 * (i >> 2) + 4 * n + (i & 3); }
struct Unit { int pm, pn, sub; };
struct Gemm { const bf16* A; const bf16* Bt; int M, N, K, lda; const bf16* A1; const bf16* Bt1; const bf16* A2; const bf16* Bt2; };
struct StaticOrder {
    static constexpr bool SPLIT = false;
    int nM, nN, nwg, G, c;
    __device__ __forceinline__ void init(int M, int N, int G_, int c_) { nM = M / BM; nN = N / BM; nwg = nM * nN; G = G_; c = c_; }
    __device__ __forceinline__ bool next(int i, Unit& u) const {
        const long L = (long)i * G + c; if (L >= nwg) return false;
        int wgid = (int)L; { const int q = nwg / NXCD, r = nwg % NXCD, xcd = wgid % NXCD, off = wgid / NXCD; wgid = (xcd < r ? xcd * (q + 1) : r * (q + 1) + (xcd - r) * q) + off; }
        const int nig = WGM * nN, gid = wgid / nig, fm = gid * WGM, gsz = (nM - fm) < WGM ? (nM - fm) : WGM;
        u.pm = fm + ((wgid % nig) % gsz); u.pn = (wgid % nig) / gsz; u.sub = 0; return true;
    }
};
struct SplitOrder {
    static constexpr bool SPLIT = true;
    int nM, nN, nwg, G, c, nfull, tail;
    __device__ __forceinline__ void init(int M, int N, int G_, int c_) { nM = M / BM; nN = N / BM; nwg = nM * nN; G = G_; c = c_; nfull = (nwg / G) * G; tail = nwg - nfull; if (2 * tail > G) { nfull = nwg; tail = 0; } }
    __device__ __forceinline__ bool next(int i, Unit& u) const {
        long L = (long)i * G + c; int sub = 0;
        if (L >= nfull) { if (tail == 0 || i != nfull / G || c >= 2 * tail) return false; const int j = (c >= tail) ? c - tail : c; sub = (c >= tail) ? 2 * j + 1 : 2 * j + 2; L = nfull + j; }
        int wgid = (int)L; { const int q = nwg / NXCD, r = nwg % NXCD, xcd = wgid % NXCD, off = wgid / NXCD; wgid = (xcd < r ? xcd * (q + 1) : r * (q + 1) + (xcd - r) * q) + off; }
        const int nig = WGM * nN, gid = wgid / nig, fm = gid * WGM, gsz = (nM - fm) < WGM ? (nM - fm) : WGM;
        u.pm = fm + ((wgid % nig) % gsz); u.pn = (wgid % nig) / gsz; u.sub = sub; return true;
    }
};
template <class Epi, class Ord>
__device__ __forceinline__ void gemm_phase(LAS unsigned char* lds, const Gemm g, const Ord& S, const Epi& E, int wave) {
    constexpr bool SPL = Ord::SPLIT;
    const int tid = tid_now(wave), wid = __builtin_amdgcn_readfirstlane(tid >> 6), lane = tid & 63, wr = wid >> 2, wc = wid & 3, fr = lane & 15, fq = lane >> 4;
    const int K = g.K, nt = K / BK, lda = g.lda;
    unsigned voffA[2], voffB[2];
#pragma unroll
    for (int i = 0; i < 2; ++i) { int R, C; stage_rc(tid * 16 + i * 8192, R, C); const int Rb = (R & ~31) + perm32(R & 31);
        voffA[i] = (unsigned)(R * lda + C) * 2u; voffB[i] = (unsigned)(Rb * K + C) * 2u; }
    const size_t kstep = (size_t)(BK * 2);
    const size_t hstepA = (size_t)HALF * lda * 2, hstepB = (size_t)HALF * K * 2;
    const size_t tstepA = 2 * hstepA, tstepB = 2 * hstepB;
    const unsigned ldsw = (unsigned)wid * 1024u;
    const int aoff = lds_byte(wr * 64 + fr, fq * 8), boff = lds_byte(wc * 32 + fr, fq * 8);
#define PG8_SA(b, h) (((b) * 2 + (h)) * HTB)
#define PG8_SB(b, h) ((4 + (b) * 2 + (h)) * HTB)
#define PG8_STAGE(bufoff, gbase, voff) do { _Pragma("unroll") for (int _i = 0; _i < 2; ++_i) \
        __builtin_amdgcn_global_load_lds((const unsigned*)((const char*)(gbase) + (voff)[_i]), (LAS unsigned*)(lds + (bufoff) + ldsw + _i * 8192), 16, 0, 0); } while (0)
#define PG8_LDA(dst, b, h) do { _Pragma("unroll") for (int m = 0; m < 4; ++m) _Pragma("unroll") for (int k = 0; k < 2; ++k) dst[m][k] = *(const LAS bf16x8*)(lds + PG8_SA(b, h) + aoff + m * 2048 + k * 1024); } while (0)
#define PG8_LDB(dst, b, h) do { _Pragma("unroll") for (int n = 0; n < 2; ++n) _Pragma("unroll") for (int k = 0; k < 2; ++k) dst[n][k] = *(const LAS bf16x8*)(lds + PG8_SB(b, h) + boff + n * 2048 + k * 1024); } while (0)
#define PG8_MMA(ai, bj, At, Bt) do { __builtin_amdgcn_s_setprio(1); _Pragma("unroll") for (int m = 0; m < 4; ++m) _Pragma("unroll") for (int n = 0; n < 2; ++n) _Pragma("unroll") for (int k = 0; k < 2; ++k) \
        acc[ai][bj][m][n] = __builtin_amdgcn_mfma_f32_16x16x32_bf16(Bt[n][k], At[m][k], acc[ai][bj][m][n], 0, 0, 0); __builtin_amdgcn_s_setprio(0); } while (0)
#define PG8_WAIT_V(n) asm volatile("s_waitcnt vmcnt(" #n ")" ::: "memory")
#define PG8_WAIT_L(n) asm volatile("s_waitcnt lgkmcnt(" #n ")" ::: "memory")
#define PG8_BAR __builtin_amdgcn_s_barrier()
#define PG8_SCHED __builtin_amdgcn_sched_barrier(0)
    constexpr int CH = Epi::CHAIN;
    Unit cur, nxt; int ui = 0;
    if (!S.next(0, cur)) return;
    f32x4 acc[2][2][4][2];
#pragma unroll
    for (int a = 0; a < 2; ++a)
#pragma unroll
        for (int b = 0; b < 2; ++b)
#pragma unroll
            for (int m = 0; m < 4; ++m)
#pragma unroll
                for (int n = 0; n < 2; ++n) acc[a][b][m][n] = (f32x4){0.f, 0.f, 0.f, 0.f};
    bf16x8 At[4][2], B0[2][2], B1[2][2];
#define PG8_AP(sub) ((const char*)((CH == 1 || (sub) == 0) ? g.A : ((sub) == 1 ? g.A1 : g.A2)))
#define PG8_BP(sub) ((const char*)((CH == 1 || (sub) == 0) ? g.Bt : ((sub) == 1 ? g.Bt1 : g.Bt2)))
#define PG8_KOFF(u) ((SPL && ((u).sub & 1)) ? (size_t)K : (size_t)0)
    const char* cA = PG8_AP(0) + (size_t)cur.pm * tstepA + PG8_KOFF(cur); const char* cB = PG8_BP(0) + (size_t)cur.pn * tstepB + PG8_KOFF(cur);
    PG8_STAGE(PG8_SB(0, 0), cB, voffB); PG8_STAGE(PG8_SB(0, 1), cB + hstepB, voffB); PG8_STAGE(PG8_SA(0, 0), cA, voffA); PG8_STAGE(PG8_SA(0, 1), cA + hstepA, voffA);
    if (wr == 1) PG8_BAR;
    PG8_WAIT_V(2); PG8_BAR;
    PG8_STAGE(PG8_SB(1, 0), cB + kstep, voffB); PG8_STAGE(PG8_SA(1, 0), cA + kstep, voffA); PG8_STAGE(PG8_SB(1, 1), cB + hstepB + kstep, voffB);
    PG8_WAIT_V(6); PG8_BAR;
    for (;;) {
        const bool has_next = S.next((ui + 1) / CH, nxt); if constexpr (!SPL) nxt.sub = (ui + 1) % CH;
        const char* nA = has_next ? PG8_AP(SPL ? 0 : nxt.sub) + (size_t)nxt.pm * tstepA + PG8_KOFF(nxt) : cA; const char* nB = has_next ? PG8_BP(SPL ? 0 : nxt.sub) + (size_t)nxt.pn * tstepB + PG8_KOFF(nxt) : cB;
        const int ntc = (SPL && cur.sub) ? (nt >> 1) : nt;
        for (int t = 0; t < ntc; t += 2) {
            const bool last = (t == ntc - 2);
            const char* a1 = cA + (size_t)(t + 1) * kstep;
            const char* a2 = last ? nA : cA + (size_t)(t + 2) * kstep; const char* b2 = last ? nB : cB + (size_t)(t + 2) * kstep;
            const char* a3 = a2 + kstep; const char* b3 = b2 + kstep;
            PG8_LDB(B0, 0, 0); PG8_LDB(B1, 0, 1); PG8_SCHED; PG8_LDA(At, 0, 0); PG8_STAGE(PG8_SA(1, 1), a1 + hstepA, voffA);
            PG8_WAIT_V(8); PG8_WAIT_L(0); PG8_BAR; PG8_MMA(0, 0, At, B0); PG8_MMA(0, 1, At, B1); PG8_BAR; PG8_SCHED;
            PG8_LDA(At, 0, 1); PG8_STAGE(PG8_SB(0, 0), b2, voffB); PG8_STAGE(PG8_SB(0, 1), b2 + hstepB, voffB); PG8_STAGE(PG8_SA(0, 0), a2, voffA);
            PG8_WAIT_V(8); PG8_WAIT_L(0); PG8_BAR; PG8_MMA(1, 0, At, B0); PG8_MMA(1, 1, At, B1); PG8_BAR; PG8_SCHED;
            PG8_LDB(B0, 1, 0); PG8_LDB(B1, 1, 1); PG8_SCHED; PG8_LDA(At, 1, 0); PG8_STAGE(PG8_SA(0, 1), a2 + hstepA, voffA);
            PG8_WAIT_V(8); PG8_WAIT_L(0); PG8_BAR; PG8_MMA(0, 0, At, B0); PG8_MMA(0, 1, At, B1); PG8_BAR; PG8_SCHED;
            PG8_LDA(At, 1, 1); PG8_STAGE(PG8_SB(1, 0), b3, voffB); PG8_STAGE(PG8_SB(1, 1), b3 + hstepB, voffB); PG8_STAGE(PG8_SA(1, 0), a3, voffA);
            PG8_WAIT_V(8); PG8_WAIT_L(0); PG8_BAR; PG8_MMA(1, 0, At, B0); PG8_MMA(1, 1, At, B1); PG8_BAR; PG8_SCHED;
        }
        if (wr == 0) PG8_BAR;
        if constexpr (SPL) {
            if (cur.sub & 1) E.put_partial(acc, cur, wave);
            else { if (cur.sub) E.get_partial(acc, cur, wave); E(acc, cur, wr, wc, fr, fq); }
        } else if constexpr (!Epi::AFTER_DRAIN) E(acc, cur, wr, wc, fr, fq);
        if (!has_next) break;
        if (CH == 1 || cur.sub == CH - 1) {
#pragma unroll
        for (int a = 0; a < 2; ++a)
#pragma unroll
            for (int b = 0; b < 2; ++b)
#pragma unroll
                for (int m = 0; m < 4; ++m)
#pragma unroll
                    for (int n = 0; n < 2; ++n) acc[a][b][m][n] = (f32x4){0.f, 0.f, 0.f, 0.f};
        }
        cur = nxt; cA = nA; cB = nB; ++ui;
        if (wr == 1) PG8_BAR;
    }
    PG8_WAIT_V(0);
    PG8_BAR;
    if constexpr (Epi::AFTER_DRAIN) E.fused(acc, cur, wr, wc, fr, fq, lds, tid);
#undef PG8_AP
#undef PG8_BP
#undef PG8_KOFF
#undef PG8_SA
#undef PG8_SB
#undef PG8_STAGE
#undef PG8_LDA
#undef PG8_LDB
#undef PG8_MMA
#undef PG8_WAIT_V
#undef PG8_WAIT_L
#undef PG8_BAR
#undef PG8_SCHED
}
}
using pg8::Unit;

struct Args { const float* in[30]; float* out; unsigned char* ws; int ph_lo, ph_hi, use_bar, pad; };
#define CAS __attribute__((address_space(4)))
typedef const CAS Args* ArgP;

__device__ __forceinline__ int src_win(int n) {
    const int t = n >> 8, g = n & 255;
    if (t < 20) return n;
    if (t < 22) return 5120 + (n - 20 * 256);
    if (t == 22) return 5632 + g;
    if (t < 28) { const int half = g >> 7, hd = (g >> 6) & 1, part = (g >> 5) & 1, i = g & 31; const int base = (t < 27) ? 5952 + (t - 23) * 256 : 6976; return base + hd * 128 + part * 64 + half * 32 + i; }
    if (t == 28) return 7232 + g;
    if (t < 53) return 7488 + (n - 29 * 256);
    { const int half = g >> 7, r = g & 127; if (r >= 32) return -1; const int part = r >> 4, i = r & 15; return 5888 + part * 32 + half * 16 + i; }
}
__device__ __forceinline__ int src_uq(int n) {
    const int t = n >> 8, g = n & 255;
    if (t < 4) { const int hd = n >> 7, d = n & 127; return hd * 192 + d; }
    const int half = g >> 7, hl = (g >> 5) & 3, part = (g >> 4) & 1, i = g & 15; const int hd = (t - 4) * 4 + hl;
    return hd * 192 + 128 + part * 32 + half * 16 + i;
}
__device__ __forceinline__ int src_ukv(int n) { const int v = n >> 10, r = n & 1023, hd = r >> 7, d = r & 127; return hd * 256 + v * 128 + d; }
__device__ __forceinline__ int src_up(int n) { const int j = n >> 8, g = n & 255; return (g < 128) ? 128 * j + g : DFF + 128 * j + (g - 128); }

typedef short s16x4p __attribute__((ext_vector_type(4)));
typedef short v4i16p __attribute__((ext_vector_type(4)));
__device__ __forceinline__ unsigned cvtpk_p(float lo, float hi) { return pk2(lo, hi); }
struct TDesc { const float* W; const float* fold; bf16* WT; int K, Nsrc, map, k0, n0; };
constexpr int J_IN = 32 * (NINP / 64), J_UQ = 8 * 24, J_UKV = 4 * 32, J_BR = 16 * 32, J_O = 32 * 32, J_UP = 32 * (NUP / 64), J_DN = (DFF / 64) * 32;
constexpr int J_L = J_IN + J_UQ + J_UKV + 3 * J_BR + J_O + J_UP + J_DN;
__device__ __forceinline__ TDesc t_desc(ArgP a, unsigned char* ws, int it) {
    const int l = it / J_L; int r = it % J_L; unsigned char* wl = ws + WS_W + (size_t)l * WL_STRIDE;
    TDesc d; d.fold = nullptr; int N;
    if (r < J_IN) { d.W = a->in[15] + (size_t)l * D * NIN; d.K = D; d.Nsrc = NIN; N = NINP; d.WT = (bf16*)(wl + WO_IN); d.map = 1; }
    else if ((r -= J_IN) < J_UQ) { d.W = a->in[19] + (size_t)l * 512 * 1536; d.K = 512; d.Nsrc = 1536; N = 1536; d.WT = (bf16*)(wl + WO_UQ); d.map = 2; d.fold = a->in[18] + l * 512; }
    else if ((r -= J_UQ) < J_UKV) { d.W = a->in[21] + (size_t)l * 256 * 2048; d.K = 256; d.Nsrc = 2048; N = 2048; d.WT = (bf16*)(wl + WO_UKV); d.map = 3; d.fold = a->in[20] + l * 256; }
    else if ((r -= J_UKV) < J_BR) { d.W = a->in[23] + (size_t)l * 1024 * 2048; d.K = 1024; d.Nsrc = 2048; N = 2048; d.WT = (bf16*)(wl + WO_A); d.map = 0; }
    else if ((r -= J_BR) < J_BR) { d.W = a->in[24] + (size_t)l * 1024 * 2048; d.K = 1024; d.Nsrc = 2048; N = 2048; d.WT = (bf16*)(wl + WO_B); d.map = 0; }
    else if ((r -= J_BR) < J_BR) { d.W = a->in[25] + (size_t)l * 1024 * 2048; d.K = 1024; d.Nsrc = 2048; N = 2048; d.WT = (bf16*)(wl + WO_C); d.map = 0; }
    else if ((r -= J_BR) < J_O) { d.W = a->in[26] + (size_t)l * 2048 * 2048; d.K = 2048; d.Nsrc = 2048; N = 2048; d.WT = (bf16*)(wl + WO_O); d.map = 0; }
    else if ((r -= J_O) < J_UP) { d.W = a->in[27] + (size_t)l * 2048 * NUP; d.K = 2048; d.Nsrc = NUP; N = NUP; d.WT = (bf16*)(wl + WO_UP); d.map = 4; }
    else { r -= J_UP; d.W = a->in[29] + (size_t)l * DFF * 2048; d.K = DFF; d.Nsrc = 2048; N = 2048; d.WT = (bf16*)(wl + WO_DN); d.map = 0; }
    const int nblk = N / 64; d.k0 = 64 * (r / nblk); d.n0 = 64 * (r % nblk);
    return d;
}
__device__ __forceinline__ void t_load(const TDesc& d, f32x4 (&v)[16], int lane) {
    const int kk = lane >> 4, n = d.n0 + 4 * (lane & 15);
    int sc; if (d.map == 0) sc = n; else if (d.map == 1) sc = src_win(n); else if (d.map == 2) sc = src_uq(n); else if (d.map == 3) sc = src_ukv(n); else sc = src_up(n);
    const float* p = d.W + (size_t)(d.k0 + kk) * d.Nsrc + (sc < 0 ? 0 : sc);
#pragma unroll
    for (int i = 0; i < 16; ++i) { f32x4 x = *(const f32x4*)(p + (size_t)(4 * i) * d.Nsrc); if (sc < 0) x = (f32x4){0.f, 0.f, 0.f, 0.f}; if (d.fold) x = x * d.fold[d.k0 + 4 * i + kk]; v[i] = x; }
}
__device__ __forceinline__ void t_store(const TDesc& d, const f32x4 (&v)[16], LAS unsigned char* scr, int lane) {
    const int kk = lane >> 4, n4 = lane & 15, g = lane >> 4, i16 = lane & 15, q = i16 >> 2, p = i16 & 3;
#pragma unroll
    for (int i = 0; i < 16; ++i) { u32x2 w; w.x = cvtpk_p(v[i].x, v[i].y); w.y = cvtpk_p(v[i].z, v[i].w); *(LAS u32x2*)(scr + (4 * i + kk) * 144 + 8 * n4) = w; }
#pragma unroll
    for (int j = 0; j < 8; ++j) { const int nb = j >> 1, k8 = 4 * (j & 1) + g;
        LAS unsigned char* p0 = scr + (8 * k8 + q) * 144 + (16 * nb + 4 * p) * 2;
        const s16x4p v0 = __builtin_bit_cast(s16x4p, __builtin_amdgcn_ds_read_tr16_b64_v4i16((LAS v4i16p*)p0));
        const s16x4p v1 = __builtin_bit_cast(s16x4p, __builtin_amdgcn_ds_read_tr16_b64_v4i16((LAS v4i16p*)(p0 + 4 * 144)));
        const bf16x8 o = (bf16x8){v0.x, v0.y, v0.z, v0.w, v1.x, v1.y, v1.z, v1.w};
        *(bf16x8*)(d.WT + (size_t)(d.n0 + 16 * nb + i16) * d.K + d.k0 + 8 * k8) = o; }
}

__device__ __forceinline__ void phase_prologue(ArgP a, LAS unsigned char* lds, int wave) {
    const int tidn = tid_now(wave), lane = tidn & 63;
    LAS unsigned char* scr = lds + wave * 9216;
    const int gw = blockIdx.x * 8 + wave, NGW = gridDim.x * 8;
    unsigned char* ws = a->ws;
    for (int it = gw; it < NL * 16 * 48; it += NGW) {
        const int l = it / 768, r = it % 768, kc = r / 48, jb = r % 48;
        const float* W = a->in[9] + (size_t)l * D * 12288 + (size_t)(kc * 128) * 12288 + jb * 256 + lane * 4;
        f32x4 acc[5];
#pragma unroll
        for (int s = 0; s < 5; ++s) acc[s] = (f32x4){0.f, 0.f, 0.f, 0.f};
        for (int k = 0; k < 128; ++k) {
            const f32x4 w = *(const f32x4*)(W + (size_t)k * 12288);
            const int kk = kc * 128 + k;
#pragma unroll
            for (int s = 0; s < 5; ++s) { const float cv = (s == 0) ? a->in[8][kk] : a->in[7][(s - 1) * D + kk]; const float sv = cv * sigmoidf_(cv); acc[s] += w * sv; }
        }
        float* P = (float*)(ws + WS_MODP) + ((size_t)(l * 16 + kc) * 5) * 12288 + jb * 256 + lane * 4;
#pragma unroll
        for (int s = 0; s < 5; ++s) *(f32x4*)(P + (size_t)s * 12288) = acc[s];
    }
    {
        const int NT = NL * J_L; int it = gw; TDesc dA, dB; f32x4 A[16], B[16];
        if (it < NT) { dA = t_desc(a, ws, it); t_load(dA, A, lane); }
        while (it < NT) {
            const int nx = it + NGW; const bool more = nx < NT;
            if (more) { dB = t_desc(a, ws, nx); t_load(dB, B, lane); }
            t_store(dA, A, scr, lane);
            if (more) { dA = dB;
#pragma unroll
                for (int i = 0; i < 16; ++i) A[i] = B[i]; }
            it = nx;
        }
    }
    const int gt = blockIdx.x * 512 + tidn, NGT = gridDim.x * 512;
    for (int i = gt; i < 2048; i += NGT) {
        float v[4], mx = -1e30f;
#pragma unroll
        for (int l = 0; l < 4; ++l) { v[l] = a->in[16][l * 2048 + i]; mx = fmaxf(mx, v[l]); }
        float e[4], s = 0.f;
#pragma unroll
        for (int l = 0; l < 4; ++l) { e[l] = expf(v[l] - mx); s += e[l]; }
        float cs = 0.f; float* LB = (float*)(ws + WS_LB);
        LB[i] = 0.f;
#pragma unroll
        for (int l = 1; l < 4; ++l) { cs += e[l] / s; LB[l * 2048 + i] = cs; }
    }
    for (int i = gt; i < 64 * 32; i += NGT) { const int pos = i >> 5, j = i & 31; const float inv = powf(10000.f, -(float)(2 * j) / 64.f); const float ang = (float)pos * inv;
        float* R = (float*)(ws + WS_ROPE); R[i] = cosf(ang); R[2048 + i] = sinf(ang); }
    for (int i = gt; i < 64 * 16; i += NGT) { const int pos = i >> 4, j = i & 15; const float inv = powf(10000.f, -(float)(2 * j) / 32.f); const float ang = (float)pos * inv;
        float* R = (float*)(ws + WS_ROPE) + 4096; R[i] = cosf(ang); R[1024 + i] = sinf(ang); }
    for (int i = gt; i < 4 * 4 * 256 * 256; i += NGT) {
        const int c = i & 255, t = (i >> 8) & 255, l = (i >> 16) & 3, b = i >> 18; const size_t row = 8192 + b * 256 + t;
        ((bf16*)(ws + WS_BKV))[((size_t)l * MKV + row) * 256 + c] = (bf16)f2bf(a->in[3][i] / a->in[20][l * 256 + c]);
        ((bf16*)(ws + WS_KC))[((size_t)l * MKV + row) * 256 + c] = (bf16)f2bf(a->in[5][i]);
        ((bf16*)(ws + WS_VC))[((size_t)l * MKV + row) * 256 + c] = (bf16)f2bf(a->in[6][i]);
    }
    for (int i = gt; i < 1024 * 4; i += NGT) ((float*)(ws + WS_SSQKV))[8192 * 4 + i] = 64.f * (1.f - EPS);
    for (int i = gt; i < 4 * 4 * 256 * 64; i += NGT) {
        const int c = i & 63, t = (i >> 6) & 255, l = (i >> 14) & 3, b = i >> 16; const size_t row = 8192 + b * 256 + t;
        ((bf16*)(ws + WS_KR))[((size_t)l * MKV + row) * 64 + c] = (bf16)f2bf(a->in[4][i]);
    }
}
__device__ __forceinline__ void phase_modreduce(ArgP a, int wave) {
    const int gt = blockIdx.x * 512 + tid_now(wave), NGT = gridDim.x * 512;
    for (int i4 = gt; i4 < NL * 5 * 12288 / 4; i4 += NGT) {
        const int i = i4 * 4, j = i % 12288, s = (i / 12288) % 5, l = i / (5 * 12288);
        f32x4 v = *(const f32x4*)(a->in[10] + l * 12288 + j);
        const float* P = (const float*)(a->ws + WS_MODP) + ((size_t)(l * 16) * 5 + s) * 12288 + j;
#pragma unroll
        for (int kc = 0; kc < 16; ++kc) v += *(const f32x4*)(P + (size_t)kc * 5 * 12288);
        *(f32x4*)((float*)(a->ws + WS_MOD) + i) = v;
    }
}

__device__ __forceinline__ int mod_sel(int m) { return (m < MC) ? 0 : 1 + ((m - MC) >> 10); }
__device__ __forceinline__ const float* x_input_row(ArgP a, int m) { return (m < MC) ? a->in[0] + (size_t)m * D : a->in[1] + (size_t)(m - MC) * D; }

__device__ __forceinline__ void phase_h0(ArgP a, int wave) {
    const int tidn = tid_now(wave), lane = tidn & 63;
    const int gw = blockIdx.x * 8 + wave, NGW = gridDim.x * 8;
    unsigned char* ws = a->ws;
    const float* MOD = (const float*)(ws + WS_MOD);
    for (int m = gw; m < MT; m += NGW) {
        const int sl = mod_sel(m); const float* xr = x_input_row(a, m); const float* mod = MOD + (size_t)sl * 12288; bf16* ho = (bf16*)(ws + WS_H) + (size_t)m * D;
        f32x4 x[8]; float sq = 0.f;
#pragma unroll
        for (int j = 0; j < 8; ++j) { x[j] = *(const f32x4*)(xr + 512 * (j >> 1) + lane * 8 + 4 * (j & 1)); sq += (x[j].x * x[j].x + x[j].y * x[j].y) + (x[j].z * x[j].z + x[j].w * x[j].w); }
        const float rs = rsq_(wave_sum(sq, lane) * (1.f / D) + EPS);
#pragma unroll
        for (int jb = 0; jb < 4; ++jb) { f32x4 h[2];
#pragma unroll
            for (int k = 0; k < 2; ++k) { const int c = 512 * jb + lane * 8 + 4 * k; h[k] = (x[2 * jb + k] * rs) * (*(const f32x4*)(a->in[11] + c) * (*(const f32x4*)(mod + D + c) + 1.f)) + *(const f32x4*)(mod + c); }
            u32x4 w; w.x = pk2(h[0].x, h[0].y); w.y = pk2(h[0].z, h[0].w); w.z = pk2(h[1].x, h[1].y); w.w = pk2(h[1].z, h[1].w); *(u32x4*)(ho + 512 * jb + lane * 8) = w; }
    }
}

__device__ __forceinline__ float gelu_tanh(float x) { const float u = 0.7978845608028654f * (x + 0.044715f * x * x * x); return x * sigmoidf_(2.f * u); }
__device__ __forceinline__ void st8bf(bf16* p, const f32x4 v0, const f32x4 v1) { u32x4 w; w.x = pk2(v0.x, v0.y); w.y = pk2(v0.z, v0.w); w.z = pk2(v1.x, v1.y); w.w = pk2(v1.z, v1.w); *(u32x4*)p = w; }

#define ROWV() f32x4 V[2][2]; _Pragma("unroll") for (int bj_ = 0; bj_ < 2; ++bj_) _Pragma("unroll") for (int n_ = 0; n_ < 2; ++n_) V[bj_][n_] = acc[ai][bj_][m][n_];
struct EpiWin {
    static constexpr bool AFTER_DRAIN = false; static constexpr int CHAIN = 1;
    unsigned char* ws; float* out; int l;
    __device__ __forceinline__ void operator()(const f32x4 (&acc)[2][2][4][2], const Unit& u, int wr, int wc, int fr, int fq) const {
        { int ln_; asm volatile("v_mbcnt_lo_u32_b32 %0, -1, 0\n\tv_mbcnt_hi_u32_b32 %0, -1, %0" : "=v"(ln_)); fr = ln_ & 15; fq = ln_ >> 4; }
        const int l = this->l;
        const int t = u.pn, row0 = u.pm * 256 + wr * 64 + fr, cl = wc * 32 + 8 * fq;
        const bool ctx = u.pm < 16;
        if (t < 4) {
            bf16* O = (bf16*)(ws + WS_QA);
#pragma unroll
            for (int ai = 0; ai < 2; ++ai)
#pragma unroll
                for (int m = 0; m < 4; ++m) { asm volatile("" ::: "memory"); const unsigned r = (unsigned)(row0 + ai * 128 + m * 16); ROWV();
#pragma unroll
                    for (int bj = 0; bj < 2; ++bj) st8bf(O + r * 1024 + t * 256 + bj * 128 + cl, V[bj][0], V[bj][1]); }
        } else if (t < 12) {
            const int cb = (t - 4) * 256;
            const float* LB = (const float*)(ws + WS_LB) + l * 2048;
            bf16* LG = (bf16*)(ws + WS_LG); bf16* KK = (bf16*)(ws + WS_KK);
#pragma unroll
            for (int bj = 0; bj < 2; ++bj) {
                const int c0 = cb + bj * 128 + cl;
                const f32x4 lb0 = *(const f32x4*)(LB + c0), lb1 = *(const f32x4*)(LB + c0 + 4);
#pragma unroll
                for (int ai = 0; ai < 2; ++ai)
#pragma unroll
                    for (int m = 0; m < 4; ++m) { asm volatile("" ::: "memory"); const unsigned r = (unsigned)(row0 + ai * 128 + m * 16); ROWV();
                        f32x4 lg[2];
#pragma unroll
                        for (int n = 0; n < 2; ++n) { const f32x4 lb = n ? lb1 : lb0; const f32x4 x = V[bj][n];
#pragma unroll
                            for (int e = 0; e < 4; ++e) { const float sg = sigmoidf_(x[e]); const float f = lb[e] + (1.f - lb[e]) * sg; lg[n][e] = __logf(f); } }
                        st8bf(LG + r * 2048 + c0, lg[0], lg[1]);
                        }
            }
        } else if (t < 16) {
            bf16* O = (bf16*)(ws + WS_VA);
#pragma unroll
            for (int ai = 0; ai < 2; ++ai)
#pragma unroll
                for (int m = 0; m < 4; ++m) { asm volatile("" ::: "memory"); const unsigned r = (unsigned)(row0 + ai * 128 + m * 16); ROWV();
#pragma unroll
                    for (int bj = 0; bj < 2; ++bj) st8bf(O + r * 1024 + (t - 12) * 256 + bj * 128 + cl, V[bj][0], V[bj][1]); }
        } else if (t < 20) {
            bf16* O = (bf16*)(ws + WS_AG);
#pragma unroll
            for (int ai = 0; ai < 2; ++ai)
#pragma unroll
                for (int m = 0; m < 4; ++m) { asm volatile("" ::: "memory"); const unsigned r = (unsigned)(row0 + ai * 128 + m * 16); ROWV();
#pragma unroll
                    for (int bj = 0; bj < 2; ++bj) { f32x4 v0 = V[bj][0], v1 = V[bj][1];
#pragma unroll
                        for (int e = 0; e < 4; ++e) { v0[e] = v0[e] * sigmoidf_(v0[e]); v1[e] = v1[e] * sigmoidf_(v1[e]); }
                        st8bf(O + r * 1024 + (t - 16) * 256 + bj * 128 + cl, v0, v1); } }
        } else if (t < 23) {
            const bool isq = t < 22;
            bf16* O = isq ? (bf16*)(ws + WS_BQ) : (bf16*)(ws + WS_BKV) + (size_t)l * MKV * 256;
            const int ld = isq ? 512 : 256, cb = isq ? (t - 20) * 256 : 0;
            float* SS = isq ? (float*)(ws + WS_SSQQ) : (float*)(ws + WS_SSQKV);
#pragma unroll
            for (int ai = 0; ai < 2; ++ai)
#pragma unroll
                for (int m = 0; m < 4; ++m) { asm volatile("" ::: "memory"); const unsigned r = (unsigned)(row0 + ai * 128 + m * 16); ROWV(); float s = 0.f;
#pragma unroll
                    for (int bj = 0; bj < 2; ++bj) { const f32x4 v0 = V[bj][0], v1 = V[bj][1];
                        s += (v0.x * v0.x + v0.y * v0.y) + (v0.z * v0.z + v0.w * v0.w) + (v1.x * v1.x + v1.y * v1.y) + (v1.z * v1.z + v1.w * v1.w);
                        st8bf(O + r * ld + cb + bj * 128 + cl, v0, v1);
                        if (!isq && ctx) { float* oc = out + OUT_CKV + (((r >> 8) * 4 + l) * 256 + (r & 255)) * 256 + bj * 128 + cl; *(f32x4*)oc = v0; *(f32x4*)(oc + 4) = v1; } }
                    s += shx(s, 16, fq * 16 + fr); s += shx(s, 32, fq * 16 + fr);
                    if (fq == 0) { if (isq) SS[r * 8 + (t - 20) * 4 + wc] = s; else SS[r * 4 + wc] = s; } }
        } else if (t < 28) {
            const bool isq = t < 27;
            const float* CS = (const float*)(ws + WS_ROPE);
            const int hd = wc >> 1, part = wc & 1, i0 = 8 * fq;
            const int ncol = hd * 128 + part * 64 + i0;
            bf16* O = isq ? (bf16*)(ws + WS_QC) : (bf16*)(ws + WS_KC) + (size_t)l * MKV * 256;
            const int ld = isq ? 1024 : 256, cb = isq ? (t - 23) * 256 : 0;
            const float qs = isq ? SCALE_C * 1.4426950408889634f : 1.f;
#pragma unroll
            for (int ai = 0; ai < 2; ++ai)
#pragma unroll
                for (int m = 0; m < 4; ++m) { asm volatile("" ::: "memory"); const unsigned r = (unsigned)(row0 + ai * 128 + m * 16); ROWV();
                    f32x4 o1[2], o2[2];
                    if (ctx) { o1[0] = V[0][0]; o1[1] = V[0][1]; o2[0] = V[1][0]; o2[1] = V[1][1]; }
                    else { const int tt = ((int)r - MC) & 1023; const int pos = part ? (tt & 63) : (tt >> 6);
#pragma unroll
                        for (int n = 0; n < 2; ++n) { const f32x4 c = *(const f32x4*)(CS + pos * 32 + i0 + 4 * n), s = *(const f32x4*)(CS + 2048 + pos * 32 + i0 + 4 * n);
                            const f32x4 x1 = V[0][n], x2 = V[1][n]; o1[n] = x1 * c - x2 * s; o2[n] = x1 * s + x2 * c; } }
                    if (!isq && ctx) { float* oc = out + OUT_K + (((r >> 8) * 4 + l) * 256 + (r & 255)) * 256 + ncol; *(f32x4*)oc = o1[0]; *(f32x4*)(oc + 4) = o1[1]; *(f32x4*)(oc + 32) = o2[0]; *(f32x4*)(oc + 36) = o2[1]; }
                    st8bf(O + r * ld + cb + ncol, o1[0] * qs, o1[1] * qs); st8bf(O + r * ld + cb + ncol + 32, o2[0] * qs, o2[1] * qs); }
        } else if (t == 28) {
            bf16* O = (bf16*)(ws + WS_VC) + (size_t)l * MKV * 256;
#pragma unroll
            for (int ai = 0; ai < 2; ++ai)
#pragma unroll
                for (int m = 0; m < 4; ++m) { asm volatile("" ::: "memory"); const unsigned r = (unsigned)(row0 + ai * 128 + m * 16); ROWV();
#pragma unroll
                    for (int bj = 0; bj < 2; ++bj) { st8bf(O + r * 256 + bj * 128 + cl, V[bj][0], V[bj][1]);
                        if (ctx) { float* oc = out + OUT_V + (((r >> 8) * 4 + l) * 256 + (r & 255)) * 256 + bj * 128 + cl; *(f32x4*)oc = V[bj][0]; *(f32x4*)(oc + 4) = V[bj][1]; } } }
        } else if (t < 53) {
            unsigned char* O = ws + WS_GT;
#pragma unroll
            for (int ai = 0; ai < 2; ++ai)
#pragma unroll
                for (int m = 0; m < 4; ++m) { asm volatile("" ::: "memory"); const unsigned r = (unsigned)(row0 + ai * 128 + m * 16); ROWV();
                    u32x4 w4 = (u32x4){0u, 0u, 0u, 0u};
#pragma unroll
                    for (int bj = 0; bj < 2; ++bj) { f32x4 v0 = V[bj][0], v1 = V[bj][1];
#pragma unroll
                        for (int e = 0; e < 4; ++e) { v0[e] = 255.f * sigmoidf_(v0[e]); v1[e] = 255.f * sigmoidf_(v1[e]); }
                        unsigned wx = 0u, wy = 0u;
#pragma unroll
                        for (int e = 0; e < 4; ++e) { wx = __builtin_amdgcn_cvt_pk_u8_f32(v0[e], e, wx); wy = __builtin_amdgcn_cvt_pk_u8_f32(v1[e], e, wy); }
                        if (bj == 0) { w4.x = wx; w4.y = wy; } else { w4.z = wx; w4.w = wy; } }
                    *(u32x4*)(O + r * 6144 + (t - 29) * 256 + 2 * cl) = w4; }
        } else {
            if (wc == 0) {
                const float* CS = (const float*)(ws + WS_ROPE) + 4096;
                const int part = fq >> 1, i0 = 8 * (fq & 1); const int ncol = part * 32 + i0;
                bf16* O = (bf16*)(ws + WS_KR) + (size_t)l * MKV * 64;
#pragma unroll
                for (int ai = 0; ai < 2; ++ai)
#pragma unroll
                    for (int m = 0; m < 4; ++m) { asm volatile("" ::: "memory"); const unsigned r = (unsigned)(row0 + ai * 128 + m * 16); ROWV();
                        f32x4 o1[2], o2[2];
                        if (ctx) { o1[0] = V[0][0]; o1[1] = V[0][1]; o2[0] = V[1][0]; o2[1] = V[1][1]; }
                        else { const int tt = ((int)r - MC) & 1023; const int pos = part ? (tt & 63) : (tt >> 6);
#pragma unroll
                            for (int n = 0; n < 2; ++n) { const f32x4 c = *(const f32x4*)(CS + pos * 16 + i0 + 4 * n), s = *(const f32x4*)(CS + 1024 + pos * 16 + i0 + 4 * n);
                                const f32x4 x1 = V[0][n], x2 = V[1][n]; o1[n] = x1 * c - x2 * s; o2[n] = x1 * s + x2 * c; } }
                        if (ctx) { float* oc = out + OUT_KR + (((r >> 8) * 4 + l) * 256 + (r & 255)) * 64 + ncol; *(f32x4*)oc = o1[0]; *(f32x4*)(oc + 4) = o1[1]; *(f32x4*)(oc + 16) = o2[0]; *(f32x4*)(oc + 20) = o2[1]; }
                        st8bf(O + r * 64 + ncol, o1[0], o1[1]); st8bf(O + r * 64 + ncol + 16, o2[0], o2[1]); }
            }
        }
    }
};

struct EpiUq {
    static constexpr bool AFTER_DRAIN = false; static constexpr int CHAIN = 1;
    unsigned char* ws;
    __device__ __forceinline__ void operator()(const f32x4 (&acc)[2][2][4][2], const Unit& u, int wr, int wc, int fr, int fq) const {
        { int ln_; asm volatile("v_mbcnt_lo_u32_b32 %0, -1, 0\n\tv_mbcnt_hi_u32_b32 %0, -1, %0" : "=v"(ln_)); fr = ln_ & 15; fq = ln_ >> 4; }
        const int t = u.pn, row0 = u.pm * 256 + wr * 64 + fr, cl = wc * 32 + 8 * fq; const bool ctx = u.pm < 16;
        const float* SS = (const float*)(ws + WS_SSQQ); bf16* O = (bf16*)(ws + WS_QF);
        const float* CS = (const float*)(ws + WS_ROPE) + 4096;
        float rsv[2][4];
#pragma unroll
        for (int ai = 0; ai < 2; ++ai)
#pragma unroll
            for (int m = 0; m < 4; ++m) { const unsigned r = (unsigned)(row0 + ai * 128 + m * 16); const f32x4 s0 = *(const f32x4*)(SS + r * 8), s1 = *(const f32x4*)(SS + r * 8 + 4);
                rsv[ai][m] = (SCALE_B * 1.4426950408889634f) * rsq_(((s0.x + s0.y) + (s0.z + s0.w) + (s1.x + s1.y) + (s1.z + s1.w)) * (1.f / 512.f) + EPS); }
#pragma unroll
        for (int ai = 0; ai < 2; ++ai)
#pragma unroll
            for (int m = 0; m < 4; ++m) { asm volatile("" ::: "memory"); const unsigned r = (unsigned)(row0 + ai * 128 + m * 16);
                const float rs = rsv[ai][m];
                if (t < 4) {
#pragma unroll
                    for (int bj = 0; bj < 2; ++bj) { const int hd = t * 2 + bj; st8bf(O + r * 1536 + hd * 192 + cl, acc[ai][bj][m][0] * rs, acc[ai][bj][m][1] * rs); }
                } else {
                    const int hd = (t - 4) * 4 + wc, part = fq >> 1, i0 = 8 * (fq & 1); const int ncol = hd * 192 + 128 + part * 32 + i0;
                    f32x4 o1[2], o2[2];
                    if (ctx) { o1[0] = acc[ai][0][m][0]; o1[1] = acc[ai][0][m][1]; o2[0] = acc[ai][1][m][0]; o2[1] = acc[ai][1][m][1]; }
                    else { const int tt = ((int)r - MC) & 1023; const int pos = part ? (tt & 63) : (tt >> 6);
#pragma unroll
                        for (int n = 0; n < 2; ++n) { const f32x4 c = *(const f32x4*)(CS + pos * 16 + i0 + 4 * n), s = *(const f32x4*)(CS + 1024 + pos * 16 + i0 + 4 * n);
                            const f32x4 x1 = acc[ai][0][m][n], x2 = acc[ai][1][m][n]; o1[n] = x1 * c - x2 * s; o2[n] = x1 * s + x2 * c; } }
                    st8bf(O + r * 1536 + ncol, o1[0] * rs, o1[1] * rs); st8bf(O + r * 1536 + ncol + 16, o2[0] * rs, o2[1] * rs);
                }
            }
    }
};

struct EpiKv {
    static constexpr bool AFTER_DRAIN = false; static constexpr int CHAIN = 1;
    unsigned char* ws;
    __device__ __forceinline__ void operator()(const f32x4 (&acc)[2][2][4][2], const Unit& u, int wr, int wc, int fr, int fq) const {
        { int ln_; asm volatile("v_mbcnt_lo_u32_b32 %0, -1, 0\n\tv_mbcnt_hi_u32_b32 %0, -1, %0" : "=v"(ln_)); fr = ln_ & 15; fq = ln_ >> 4; }
        const int row0 = u.pm * 256 + wr * 64 + fr, cl = wc * 32 + 8 * fq;
        const float* SS = (const float*)(ws + WS_SSQKV); bf16* O = (bf16*)(ws + WS_KV);
        float rsv[2][4];
#pragma unroll
        for (int ai = 0; ai < 2; ++ai)
#pragma unroll
            for (int m = 0; m < 4; ++m) { const unsigned r = (unsigned)(row0 + ai * 128 + m * 16); const f32x4 s0 = *(const f32x4*)(SS + r * 4);
                rsv[ai][m] = rsq_(((s0.x + s0.y) + (s0.z + s0.w)) * (1.f / 256.f) + EPS); }
#pragma unroll
        for (int ai = 0; ai < 2; ++ai)
#pragma unroll
            for (int m = 0; m < 4; ++m) { asm volatile("" ::: "memory"); const unsigned r = (unsigned)(row0 + ai * 128 + m * 16);
                const float rs = rsv[ai][m];
#pragma unroll
                for (int bj = 0; bj < 2; ++bj) st8bf(O + r * 2048 + u.pn * 256 + bj * 128 + cl, acc[ai][bj][m][0] * rs, acc[ai][bj][m][1] * rs); }
    }
};

struct EpiBranch {
    static constexpr bool AFTER_DRAIN = false; static constexpr int CHAIN = 3;
    unsigned char* ws;
    __device__ __forceinline__ void operator()(f32x4 (&acc)[2][2][4][2], const Unit& u, int wr, int wc, int fr, int fq) const {
        { int ln_; asm volatile("v_mbcnt_lo_u32_b32 %0, -1, 0\n\tv_mbcnt_hi_u32_b32 %0, -1, %0" : "=v"(ln_)); fr = ln_ & 15; fq = ln_ >> 4; }
        const int row0 = u.pm * 256 + wr * 64 + fr, cl = wc * 32 + 8 * fq;
        const unsigned char* G = ws + WS_GT; bf16* O = (bf16*)(ws + WS_MG);
        const int sub = u.sub;
#pragma unroll
        for (int ai = 0; ai < 2; ++ai) { asm volatile("" ::: "memory");
            u32x4 ga4[4], gb4[4];
#pragma unroll
            for (int m = 0; m < 4; ++m) { const unsigned r = (unsigned)(row0 + ai * 128 + m * 16); const int c16 = u.pn * 256 + 2 * cl;
                ga4[m] = *(const u32x4*)(G + r * 6144 + sub * 2048 + c16);
                gb4[m] = (sub < 2) ? *(const u32x4*)(G + r * 6144 + (sub + 1) * 2048 + c16) : (u32x4){0u, 0u, 0u, 0u}; }
#pragma unroll
            for (int m = 0; m < 4; ++m)
#pragma unroll
                for (int bj = 0; bj < 2; ++bj) { const unsigned r = (unsigned)(row0 + ai * 128 + m * 16); const int c = u.pn * 256 + bj * 128 + cl;
                    const u32x2 a4 = bj ? (u32x2){ga4[m].z, ga4[m].w} : (u32x2){ga4[m].x, ga4[m].y}, b4 = bj ? (u32x2){gb4[m].z, gb4[m].w} : (u32x2){gb4[m].x, gb4[m].y};
#define UB_(w, k) ((float)(((w) >> (8 * (k))) & 0xffu))
                    float s[8] = {UB_(a4.x, 0), UB_(a4.x, 1), UB_(a4.x, 2), UB_(a4.x, 3), UB_(a4.y, 0), UB_(a4.y, 1), UB_(a4.y, 2), UB_(a4.y, 3)};
#pragma unroll
                    for (int e = 0; e < 8; ++e) s[e] = fmaxf(s[e], 255e-6f);
                    if (sub < 2) { const float d[8] = {UB_(b4.x, 0), UB_(b4.x, 1), UB_(b4.x, 2), UB_(b4.x, 3), UB_(b4.y, 0), UB_(b4.y, 1), UB_(b4.y, 2), UB_(b4.y, 3)};
#pragma unroll
                        for (int e = 0; e < 8; ++e) s[e] *= __builtin_amdgcn_rcpf(fmaxf(d[e], 255e-6f)); }
                    else {
#pragma unroll
                        for (int e = 0; e < 8; ++e) s[e] *= (1.f / 255.f); }
#undef UB_
                    f32x4 v0 = acc[ai][bj][m][0], v1 = acc[ai][bj][m][1];
                    v0.x *= s[0]; v0.y *= s[1]; v0.z *= s[2]; v0.w *= s[3]; v1.x *= s[4]; v1.y *= s[5]; v1.z *= s[6]; v1.w *= s[7];
                    if (sub < 2) { acc[ai][bj][m][0] = v0; acc[ai][bj][m][1] = v1; }
                    else st8bf(O + r * 2048 + c, v0, v1); } }
    }
};

struct EpiF32 {
    static constexpr bool AFTER_DRAIN = false; static constexpr int CHAIN = 1;
    float* O; int ld;
    __device__ __forceinline__ void operator()(const f32x4 (&acc)[2][2][4][2], const Unit& u, int wr, int wc, int fr, int fq) const {
        { int ln_; asm volatile("v_mbcnt_lo_u32_b32 %0, -1, 0\n\tv_mbcnt_hi_u32_b32 %0, -1, %0" : "=v"(ln_)); fr = ln_ & 15; fq = ln_ >> 4; }
        const int row0 = u.pm * 256 + wr * 64 + fr, cl = wc * 32 + 8 * fq;
#pragma unroll
        for (int ai = 0; ai < 2; ++ai)
#pragma unroll
            for (int m = 0; m < 4; ++m) { asm volatile("" ::: "memory"); const unsigned r = (unsigned)(row0 + ai * 128 + m * 16);
#pragma unroll
                for (int bj = 0; bj < 2; ++bj) { float* p = O + r * ld + u.pn * 256 + bj * 128 + cl; *(f32x4*)p = acc[ai][bj][m][0]; *(f32x4*)(p + 4) = acc[ai][bj][m][1]; } }
    }
};
struct EpiBf {
    static constexpr bool AFTER_DRAIN = false; static constexpr int CHAIN = 1;
    bf16* O; int ld;
    __device__ __forceinline__ void operator()(const f32x4 (&acc)[2][2][4][2], const Unit& u, int wr, int wc, int fr, int fq) const {
        { int ln_; asm volatile("v_mbcnt_lo_u32_b32 %0, -1, 0\n\tv_mbcnt_hi_u32_b32 %0, -1, %0" : "=v"(ln_)); fr = ln_ & 15; fq = ln_ >> 4; }
        const int row0 = u.pm * 256 + wr * 64 + fr, cl = wc * 32 + 8 * fq;
#pragma unroll
        for (int ai = 0; ai < 2; ++ai)
#pragma unroll
            for (int m = 0; m < 4; ++m) { asm volatile("" ::: "memory"); const unsigned r = (unsigned)(row0 + ai * 128 + m * 16);
#pragma unroll
                for (int bj = 0; bj < 2; ++bj) st8bf(O + r * ld + u.pn * 256 + bj * 128 + cl, acc[ai][bj][m][0], acc[ai][bj][m][1]); }
    }
};

__device__ __forceinline__ float dpp_prev(float x) { return __builtin_bit_cast(float, __builtin_amdgcn_update_dpp(0, __builtin_bit_cast(int, x), 0x121, 0xf, 0xf, false)); }
__device__ __forceinline__ float dpp_next(float x) { return __builtin_bit_cast(float, __builtin_amdgcn_update_dpp(0, __builtin_bit_cast(int, x), 0x12f, 0xf, 0xf, false)); }
__device__ __forceinline__ float dpp_up(float e, float x) { return __builtin_bit_cast(float, __builtin_amdgcn_update_dpp(__builtin_bit_cast(int, e), __builtin_bit_cast(int, x), 0x111, 0xf, 0xf, false)); }
__device__ __forceinline__ float dpp_dn(float e, float x) { return __builtin_bit_cast(float, __builtin_amdgcn_update_dpp(__builtin_bit_cast(int, e), __builtin_bit_cast(int, x), 0x101, 0xf, 0xf, false)); }
struct EpiUp {
    static constexpr bool AFTER_DRAIN = false; static constexpr int CHAIN = 1;
    unsigned char* ws; const float* cw; LAS unsigned char* hl; int l;
    __device__ __forceinline__ void put_partial(const f32x4 (&acc)[2][2][4][2], const Unit& u, int wave) const {
        const int tid = tid_now(wave), j = (u.sub - 1) >> 1;
        float* P = (float*)(ws + WS_SPL) + (size_t)j * 65536 + tid * 4;
#pragma unroll
        for (int ai = 0; ai < 2; ++ai)
#pragma unroll
            for (int bj = 0; bj < 2; ++bj)
#pragma unroll
                for (int m = 0; m < 4; ++m)
#pragma unroll
                    for (int n = 0; n < 2; ++n) *(f32x4*)(P + (((ai * 2 + bj) * 4 + m) * 2 + n) * 2048) = acc[ai][bj][m][n];
        asm volatile("s_waitcnt vmcnt(0)" ::: "memory");
        __syncthreads();
        if (tid == 0) { __builtin_amdgcn_fence(__ATOMIC_RELEASE, "agent"); asm volatile("s_waitcnt vmcnt(0)" ::: "memory"); __hip_atomic_store((unsigned*)ws + CW_SPL + l * 128 + j, 1u, RLX_AGENT); }
    }
    __device__ __forceinline__ void get_partial(f32x4 (&acc)[2][2][4][2], const Unit& u, int wave) const {
        const int tid = tid_now(wave), j = (u.sub - 1) >> 1;
        if (tid == 0) { unsigned* f = (unsigned*)ws + CW_SPL + l * 128 + j; unsigned sp = 0; while (__hip_atomic_load(f, RLX_AGENT) == 0u) { __builtin_amdgcn_s_sleep(1); if (++sp > (1u << 22)) break; }
            __builtin_amdgcn_fence(__ATOMIC_ACQUIRE, "agent"); asm volatile("s_waitcnt vmcnt(0)" ::: "memory"); }
        __syncthreads();
        const float* P = (const float*)(ws + WS_SPL) + (size_t)j * 65536 + tid * 4;
#pragma unroll
        for (int ai = 0; ai < 2; ++ai) { f32x4 p[2][4][2];
#pragma unroll
            for (int bj = 0; bj < 2; ++bj)
#pragma unroll
                for (int m = 0; m < 4; ++m)
#pragma unroll
                    for (int n = 0; n < 2; ++n) p[bj][m][n] = *(const f32x4*)(P + (((ai * 2 + bj) * 4 + m) * 2 + n) * 2048);
#pragma unroll
            for (int bj = 0; bj < 2; ++bj)
#pragma unroll
                for (int m = 0; m < 4; ++m)
#pragma unroll
                    for (int n = 0; n < 2; ++n) acc[ai][bj][m][n] += p[bj][m][n]; }
    }
    __device__ __forceinline__ void operator()(const f32x4 (&acc)[2][2][4][2], const Unit& u, int wr, int wc, int fr, int fq) const {
        { int ln_; asm volatile("v_mbcnt_lo_u32_b32 %0, -1, 0\n\tv_mbcnt_hi_u32_b32 %0, -1, %0" : "=v"(ln_)); fr = ln_ & 15; fq = ln_ >> 4; }
        const int cl = wc * 32 + 8 * fq;
        LAS f32x4* HL = (LAS f32x4*)hl;
#pragma unroll
        for (int ai = 0; ai < 2; ++ai) {
            if (fr == 0) {
#pragma unroll
                for (int bj = 0; bj < 2; ++bj)
#pragma unroll
                    for (int n = 0; n < 2; ++n) HL[((((ai * 2 + wr) * 4 + wc) * 2 + 0) * 4 + fq) * 4 + bj * 2 + n] = acc[ai][bj][0][n]; }
            if (fr == 15) {
#pragma unroll
                for (int bj = 0; bj < 2; ++bj)
#pragma unroll
                    for (int n = 0; n < 2; ++n) HL[((((ai * 2 + wr) * 4 + wc) * 2 + 1) * 4 + fq) * 4 + bj * 2 + n] = acc[ai][bj][3][n]; }
        }
        if (u.pm >= 16) {
            bf16* HU = (bf16*)(ws + WS_HALO) + (size_t)(u.pm - 16) * 4 * NUP + u.pn * 256 + cl;
            if (wr == 0 && fr < 2) {
#pragma unroll
                for (int bj = 0; bj < 2; ++bj) st8bf(HU + (size_t)fr * NUP + bj * 128, acc[0][bj][0][0], acc[0][bj][0][1]); }
            if (wr == 1 && fr >= 14) {
#pragma unroll
                for (int bj = 0; bj < 2; ++bj) st8bf(HU + (size_t)(fr - 12) * NUP + bj * 128, acc[1][bj][3][0], acc[1][bj][3][1]); }
        }
        asm volatile("s_waitcnt lgkmcnt(0)" ::: "memory");
        __builtin_amdgcn_s_barrier();
        bf16* ACT = (bf16*)(ws + WS_ACT);
        LAS u32x2* KEEP = (LAS u32x2*)(hl - HALO_OFF + 3 * 16384) + (wr * 4 + wc) * 64 + (fq * 16 + fr);
#pragma unroll
        for (int ai = 0; ai < 2; ++ai) {
#pragma unroll
            for (int n = 0; n < 2; ++n) { asm volatile("" ::: "memory");
                f32x4 wa[3], wg[3];
#pragma unroll
                for (int tap = 0; tap < 3; ++tap) { const float* p = cw + tap * NUP + u.pn * 128 + cl + 4 * n; wa[tap] = *(const f32x4*)p; wg[tap] = *(const f32x4*)(p + DFF); }
                f32x4 top[2], bot[2];
#pragma unroll
                for (int bj = 0; bj < 2; ++bj) {
                    const int tsrc = (wr == 1) ? (ai * 2 + 0) : 1;
                    const int bsrc = (wr == 0) ? (ai * 2 + 1) : 2;
                    const f32x4 tv = HL[(((tsrc * 4 + wc) * 2 + 1) * 4 + fq) * 4 + bj * 2 + n], bv = HL[(((bsrc * 4 + wc) * 2 + 0) * 4 + fq) * 4 + bj * 2 + n];
                    top[bj] = (wr == 1 || ai == 1) ? tv : (f32x4){0.f, 0.f, 0.f, 0.f};
                    bot[bj] = (wr == 0 || ai == 0) ? bv : (f32x4){0.f, 0.f, 0.f, 0.f}; }
#pragma unroll
                for (int m = 0; m < 4; ++m) { asm volatile("" ::: "memory");
                    const unsigned r = (unsigned)(u.pm * 256 + ai * 128 + wr * 64 + m * 16 + fr);
                    f32x4 res;
#pragma unroll
                    for (int e = 0; e < 4; ++e) {
                        float v[2];
#pragma unroll
                        for (int bj = 0; bj < 2; ++bj) {
                            const float x = acc[ai][bj][m][n][e];
                            const float pe_ = (m == 0) ? top[bj][e] : dpp_prev(acc[ai][bj][m == 0 ? 0 : m - 1][n][e]);
                            const float ne_ = (m == 3) ? bot[bj][e] : dpp_next(acc[ai][bj][m == 3 ? 3 : m + 1][n][e]);
                            const float up = dpp_up(pe_, x), dn = dpp_dn(ne_, x);
                            const float w0 = bj ? wg[0][e] : wa[0][e], w1 = bj ? wg[1][e] : wa[1][e], w2 = bj ? wg[2][e] : wa[2][e];
                            v[bj] = w0 * up + w1 * x + w2 * dn; }
                        res[e] = v[0] * gelu_tanh(v[1]); }
                    u32x2 o; o.x = cvtpk_p(res.x, res.y); o.y = cvtpk_p(res.z, res.w);
                    if (n == 0) KEEP[m * 512] = o;
                    else { const u32x2 k0 = KEEP[m * 512]; const u32x4 o4 = (u32x4){k0.x, k0.y, o.x, o.y}; *(u32x4*)(ACT + r * DFF + u.pn * 128 + cl) = o4; } }
            }
        }
        __builtin_amdgcn_s_barrier();
    }
};
__device__ __forceinline__ void conv_fixup(ArgP a, int l, int pm, int wave) {
    if (pm < 16) return;
    const int tid = tid_now(wave); const int tl = pm - 16;
    const bf16* HU = (const bf16*)(a->ws + WS_HALO); bf16* ACT = (bf16*)(a->ws + WS_ACT); const float* CW = a->in[28] + (size_t)l * 3 * NUP;
    for (int it = tid; it < 2 * (DFF / 8); it += 512) {
        const int which = it / (DFF / 8), c = (it % (DFF / 8)) * 8; const int j = c >> 7, i = c & 127;
        if (which == 0 ? ((tl & 3) == 0) : ((tl & 3) == 3)) continue;
        const bf16* r0 = which == 0 ? HU + ((size_t)(tl - 1) * 4 + 3) * NUP : HU + ((size_t)tl * 4 + 2) * NUP;
        const bf16* r1 = which == 0 ? HU + ((size_t)tl * 4 + 0) * NUP : HU + ((size_t)tl * 4 + 3) * NUP;
        const bf16* r2 = which == 0 ? HU + ((size_t)tl * 4 + 1) * NUP : HU + ((size_t)(tl + 1) * 4 + 0) * NUP;
        const bf16* rr[3] = {r0, r1, r2};
        f32x4 ra0 = (f32x4){0.f, 0.f, 0.f, 0.f}, ra1 = ra0, rg0 = ra0, rg1 = ra0;
#pragma unroll
        for (int tap = 0; tap < 3; ++tap) { const u32x4 xa = *(const u32x4*)(rr[tap] + 256 * j + i), xg = *(const u32x4*)(rr[tap] + 256 * j + i + 128);
            const float* p = CW + tap * NUP + c; const f32x4 wa0 = *(const f32x4*)p, wa1 = *(const f32x4*)(p + 4), wg0 = *(const f32x4*)(p + DFF), wg1 = *(const f32x4*)(p + DFF + 4);
            ra0 += wa0 * (f32x4){bf_lo(xa.x), bf_hi(xa.x), bf_lo(xa.y), bf_hi(xa.y)}; ra1 += wa1 * (f32x4){bf_lo(xa.z), bf_hi(xa.z), bf_lo(xa.w), bf_hi(xa.w)};
            rg0 += wg0 * (f32x4){bf_lo(xg.x), bf_hi(xg.x), bf_lo(xg.y), bf_hi(xg.y)}; rg1 += wg1 * (f32x4){bf_lo(xg.z), bf_hi(xg.z), bf_lo(xg.w), bf_hi(xg.w)}; }
        u32x4 o; o.x = pk2(ra0.x * gelu_tanh(rg0.x), ra0.y * gelu_tanh(rg0.y)); o.y = pk2(ra0.z * gelu_tanh(rg0.z), ra0.w * gelu_tanh(rg0.w));
        o.z = pk2(ra1.x * gelu_tanh(rg1.x), ra1.y * gelu_tanh(rg1.y)); o.w = pk2(ra1.z * gelu_tanh(rg1.z), ra1.w * gelu_tanh(rg1.w));
        *(u32x4*)(ACT + (size_t)(pm * 256 + (which ? 255 : 0)) * DFF + c) = o;
    }
    asm volatile("s_waitcnt vmcnt(0)" ::: "memory");
    __syncthreads();
}

#define RLX_AG __ATOMIC_RELAXED, __HIP_MEMORY_SCOPE_AGENT
__device__ __forceinline__ void panel_exchange(LAS float* P, LAS float* R, unsigned* X, unsigned* cnt, int pm, int pn, int tid) {
    if (tid < 256) { const f32x4 p = *(const LAS f32x4*)(P + tid * 4); const float tot = (p.x + p.y) + (p.z + p.w);
        __hip_atomic_store(X + ((size_t)(pm * 256 + tid)) * 8 + pn, __builtin_bit_cast(unsigned, tot), RLX_AG); }
    asm volatile("s_waitcnt vmcnt(0)" ::: "memory");
    __syncthreads();
    if (tid == 0) { (void)__hip_atomic_fetch_add(cnt, 1u, RLX_AG);
        unsigned sp = 0; while (__hip_atomic_load(cnt, RLX_AG) < 8u) { __builtin_amdgcn_s_sleep(1); if (++sp > (1u << 22)) break; } }
    __syncthreads();
    if (tid < 256) { float tot = 0.f;
#pragma unroll
        for (int j = 0; j < 8; ++j) tot += __builtin_bit_cast(float, __hip_atomic_load(X + ((size_t)(pm * 256 + tid)) * 8 + j, RLX_AG));
        R[tid] = rsq_(tot * (1.f / D) + EPS); }
    __syncthreads();
}
template <int WHICH, bool XF32>
struct EpiResid {
    static constexpr bool AFTER_DRAIN = true; static constexpr int CHAIN = 1;
    unsigned char* ws; float* out; const float* xin0; const float* xin1; const float* npost; const float* nnext; int l; int mk_next;
    __device__ __forceinline__ void operator()(const f32x4 (&acc)[2][2][4][2], const Unit& u, int wr, int wc, int fr, int fq) const {}
    __device__ __forceinline__ void fused(f32x4 (&acc)[2][2][4][2], const Unit& u, int wr, int wc, int fr, int fq, LAS unsigned char* lds, int tid) const {
        { int ln_; asm volatile("v_mbcnt_lo_u32_b32 %0, -1, 0\n\tv_mbcnt_hi_u32_b32 %0, -1, %0" : "=v"(ln_)); fr = ln_ & 15; fq = ln_ >> 4; tid = (wr * 4 + wc) * 64 + ln_; }
        LAS float* P = (LAS float*)lds; LAS float* R = (LAS float*)(lds + 4096);
        const int lr0 = wr * 64 + fr, cl = wc * 32 + 8 * fq, ln = fq * 16 + fr;
#pragma unroll
        for (int ai = 0; ai < 2; ++ai)
#pragma unroll
            for (int m = 0; m < 4; ++m) { float sq = 0.f;
#pragma unroll
                for (int bj = 0; bj < 2; ++bj)
#pragma unroll
                    for (int n = 0; n < 2; ++n) { const f32x4 v = acc[ai][bj][m][n]; sq += (v.x * v.x + v.y * v.y) + (v.z * v.z + v.w * v.w); }
                sq += shx(sq, 16, ln); sq += shx(sq, 32, ln);
                if (fq == 0) P[(ai * 128 + lr0 + m * 16) * 4 + wc] = sq; }
        __syncthreads();
        unsigned* X = (unsigned*)(ws + WS_XCH) + (size_t)(WHICH * 2) * MT * 8;
        unsigned* cnt = (unsigned*)(ws + WS_CTL) + CW_CNT + (((l * 2 + WHICH) * 2) * 32 + u.pm) * 64;
        const int sel = (u.pm < 16) ? 0 : 1 + ((u.pm - 16) >> 2);
        const float* MODL = (const float*)(ws + WS_MOD) + (size_t)(l * 5 + sel) * 12288;
        const unsigned cb = (unsigned)(u.pn * 256 + cl);
        const bf16* XB = (const bf16*)(ws + WS_XB);
        u32x4 xraw[4][2];
#pragma unroll
        for (int m = 0; m < 4; ++m)
#pragma unroll
            for (int bj = 0; bj < 2; ++bj) xraw[m][bj] = (u32x4){0u, 0u, 0u, 0u};
        if constexpr (!XF32) {
#pragma unroll
            for (int m = 0; m < 4; ++m) { const unsigned r = (unsigned)(u.pm * 256 + lr0 + m * 16);
#pragma unroll
                for (int bj = 0; bj < 2; ++bj) xraw[m][bj] = *(const u32x4*)(XB + r * D + cb + bj * 128); } }
        panel_exchange(P, R, X, cnt, u.pm, u.pn, tid);
        {
        f32x4 gw[2][2];
#pragma unroll
        for (int bj = 0; bj < 2; ++bj)
#pragma unroll
            for (int n = 0; n < 2; ++n) gw[bj][n] = *(const f32x4*)(MODL + (WHICH ? 5 : 2) * D + cb + (bj * 128 + 4 * n)) * *(const f32x4*)(npost + cb + (bj * 128 + 4 * n));
#pragma unroll
        for (int ai = 0; ai < 2; ++ai) { asm volatile("" ::: "memory");
            f32x4 xa[4][2][2];
            if constexpr (XF32) {
#pragma unroll
                for (int m = 0; m < 4; ++m) { const size_t r = (size_t)u.pm * 256 + ai * 128 + lr0 + m * 16; const float* xr = ((r < (size_t)MC) ? xin0 + r * D : xin1 + (r - MC) * D) + cb;
#pragma unroll
                    for (int bj = 0; bj < 2; ++bj)
#pragma unroll
                        for (int n = 0; n < 2; ++n) xa[m][bj][n] = *(const f32x4*)(xr + (bj * 128 + 4 * n)); }
            } else {
                if (ai == 1) {
#pragma unroll
                    for (int m = 0; m < 4; ++m) { const unsigned r = (unsigned)(u.pm * 256 + 128 + lr0 + m * 16);
#pragma unroll
                        for (int bj = 0; bj < 2; ++bj) xraw[m][bj] = *(const u32x4*)(XB + r * D + cb + bj * 128); } }
#pragma unroll
                for (int m = 0; m < 4; ++m)
#pragma unroll
                    for (int bj = 0; bj < 2; ++bj) { const u32x4 w = xraw[m][bj];
                        xa[m][bj][0] = (f32x4){bf_lo(w.x), bf_hi(w.x), bf_lo(w.y), bf_hi(w.y)}; xa[m][bj][1] = (f32x4){bf_lo(w.z), bf_hi(w.z), bf_lo(w.w), bf_hi(w.w)}; } }
#pragma unroll
            for (int m = 0; m < 4; ++m) { const int lr = ai * 128 + lr0 + m * 16; const float rs = R[lr]; float sq = 0.f;
#pragma unroll
                for (int bj = 0; bj < 2; ++bj)
#pragma unroll
                    for (int n = 0; n < 2; ++n) { const f32x4 xn = xa[m][bj][n] + gw[bj][n] * (acc[ai][bj][m][n] * rs); acc[ai][bj][m][n] = xn;
                        sq += (xn.x * xn.x + xn.y * xn.y) + (xn.z * xn.z + xn.w * xn.w); }
                sq += shx(sq, 16, ln); sq += shx(sq, 32, ln);
                if (fq == 0) P[lr * 4 + wc] = sq; } }
        }
        if (!mk_next) {
#pragma unroll
            for (int ai = 0; ai < 2; ++ai)
#pragma unroll
                for (int m = 0; m < 4; ++m) { const size_t r = (size_t)u.pm * 256 + ai * 128 + lr0 + m * 16; float* orow = out + r * D + cb;
#pragma unroll
                    for (int bj = 0; bj < 2; ++bj)
#pragma unroll
                        for (int n = 0; n < 2; ++n) *(f32x4*)(orow + (bj * 128 + 4 * n)) = acc[ai][bj][m][n]; }
            return; }
        const float* MODN = (const float*)(ws + WS_MOD) + (size_t)((WHICH ? l + 1 : l) * 5 + sel) * 12288;
        f32x4 va[2][2], vb[2][2], sh[2][2];
#pragma unroll
        for (int bj = 0; bj < 2; ++bj)
#pragma unroll
            for (int n = 0; n < 2; ++n) { const unsigned c = cb + (unsigned)(bj * 128 + 4 * n);
                va[bj][n] = *(const f32x4*)(nnext + c); vb[bj][n] = *(const f32x4*)(MODN + (WHICH ? 1 : 4) * D + c); sh[bj][n] = *(const f32x4*)(MODN + (WHICH ? 0 : 3) * D + c); }
        __syncthreads();
        panel_exchange(P, R, X + (size_t)MT * 8, cnt + 32 * 64, u.pm, u.pn, tid);
        f32x4 vv[2][2];
#pragma unroll
        for (int bj = 0; bj < 2; ++bj)
#pragma unroll
            for (int n = 0; n < 2; ++n) vv[bj][n] = va[bj][n] * (vb[bj][n] + 1.f);
        bf16* H = (bf16*)(ws + WS_H); bf16* XO = (bf16*)(ws + WS_XB);
#pragma unroll
        for (int ai = 0; ai < 2; ++ai)
#pragma unroll
            for (int m = 0; m < 4; ++m) { const int lr = ai * 128 + lr0 + m * 16; const unsigned r = (unsigned)(u.pm * 256 + lr); const float rs = R[lr];
#pragma unroll
                for (int bj = 0; bj < 2; ++bj) {
                    st8bf(XO + r * D + cb + bj * 128, acc[ai][bj][m][0], acc[ai][bj][m][1]);
                    st8bf(H + r * D + cb + bj * 128, (acc[ai][bj][m][0] * rs) * vv[bj][0] + sh[bj][0], (acc[ai][bj][m][1] * rs) * vv[bj][1] + sh[bj][1]); } }
        __syncthreads();
    }
};

__device__ __forceinline__ void job_ckv_norm(ArgP a, int l, int wave) {
    const int tidn = tid_now(wave), lane = tidn & 63;
    const int gw = blockIdx.x * 8 + wave, NGW = gridDim.x * 8;
    const float* SS = (const float*)(a->ws + WS_SSQKV);
    const f32x4 g = *(const f32x4*)(a->in[20] + l * 256 + lane * 4);
    for (int m = gw; m < MC; m += NGW) {
        const f32x4 s0 = *(const f32x4*)(SS + (size_t)m * 4); const float rs = rsq_(((s0.x + s0.y) + (s0.z + s0.w)) * (1.f / 256.f) + EPS);
        float* p = a->out + OUT_CKV + ((size_t)((m >> 8) * 4 + l) * 256 + (m & 255)) * 256 + lane * 4;
        *(f32x4*)p = *(const f32x4*)p * rs * g;
    }
}

typedef short s16x4 __attribute__((ext_vector_type(4)));
typedef short v4i16_t __attribute__((ext_vector_type(4)));
constexpr float LOG2E = 1.4426950408889634f;
__device__ __forceinline__ unsigned k_swz(unsigned ob) { return ob ^ (((ob >> 9) & 1u) << 5); }
__device__ __forceinline__ unsigned offb(unsigned row, unsigned ch) { return 256u * row + 16u * (ch ^ (((row & 3u) << 2) | ((row >> 2) & 3u))); }
__device__ __forceinline__ unsigned cvtpk(float lo, float hi) { return pk2(lo, hi); }

template <int DK>
__device__ __forceinline__ void attn_stage_load(u32x4 (&kr)[DK / 64], u32x4 (&vr)[2], const bf16* K1, int ldk1, const bf16* K2, int ldk2, const bf16* V, int ldv, int row0, int tid) {
#pragma unroll
    for (int i = 0; i < DK / 64; ++i) { const int c = tid + 512 * i, key = c / (DK / 8), ch = c % (DK / 8);
        if (DK == 128 || ch < 16) kr[i] = *(const u32x4*)(K1 + (unsigned)((row0 + key) * ldk1 + ch * 8)); else kr[i] = *(const u32x4*)(K2 + (unsigned)((row0 + key) * ldk2 + (ch - 16) * 8)); }
#pragma unroll
    for (int i = 0; i < 2; ++i) { const int c = tid + 512 * i, row = c >> 4, ch = c & 15; vr[i] = *(const u32x4*)(V + (unsigned)((row0 + row) * ldv + ch * 8)); }
}
template <int DK>
__device__ __forceinline__ void attn_stage_store(LAS unsigned char* kb, LAS unsigned char* vb, const u32x4 (&kr)[DK / 64], const u32x4 (&vr)[2], int tid) {
#pragma unroll
    for (int i = 0; i < DK / 64; ++i) { const int c = tid + 512 * i, key = c / (DK / 8), ch = c % (DK / 8);
        const int w = key & 31, lr = (key & 32) + ((w >> 2) & 1) * 16 + (w >> 3) * 4 + (w & 3);
        *(LAS u32x4*)(kb + ((lr >> 4) * (DK / 32) + (ch >> 2)) * 1024 + k_swz((unsigned)((lr & 15) * 64 + (ch & 3) * 16))) = kr[i]; }
#pragma unroll
    for (int i = 0; i < 2; ++i) { const int c = tid + 512 * i, row = c >> 4, ch = c & 15; *(LAS u32x4*)(vb + offb((unsigned)row, (unsigned)ch)) = vr[i]; }
}
template <int DK>
__device__ __forceinline__ void attn_unit(LAS unsigned char* lds, int wave, int tid, const bf16* Q, int ldq, const bf16* K1, int ldk1, const bf16* K2, int ldk2, const bf16* V, int ldv,
                                          int s0_row, int s0_tiles, int s1_row, int s1_tiles, bool masked, int qpos0, int kpos0, float sink2, bool has_sink, bf16* O, int ldo) {
    constexpr int KS = DK / 32, KBYTES = 64 * DK * 2, BUF = KBYTES + 16384;
    const int lane = tid & 63, g = lane >> 4, i = lane & 15, q = i >> 2, p = i & 3;
    bf16x8 qf[KS];
    { const bf16* qp = Q + (size_t)(16 * wave + i) * ldq + g * 8;
#pragma unroll
      for (int ks = 0; ks < KS; ++ks) qf[ks] = *(const bf16x8*)(qp + ks * 32); }
    const unsigned koff = k_swz((unsigned)(i * 64 + g * 16));
    unsigned voff[2], vsw[2];
#pragma unroll
    for (int h = 0; h < 2; ++h) { voff[h] = 256u * (unsigned)(8 * g + 4 * h + q) + 8u * (unsigned)(p & 1); vsw[h] = (unsigned)((q << 2) | ((2 * g + h) & 3)); }
    f32x4 o[8];
#pragma unroll
    for (int d = 0; d < 8; ++d) o[d] = (f32x4){0.f, 0.f, 0.f, 0.f};
    float mrun = has_sink ? sink2 : -1e30f, lsum = (has_sink && g == 0) ? 1.f : 0.f;
    const int nt = s0_tiles + s1_tiles, tq = qpos0 + 16 * wave + i;
    u32x4 kr[2][DK / 64], vr[2][2];
    attn_stage_load<DK>(kr[0], vr[0], K1, ldk1, K2, ldk2, V, ldv, s0_row, tid);
    attn_stage_store<DK>(lds, lds + KBYTES, kr[0], vr[0], tid);
    { const int rown = 1 < s0_tiles ? s0_row + 64 : s1_row + 64 * (1 - s0_tiles); attn_stage_load<DK>(kr[1], vr[1], K1, ldk1, K2, ldk2, V, ldv, rown, tid); }
    asm volatile("s_waitcnt lgkmcnt(0)" ::: "memory"); __builtin_amdgcn_s_barrier();
    for (int t2 = 0; t2 < nt; t2 += 2) {
#pragma unroll
      for (int par = 0; par < 2; ++par) {
        const int t = t2 + par;
        if (t + 2 < nt) { const int tn = t + 2; const int rown = tn < s0_tiles ? s0_row + 64 * tn : s1_row + 64 * (tn - s0_tiles); attn_stage_load<DK>(kr[par], vr[par], K1, ldk1, K2, ldk2, V, ldv, rown, tid); }
        LAS unsigned char* kb = lds + par * BUF; LAS unsigned char* vb = kb + KBYTES;
        f32x4 s[2][2];
        constexpr int KQB = (KS <= 4) ? 2 : 1;
        bf16x8 kq[KQB][KS];
#define ATT_LOADK(blk, dst) _Pragma("unroll") for (int ks = 0; ks < KS; ++ks) dst[ks] = *(const LAS bf16x8*)(kb + ((blk) * KS + ks) * 1024 + koff)
        if (KQB == 2) { ATT_LOADK(0, kq[0]); }
#pragma unroll
        for (int bq = 0; bq < 4; ++bq) {
            if (KQB == 2) { if (bq < 3) { ATT_LOADK(bq + 1, kq[(bq + 1) & (KQB - 1)]); } } else { ATT_LOADK(bq, kq[0]); }
            __builtin_amdgcn_sched_barrier(0);
            f32x4 acc = (f32x4){0.f, 0.f, 0.f, 0.f};
#pragma unroll
            for (int ks = 0; ks < KS; ++ks) acc = __builtin_amdgcn_mfma_f32_16x16x32_bf16(kq[bq & (KQB - 1)][ks], qf[ks], acc, 0, 0, 0);
            s[bq >> 1][bq & 1] = acc;
            __builtin_amdgcn_sched_barrier(0);
        }
#undef ATT_LOADK
        bf16x8 vq[1][8];
#define ATT_LOADV(kh_, dst) _Pragma("unroll") for (int d = 0; d < 8; ++d) { \
            const s16x4 v0_ = __builtin_bit_cast(s16x4, __builtin_amdgcn_ds_read_tr16_b64_v4i16((LAS v4i16_t*)(vb + (kh_) * 8192 + voff[0] + 16u * ((unsigned)(2 * d + (p >> 1)) ^ vsw[0])))); \
            const s16x4 v1_ = __builtin_bit_cast(s16x4, __builtin_amdgcn_ds_read_tr16_b64_v4i16((LAS v4i16_t*)(vb + (kh_) * 8192 + voff[1] + 16u * ((unsigned)(2 * d + (p >> 1)) ^ vsw[1])))); \
            dst[d] = (bf16x8){v0_.x, v0_.y, v0_.z, v0_.w, v1_.x, v1_.y, v1_.z, v1_.w}; }
        if (KS <= 4) { ATT_LOADV(0, vq[0]); }
        __builtin_amdgcn_sched_barrier(0);
        if (masked && t < s0_tiles) { const int kp = kpos0 + 64 * t + 8 * g;
#pragma unroll
            for (int kh = 0; kh < 2; ++kh)
#pragma unroll
                for (int hi = 0; hi < 2; ++hi)
#pragma unroll
                    for (int e = 0; e < 4; ++e) { const int d = tq - (kp + 32 * kh + 4 * hi + e); if (d > 128 || d < -128) s[kh][hi][e] = -1e30f; } }
        float tm = fmaxf(fmaxf(fmaxf(s[0][0].x, s[0][0].y), fmaxf(s[0][0].z, s[0][0].w)), fmaxf(fmaxf(s[0][1].x, s[0][1].y), fmaxf(s[0][1].z, s[0][1].w)));
        tm = fmaxf(tm, fmaxf(fmaxf(fmaxf(s[1][0].x, s[1][0].y), fmaxf(s[1][0].z, s[1][0].w)), fmaxf(fmaxf(s[1][1].x, s[1][1].y), fmaxf(s[1][1].z, s[1][1].w))));
        tm = fmaxf(tm, shx(tm, 16, lane)); tm = fmaxf(tm, shx(tm, 32, lane));
        const float mnew = fmaxf(mrun, tm), alpha = __builtin_amdgcn_exp2f(mrun - mnew); mrun = mnew;
        float ps = 0.f; bf16x8 pf[2];
#pragma unroll
        for (int kh = 0; kh < 2; ++kh) { float pv[8];
#pragma unroll
            for (int hi = 0; hi < 2; ++hi)
#pragma unroll
                for (int e = 0; e < 4; ++e) { const float pe = __builtin_amdgcn_exp2f(s[kh][hi][e] - mnew); pv[hi * 4 + e] = pe; ps += pe; }
            u32x4 w; w.x = cvtpk(pv[0], pv[1]); w.y = cvtpk(pv[2], pv[3]); w.z = cvtpk(pv[4], pv[5]); w.w = cvtpk(pv[6], pv[7]); pf[kh] = __builtin_bit_cast(bf16x8, w); }
        lsum = lsum * alpha + ps;
#pragma unroll
        for (int d = 0; d < 8; ++d) o[d] = o[d] * alpha;
        if (KS > 4) { ATT_LOADV(0, vq[0]); __builtin_amdgcn_sched_barrier(0); }
#pragma unroll
        for (int d = 0; d < 8; ++d) o[d] = __builtin_amdgcn_mfma_f32_16x16x32_bf16(vq[0][d], pf[0], o[d], 0, 0, 0);
        __builtin_amdgcn_sched_barrier(0);
        ATT_LOADV(1, vq[0]);
        __builtin_amdgcn_sched_barrier(0);
#pragma unroll
        for (int d = 0; d < 8; ++d) o[d] = __builtin_amdgcn_mfma_f32_16x16x32_bf16(vq[0][d], pf[1], o[d], 0, 0, 0);
#undef ATT_LOADV
        if (t + 1 < nt) attn_stage_store<DK>(lds + (1 - par) * BUF, lds + (1 - par) * BUF + KBYTES, kr[1 - par], vr[1 - par], tid);
        asm volatile("s_waitcnt lgkmcnt(0)" ::: "memory"); __builtin_amdgcn_s_barrier();
      }
    }
    lsum += shx(lsum, 16, lane); lsum += shx(lsum, 32, lane);
    const float inv = 1.f / lsum;
    const int lane_e = tid_now(wave) & 63;
    bf16* op = O + (unsigned)((16 * wave + (lane_e & 15)) * ldo + 4 * (lane_e >> 4));
#pragma unroll
    for (int d = 0; d < 8; ++d) { u32x2 w; w.x = cvtpk(o[d].x * inv, o[d].y * inv); w.y = cvtpk(o[d].z * inv, o[d].w * inv); *(u32x2*)(op + 16 * d) = w; }
}
__device__ __forceinline__ void job_attn_c(ArgP a, int l, LAS unsigned char* lds, int wave, int u_first, int u_end, int u_stride) {
    const int tid = tid_now(wave); unsigned char* ws = a->ws;
    const bf16* Q = (const bf16*)(ws + WS_QC); const bf16* K = (const bf16*)(ws + WS_KC) + (size_t)l * MKV * 256; const bf16* V = (const bf16*)(ws + WS_VC) + (size_t)l * MKV * 256;
    bf16* O = (bf16*)(ws + WS_OC);
    for (int u = u_first; u < u_end; u += u_stride) {
        int h, m0, s0r, s0t, s1r, s1t, qp, kp; bool mk;
        if (u < 256) { const int b = u >> 6, qb = u & 7; h = (u >> 3) & 7; const int lo = qb * 128 - 128 < 0 ? 0 : qb * 128 - 128, hi = qb * 128 + 256 > 1024 ? 1024 : qb * 128 + 256;
            m0 = MC + b * 1024 + qb * 128; s0r = MC + b * 1024 + lo; s0t = (hi - lo) >> 6; s1r = MT + b * 256; s1t = 4; mk = true; qp = qb * 128; kp = lo; }
        else { const int v = u - 256, b = v >> 4, qb = v & 1; h = (v >> 1) & 7; m0 = b * 256 + qb * 128; s0r = b * 256; s0t = 4; s1r = 0; s1t = 0; mk = false; qp = 0; kp = 0; }
        const int kg = h >> 2;
        attn_unit<128>(lds, wave, tid, Q + (size_t)m0 * 1024 + h * 128, 1024, K + kg * 128, 256, nullptr, 0, V + kg * 128, 256, s0r, s0t, s1r, s1t, mk, qp, kp,
                       a->in[22][l * 8 + h] * LOG2E, true, O + (size_t)m0 * 1024 + h * 128, 1024);
    }
}
__device__ __forceinline__ void job_attn_b(ArgP a, int l, LAS unsigned char* lds, int wave) {
    const int tid = tid_now(wave); unsigned char* ws = a->ws;
    const bf16* Q = (const bf16*)(ws + WS_QF); const bf16* KV = (const bf16*)(ws + WS_KV); const bf16* KR = (const bf16*)(ws + WS_KR) + (size_t)l * MKV * 64;
    bf16* O = (bf16*)(ws + WS_OBB);
    for (int u = blockIdx.x; u < 512; u += gridDim.x) {
        int h, m0, s0r, s0t, s1r, s1t;
        if (u < 256) { const int b = u >> 6, qb = u & 7; h = (u >> 3) & 7; m0 = MC + b * 1024 + qb * 128; s0r = MC + b * 1024; s0t = 16; s1r = MT + b * 256; s1t = 4; }
        else { const int v = u - 256, b = v >> 4, qb = v & 1; h = (v >> 1) & 7; m0 = b * 256 + qb * 128; s0r = b * 256; s0t = 4; s1r = 0; s1t = 0; }
        attn_unit<192>(lds, wave, tid, Q + (size_t)m0 * 1536 + h * 192, 1536, KV + h * 128, 2048, KR, 64, KV + 1024 + h * 128, 2048, s0r, s0t, s1r, s1t, false, 0, 0, 0.f, false,
                       O + (size_t)m0 * 1024 + h * 128, 1024);
    }
}
constexpr int SC_QG = 0, SC_KG = 8192, SC_KD = 16384, SC_VV = 24576, SC_EL = 32768, SC_SEG = 33280, SC_BUF = 38912;
__device__ __forceinline__ bf16x8 tr2(LAS unsigned char* p0, LAS unsigned char* p1) {
    const s16x4 v0 = __builtin_bit_cast(s16x4, __builtin_amdgcn_ds_read_tr16_b64_v4i16((LAS v4i16_t*)p0));
    const s16x4 v1 = __builtin_bit_cast(s16x4, __builtin_amdgcn_ds_read_tr16_b64_v4i16((LAS v4i16_t*)p1));
    return (bf16x8){v0.x, v0.y, v0.z, v0.w, v1.x, v1.y, v1.z, v1.w};
}
struct ScanRegs { unsigned lg[4]; unsigned qv[4]; u32x4 vv; };
__device__ __forceinline__ void scan_stage_load(ScanRegs& R, const bf16* LG, const bf16* KK, const bf16* QA, const bf16* VA, int m0, int n, int dir, int h, int c, int wave, int lane, int tid) {
#pragma unroll
    for (int tt = 0; tt < 4; ++tt) { const int j = 32 * c + 4 * wave + tt; const size_t m = m0 + (dir ? n - 1 - j : j);
        R.lg[tt] = *(const unsigned*)(LG + m * 2048 + dir * 1024 + h * 128 + 2 * lane);
        R.qv[tt] = *(const unsigned*)(QA + m * 1024 + h * 128 + 2 * lane); }
    { const int j = 32 * c + (tid >> 4); const size_t m = m0 + (dir ? n - 1 - j : j); R.vv = *(const u32x4*)(VA + m * 1024 + h * 128 + (tid & 15) * 8); }
}
__device__ __forceinline__ void scan_stage_finish(const ScanRegs& R, LAS unsigned char* buf, int wave, int lane, int tid) {
    f32x2 cs[4]; cs[0] = (f32x2){bf_lo(R.lg[0]), bf_hi(R.lg[0])}; cs[1] = cs[0] + (f32x2){bf_lo(R.lg[1]), bf_hi(R.lg[1])}; cs[2] = cs[1] + (f32x2){bf_lo(R.lg[2]), bf_hi(R.lg[2])}; cs[3] = cs[2] + (f32x2){bf_lo(R.lg[3]), bf_hi(R.lg[3])};
    LAS f32x2* SEG = (LAS f32x2*)(buf + SC_SEG);
    SEG[wave * 64 + lane] = cs[3];
    asm volatile("s_waitcnt lgkmcnt(0)" ::: "memory"); __builtin_amdgcn_s_barrier();
    f32x2 pre = (f32x2){0.f, 0.f}, tot = (f32x2){0.f, 0.f};
#pragma unroll
    for (int s = 0; s < 8; ++s) { const f32x2 v = SEG[s * 64 + lane]; tot += v; if (s < wave) pre += v; }
#pragma unroll
    for (int tt = 0; tt < 4; ++tt) { const int j = 4 * wave + tt; const f32x2 G = pre + cs[tt];
        const float e0 = __expf(G.x), e1 = __expf(G.y), i0 = __expf(fminf(-G.x, 80.f)), i1 = __expf(fminf(-G.y, 80.f)), d0 = __expf(tot.x - G.x), d1 = __expf(tot.y - G.y);
        const float k0 = 1.f - __expf(bf_lo(R.lg[tt])), k1 = 1.f - __expf(bf_hi(R.lg[tt])), q0 = bf_lo(R.qv[tt]), q1 = bf_hi(R.qv[tt]);
        const unsigned o = offb((unsigned)j, (unsigned)(lane >> 2)) + 4u * (unsigned)(lane & 3);
        *(LAS unsigned*)(buf + SC_QG + o) = cvtpk(q0 * e0, q1 * e1);
        *(LAS unsigned*)(buf + SC_KG + o) = cvtpk(k0 * i0, k1 * i1);
        *(LAS unsigned*)(buf + SC_KD + o) = cvtpk(k0 * d0, k1 * d1); }
    *(LAS u32x4*)(buf + SC_VV + offb((unsigned)(tid >> 4), (unsigned)(tid & 15))) = R.vv;
    if (wave == 0) ((LAS f32x2*)(buf + SC_EL))[lane] = (f32x2){__expf(tot.x), __expf(tot.y)};
    asm volatile("s_waitcnt lgkmcnt(0)" ::: "memory"); __builtin_amdgcn_s_barrier();
}
__device__ __forceinline__ void scan_item(ArgP a, int l, int item, LAS unsigned char* lds, int wave, int tid) {
    const int lane = tid & 63, g = lane >> 4, i = lane & 15, q = i >> 2, p = i & 3;
    const int dir = item & 1, h = (item >> 1) & 7, sq = item >> 4;
    const bool lat = sq >= 16; const int n = lat ? 1024 : 256; const int m0 = lat ? MC + (sq - 16) * 1024 : sq * 256; const int nc = n >> 5;
    unsigned char* ws = a->ws;
    const bf16* QA = (const bf16*)(ws + WS_QA); const bf16* KK = (const bf16*)(ws + WS_KK); const bf16* VA = (const bf16*)(ws + WS_VA); const bf16* LG = (const bf16*)(ws + WS_LG);
    bf16* OO = (bf16*)(ws + (dir ? WS_OB : WS_OF));
    f32x4 S[8];
    if (lat) { const float* s0 = a->in[2] + ((((size_t)(sq - 16) * 4 + l) * 2 + dir) * 8 + h) * 16384 + 16 * wave + i;
#pragma unroll
        for (int aa = 0; aa < 8; ++aa)
#pragma unroll
            for (int e = 0; e < 4; ++e) S[aa][e] = s0[(16 * aa + 4 * g + e) * 128]; }
    else {
#pragma unroll
        for (int aa = 0; aa < 8; ++aa) S[aa] = (f32x4){0.f, 0.f, 0.f, 0.f}; }
    ScanRegs R0, R1;
    scan_stage_load(R0, LG, KK, QA, VA, m0, n, dir, h, 0, wave, lane, tid);
    scan_stage_load(R1, LG, KK, QA, VA, m0, n, dir, h, 1, wave, lane, tid);
    scan_stage_finish(R0, lds, wave, lane, tid);
    unsigned rro[2][4];
#pragma unroll
    for (int b = 0; b < 2; ++b)
#pragma unroll
        for (int ks = 0; ks < 4; ++ks) rro[b][ks] = offb((unsigned)(16 * b + i), (unsigned)(4 * ks + g));
    for (int c2 = 0; c2 < nc; c2 += 2) {
#pragma unroll
      for (int par = 0; par < 2; ++par) {
        const int c = c2 + par;
        const bool more = c + 1 < nc;
        if (c + 2 < nc) { if (par == 0) scan_stage_load(R0, LG, KK, QA, VA, m0, n, dir, h, c + 2, wave, lane, tid); else scan_stage_load(R1, LG, KK, QA, VA, m0, n, dir, h, c + 2, wave, lane, tid); }
        LAS unsigned char* buf = lds + par * SC_BUF;
        f32x4 at[2][2];
#pragma unroll
        for (int sb = 0; sb < 2; ++sb)
#pragma unroll
            for (int tb = 0; tb < 2; ++tb) at[sb][tb] = (f32x4){0.f, 0.f, 0.f, 0.f};
        { bf16x8 kf[4][2], qf[4][2];
#pragma unroll
          for (int ks = 0; ks < 4; ++ks)
#pragma unroll
              for (int b = 0; b < 2; ++b) { kf[ks][b] = *(const LAS bf16x8*)(buf + SC_KG + rro[b][ks]); qf[ks][b] = *(const LAS bf16x8*)(buf + SC_QG + rro[b][ks]); }
          __builtin_amdgcn_sched_barrier(0);
#pragma unroll
          for (int ks = 0; ks < 4; ++ks)
#pragma unroll
              for (int sb = 0; sb < 2; ++sb)
#pragma unroll
                  for (int tb = 0; tb < 2; ++tb) at[sb][tb] = __builtin_amdgcn_mfma_f32_16x16x32_bf16(kf[ks][sb], qf[ks][tb], at[sb][tb], 0, 0, 0); }
        bf16x8 pb[2];
#pragma unroll
        for (int tb = 0; tb < 2; ++tb) { float v[8];
#pragma unroll
            for (int sb = 0; sb < 2; ++sb)
#pragma unroll
                for (int e = 0; e < 4; ++e) v[sb * 4 + e] = (16 * sb + 4 * g + e > 16 * tb + i) ? 0.f : at[sb][tb][e];
            u32x4 w; w.x = cvtpk(v[0], v[1]); w.y = cvtpk(v[2], v[3]); w.z = cvtpk(v[4], v[5]); w.w = cvtpk(v[6], v[7]); pb[tb] = __builtin_bit_cast(bf16x8, w); }
        f32x4 ot[2];
        u32x4 qb[4][2];
        const bf16x8 vfi = tr2(buf + SC_VV + offb((unsigned)(4 * g + q), (unsigned)(2 * wave + (p >> 1))) + 8 * (p & 1), buf + SC_VV + offb((unsigned)(16 + 4 * g + q), (unsigned)(2 * wave + (p >> 1))) + 8 * (p & 1));
#pragma unroll
        for (int ks = 0; ks < 4; ++ks)
#pragma unroll
            for (int tb = 0; tb < 2; ++tb) {
                const u32x2 b0 = *(const LAS u32x2*)(buf + SC_QG + offb((unsigned)(16 * tb + i), (unsigned)(4 * ks + (g >> 1))) + 8 * (g & 1));
                const u32x2 b1 = *(const LAS u32x2*)(buf + SC_QG + offb((unsigned)(16 * tb + i), (unsigned)(4 * ks + 2 + (g >> 1))) + 8 * (g & 1));
                qb[ks][tb] = (u32x4){b0.x, b0.y, b1.x, b1.y}; }
        __builtin_amdgcn_sched_barrier(0);
#pragma unroll
        for (int tb = 0; tb < 2; ++tb) ot[tb] = __builtin_amdgcn_mfma_f32_16x16x32_bf16(vfi, pb[tb], (f32x4){0.f, 0.f, 0.f, 0.f}, 0, 0, 0);
#pragma unroll
        for (int ks = 0; ks < 4; ++ks) {
            u32x4 w; w.x = cvtpk(S[2 * ks].x, S[2 * ks].y); w.y = cvtpk(S[2 * ks].z, S[2 * ks].w); w.z = cvtpk(S[2 * ks + 1].x, S[2 * ks + 1].y); w.w = cvtpk(S[2 * ks + 1].z, S[2 * ks + 1].w);
            const bf16x8 sa = __builtin_bit_cast(bf16x8, w);
#pragma unroll
            for (int tb = 0; tb < 2; ++tb) ot[tb] = __builtin_amdgcn_mfma_f32_16x16x32_bf16(sa, __builtin_bit_cast(bf16x8, qb[ks][tb]), ot[tb], 0, 0, 0); }
        bf16x8 kdf[8]; f32x4 el[8];
        const bf16x8 vfu = tr2(buf + SC_VV + offb((unsigned)(8 * g + q), (unsigned)(2 * wave + (p >> 1))) + 8 * (p & 1), buf + SC_VV + offb((unsigned)(8 * g + 4 + q), (unsigned)(2 * wave + (p >> 1))) + 8 * (p & 1));
#pragma unroll
        for (int aa = 0; aa < 8; ++aa) { el[aa] = *(const LAS f32x4*)(buf + SC_EL + (16 * aa + 4 * g) * 4);
            kdf[aa] = tr2(buf + SC_KD + offb((unsigned)(8 * g + q), (unsigned)(2 * aa + (p >> 1))) + 8 * (p & 1), buf + SC_KD + offb((unsigned)(8 * g + 4 + q), (unsigned)(2 * aa + (p >> 1))) + 8 * (p & 1)); }
        __builtin_amdgcn_sched_barrier(0);
#pragma unroll
        for (int tb = 0; tb < 2; ++tb) { const int j = 32 * c + 16 * tb + i; const size_t m = m0 + (dir ? n - 1 - j : j);
            u32x2 w2; w2.x = cvtpk(ot[tb].x, ot[tb].y); w2.y = cvtpk(ot[tb].z, ot[tb].w); *(u32x2*)(OO + m * 1024 + h * 128 + 16 * wave + 4 * g) = w2; }
#pragma unroll
        for (int aa = 0; aa < 8; ++aa) S[aa] = __builtin_amdgcn_mfma_f32_16x16x32_bf16(kdf[aa], vfu, S[aa] * el[aa], 0, 0, 0);
        if (more) { if (par == 0) scan_stage_finish(R1, lds + SC_BUF, wave, lane, tid); else scan_stage_finish(R0, lds, wave, lane, tid); }
      }
    }
    if (!lat) { float* so = a->out + OUT_ST + ((((size_t)sq * 4 + l) * 2 + dir) * 8 + h) * 16384 + 16 * wave + i;
#pragma unroll
        for (int aa = 0; aa < 8; ++aa)
#pragma unroll
            for (int e = 0; e < 4; ++e) so[(16 * aa + 4 * g + e) * 128] = S[aa][e]; }
    __syncthreads();
}
__device__ __forceinline__ void job_oa_post(ArgP a, int l, int wave) {
    const int tidn = tid_now(wave), lane = tidn & 63;
    const int gw = blockIdx.x * 8 + wave, NGW = gridDim.x * 8;
    const bf16* OF = (const bf16*)(a->ws + WS_OF); const bf16* OB = (const bf16*)(a->ws + WS_OB); const bf16* AG = (const bf16*)(a->ws + WS_AG); bf16* O = (bf16*)(a->ws + WS_OA);
    const float* gn = a->in[17] + l * 128 + (lane & 7) * 16;
    for (int m = gw; m < MT; m += NGW) {
        const size_t o = (size_t)m * 1024 + lane * 16; f32x4 v[4]; float s = 0.f;
#pragma unroll
        for (int j = 0; j < 4; ++j) { const u32x2 fa = *(const u32x2*)(OF + o + 4 * j), fb = *(const u32x2*)(OB + o + 4 * j); v[j] = (f32x4){bf_lo(fa.x) + bf_lo(fb.x), bf_hi(fa.x) + bf_hi(fb.x), bf_lo(fa.y) + bf_lo(fb.y), bf_hi(fa.y) + bf_hi(fb.y)}; s += (v[j].x * v[j].x + v[j].y * v[j].y) + (v[j].z * v[j].z + v[j].w * v[j].w); }
        s += shx(s, 1, lane); s += shx(s, 2, lane); s += shx(s, 4, lane);
        const float rs = rsq_(s * (1.f / 128.f) + EPS);
        const u32x4 g0 = *(const u32x4*)(AG + o), g1 = *(const u32x4*)(AG + o + 8);
        const unsigned gg[8] = {g0.x, g0.y, g0.z, g0.w, g1.x, g1.y, g1.z, g1.w};
        unsigned ow[8];
#pragma unroll
        for (int j = 0; j < 4; ++j) { const f32x4 w = *(const f32x4*)(gn + 4 * j); const f32x4 r = v[j] * rs * w;
            ow[2 * j] = pk2(r.x * bf_lo(gg[2 * j]), r.y * bf_hi(gg[2 * j])); ow[2 * j + 1] = pk2(r.z * bf_lo(gg[2 * j + 1]), r.w * bf_hi(gg[2 * j + 1])); }
        *(u32x4*)(O + o) = (u32x4){ow[0], ow[1], ow[2], ow[3]}; *(u32x4*)(O + o + 8) = (u32x4){ow[4], ow[5], ow[6], ow[7]};
    }
}
constexpr int PH_PER_LAYER = 7, PH_PRE = 3, PH_TOTAL = PH_PRE + NL * PH_PER_LAYER;
__global__ void __launch_bounds__(512, 2) mega(Args args) {
    extern __shared__ __attribute__((aligned(16))) unsigned char lds_raw[];
    LAS unsigned char* lds = (LAS unsigned char*)lds_raw;
    const int tid = threadIdx.x, lane = tid & 63, wave = __builtin_amdgcn_readfirstlane(tid >> 6);
    volatile LAS unsigned* MISC = (volatile LAS unsigned*)(lds + MISC_OFF);
    for (int u = tid; u < (LDS_BYTES - LDSCTL_OFF) / 4; u += 512) ((LAS unsigned*)(lds + LDSCTL_OFF))[u] = 0u;
    __syncthreads();
    unsigned* barw = (unsigned*)(args.ws + WS_CTL) + CW_BAR;
    XcdBarrier bar; bar.bar = barw; bar.x = 0; bar.st = nullptr;
    if (args.use_bar) bar = xcd_barrier_post(barw, MISC + 8);
    const int lo = args.ph_lo, hi = args.ph_hi;
#ifndef PHMASK
#define PHMASK 0xFFFF
#endif
#define EN(j) ((PHMASK >> (j)) & 1)
#ifndef P2MASK
#define P2MASK 0xFF
#endif
#define P2EN(j) ((P2MASK >> (j)) & 1)
#ifndef DUPMASK
#define DUPMASK 0
#endif
#define REP(j) for (int rep_ = 0; rep_ < 1 + ((DUPMASK >> (j)) & 1); ++rep_)
#define IN(k) (lo <= (k) && (k) < hi)
#define SEAM(k) do { if (IN((k) + 1)) xcd_barrier(bar); } while (0)
    const int G = gridDim.x, bx = blockIdx.x;
#define LAUNDER(p) asm volatile("" : "+s"(p))

    if (EN(0) && IN(0)) { ArgP ap = (ArgP)__builtin_amdgcn_kernarg_segment_ptr(); LAUNDER(ap); REP(0) { phase_prologue(ap, lds, wave); } SEAM(0); }
    if (EN(1) && IN(1)) { ArgP ap = (ArgP)__builtin_amdgcn_kernarg_segment_ptr(); LAUNDER(ap); REP(1) { phase_modreduce(ap, wave); } SEAM(1); }
    if (EN(2) && IN(2)) { ArgP ap = (ArgP)__builtin_amdgcn_kernarg_segment_ptr(); LAUNDER(ap); REP(2) { phase_h0(ap, wave); } SEAM(2); }

    for (int l = 0; l < NL; ++l) {
        const int pb = PH_PRE + l * PH_PER_LAYER;
        if (EN(3) && IN(pb + 0)) { ArgP ap = (ArgP)__builtin_amdgcn_kernarg_segment_ptr(); LAUNDER(ap); unsigned char* ws = ap->ws; unsigned char* wl = ws + WS_W + (size_t)l * WL_STRIDE; float* outp = ap->out; REP(3) {
            pg8::Gemm g{(const bf16*)(ws + WS_H), (const bf16*)(wl + WO_IN), MT, NINP, D, D, nullptr, nullptr, nullptr, nullptr}; int bxl = bx, Gl = G; asm volatile("" : "+s"(bxl), "+s"(Gl)); pg8::StaticOrder S; S.init(MT, NINP, Gl, bxl);
            EpiWin E{ws, outp, l}; pg8::gemm_phase(lds, g, S, E, wave);
            }
            SEAM(pb + 0);
        }
        if (EN(4) && IN(pb + 1)) { ArgP ap = (ArgP)__builtin_amdgcn_kernarg_segment_ptr(); LAUNDER(ap); unsigned char* ws = ap->ws; unsigned char* wl = ws + WS_W + (size_t)l * WL_STRIDE; float* outp = ap->out; REP(4) {
            if (bx >= 64) { const int cb = bx - 64, GB = G - 64;
                if (P2EN(0)) { pg8::Gemm g{(const bf16*)(ws + WS_BQ), (const bf16*)(wl + WO_UQ), MT, 1536, 512, 512, nullptr, nullptr, nullptr, nullptr}; pg8::StaticOrder S; S.init(MT, 1536, GB, cb); EpiUq E{ws}; pg8::gemm_phase(lds, g, S, E, wave); }
                LAUNDER(ap); ws = ap->ws; wl = ws + WS_W + (size_t)l * WL_STRIDE;
                if (P2EN(1)) { pg8::Gemm g{(const bf16*)(ws + WS_BKV) + (size_t)l * MKV * 256, (const bf16*)(wl + WO_UKV), MKV, 2048, 256, 256, nullptr, nullptr, nullptr, nullptr}; pg8::StaticOrder S; S.init(MKV, 2048, GB, cb); EpiKv E{ws}; pg8::gemm_phase(lds, g, S, E, wave); }
                __syncthreads();
                LAUNDER(ap);
                if (P2EN(3)) { scan_item(ap, l, cb, lds, wave, tid_now(wave)); if (cb >= 96 && cb < 160) scan_item(ap, l, 192 + (cb - 96), lds, wave, tid_now(wave)); }
                __syncthreads();
                LAUNDER(ap);
            } else {
                if (P2EN(3)) scan_item(ap, l, 256 + bx, lds, wave, tid_now(wave));
            }
            __syncthreads();
            LAUNDER(ap);
            if (P2EN(2) && rep_ == 0) job_ckv_norm(ap, l, wave);
            }
            SEAM(pb + 1);
        }
        if (EN(5) && IN(pb + 2)) { ArgP ap = (ArgP)__builtin_amdgcn_kernarg_segment_ptr(); LAUNDER(ap); unsigned char* ws = ap->ws; unsigned char* wl = ws + WS_W + (size_t)l * WL_STRIDE; float* outp = ap->out; REP(5) {
            job_attn_c(ap, l, lds, wave, bx, 512, G);
            LAUNDER(ap);
            job_attn_b(ap, l, lds, wave);
            LAUNDER(ap);
            job_oa_post(ap, l, wave);
            }
            SEAM(pb + 2);
        }
        if (EN(6) && IN(pb + 3)) { ArgP ap = (ArgP)__builtin_amdgcn_kernarg_segment_ptr(); LAUNDER(ap); unsigned char* ws = ap->ws; unsigned char* wl = ws + WS_W + (size_t)l * WL_STRIDE; float* outp = ap->out; REP(6) {
            pg8::StaticOrder S; S.init(MT, D, G, bx);
            { pg8::Gemm g{(const bf16*)(ws + WS_OA), (const bf16*)(wl + WO_A), MT, D, 1024, 1024, (const bf16*)(ws + WS_OBB), (const bf16*)(wl + WO_B), (const bf16*)(ws + WS_OC), (const bf16*)(wl + WO_C)}; EpiBranch E{ws}; pg8::gemm_phase(lds, g, S, E, wave); }
            }
            SEAM(pb + 3);
        }
        if (EN(7) && IN(pb + 4)) { ArgP ap = (ArgP)__builtin_amdgcn_kernarg_segment_ptr(); LAUNDER(ap); unsigned char* ws = ap->ws; unsigned char* wl = ws + WS_W + (size_t)l * WL_STRIDE; float* outp = ap->out;
            pg8::Gemm g{(const bf16*)(ws + WS_MG), (const bf16*)(wl + WO_O), MT, D, D, D, nullptr, nullptr, nullptr, nullptr}; pg8::StaticOrder S; S.init(MT, D, G, bx);
            const float* x0 = (l == 0) ? ap->in[0] : outp; const float* x1 = (l == 0) ? ap->in[1] : outp + (size_t)MC * D;
            if (l == 0) { EpiResid<0, true> E{ws, outp, x0, x1, ap->in[12] + l * D, ap->in[13] + l * D, l, 1}; pg8::gemm_phase(lds, g, S, E, wave); }
            else { EpiResid<0, false> E{ws, outp, x0, x1, ap->in[12] + l * D, ap->in[13] + l * D, l, 1}; pg8::gemm_phase(lds, g, S, E, wave); }
            SEAM(pb + 4);
        }
        if (EN(9) && IN(pb + 5)) { ArgP ap = (ArgP)__builtin_amdgcn_kernarg_segment_ptr(); LAUNDER(ap); unsigned char* ws = ap->ws; unsigned char* wl = ws + WS_W + (size_t)l * WL_STRIDE; float* outp = ap->out; REP(9) {
            pg8::Gemm g{(const bf16*)(ws + WS_H), (const bf16*)(wl + WO_UP), MT, NUP, D, D, nullptr, nullptr, nullptr, nullptr}; pg8::SplitOrder S; S.init(MT, NUP, G, bx);
            EpiUp E{ws, ap->in[28] + (size_t)l * 3 * NUP, lds + HALO_OFF, l}; pg8::gemm_phase(lds, g, S, E, wave);
            }
            SEAM(pb + 5);
        }
        if (EN(11) && IN(pb + 6)) { ArgP ap = (ArgP)__builtin_amdgcn_kernarg_segment_ptr(); LAUNDER(ap); unsigned char* ws = ap->ws; unsigned char* wl = ws + WS_W + (size_t)l * WL_STRIDE; float* outp = ap->out;
            pg8::Gemm g{(const bf16*)(ws + WS_ACT), (const bf16*)(wl + WO_DN), MT, D, DFF, DFF, nullptr, nullptr, nullptr, nullptr}; pg8::StaticOrder S; S.init(MT, D, G, bx);
            { Unit u0; if (S.next(0, u0)) conv_fixup(ap, l, u0.pm, wave); }
            LAUNDER(ap); ws = ap->ws; wl = ws + WS_W + (size_t)l * WL_STRIDE; outp = ap->out;
            const int nx = (l < NL - 1) ? 1 : 0;
            EpiResid<1, false> E{ws, outp, outp, outp + (size_t)MC * D, ap->in[14] + l * D, ap->in[11] + (nx ? l + 1 : l) * D, l, nx}; pg8::gemm_phase(lds, g, S, E, wave);
            if (l < NL - 1) SEAM(pb + 6);
        }
    }
#undef IN
#undef SEAM
}

extern "C" void kernel_launch(void* const* d_in, const int* in_sizes, int n_in, void* d_out, int out_size, void* d_ws, size_t ws_size, hipStream_t stream) {
    static int grid = 0;
    if (grid == 0) {
        if (n_in != 30 || (size_t)out_size != OUT_END || ws_size < WS_END) { fprintf(stderr, "kernel_launch: unexpected sizes n_in %d out %d ws %zu\n", n_in, out_size, ws_size); grid = -1; return; }
        int dev = 0, cus = 0, per_cu = 0;
        if (hipGetDevice(&dev) != hipSuccess || hipDeviceGetAttribute(&cus, hipDeviceAttributeMultiprocessorCount, dev) != hipSuccess) { grid = -1; return; }
        if (hipFuncSetAttribute((const void*)mega, hipFuncAttributeMaxDynamicSharedMemorySize, LDS_BYTES) != hipSuccess) { fprintf(stderr, "kernel_launch: hipFuncSetAttribute failed\n"); grid = -1; return; }
        if (hipOccupancyMaxActiveBlocksPerMultiprocessor(&per_cu, (const void*)mega, 512, LDS_BYTES) != hipSuccess || per_cu < 1) fprintf(stderr, "kernel_launch: occupancy query reports %d\n", per_cu);
        (void)hipGetLastError();
        grid = cus;
    }
    if (grid < 0) return;
    (void)hipMemsetAsync((char*)d_ws + WS_CTL, 0, CTL_ZERO_BYTES, stream);
    Args a{};
    for (int i = 0; i < 30; ++i) a.in[i] = (const float*)d_in[i];
    a.out = (float*)d_out; a.ws = (unsigned char*)d_ws; a.pad = 0;
#if MK_ONE_LAUNCH
    a.ph_lo = 0; a.ph_hi = PH_TOTAL; a.use_bar = 1;
    hipLaunchKernelGGL(mega, dim3(grid), dim3(512), LDS_BYTES, stream, a);
#else
    a.use_bar = 0;
    for (int p = 0; p < PH_TOTAL; ++p) { a.ph_lo = p; a.ph_hi = p + 1; hipLaunchKernelGGL(mega, dim3(grid), dim3(512), LDS_BYTES, stream, a); }
#endif
}
```

```cpp
#include <hip/hip_runtime.h>
#include <cstdio>
#include <cstdint>

#ifndef MK_ONE_LAUNCH
#define MK_ONE_LAUNCH 1
#endif

#define GAS __attribute__((address_space(1)))
#define LAS __attribute__((address_space(3)))
typedef unsigned short bf16;
typedef short bf16x8 __attribute__((ext_vector_type(8)));
typedef float f32x4 __attribute__((ext_vector_type(4)));
typedef float f32x2 __attribute__((ext_vector_type(2)));
typedef unsigned u32x4 __attribute__((ext_vector_type(4)));
typedef unsigned u32x2 __attribute__((ext_vector_type(2)));
typedef GAS unsigned gu32;

constexpr int D = 2048, NL = 4, MC = 4096, MT = 8192, MKV = 9216;
constexpr int NIN = 13632, NINP = 13824, DFF = 5504, NUP = 11008;
constexpr float EPS = 1e-6f;
constexpr float SCALE_B = 0.07216878364870322f;
constexpr float SCALE_C = 0.08838834764831845f;

constexpr size_t OUT_Y = 0, OUT_ST = 16777216, OUT_CKV = OUT_ST + 16777216, OUT_KR = OUT_CKV + 4194304, OUT_K = OUT_KR + 1048576, OUT_V = OUT_K + 4194304, OUT_END = OUT_V + 4194304;

constexpr size_t MiB = 1u << 20;
constexpr size_t WS_CTL = 0, CTL_ZERO_BYTES = 1 * MiB;
constexpr size_t WS_MODP = 2 * MiB;
constexpr size_t WS_MOD = 18 * MiB;
constexpr size_t WS_LB = 19 * MiB;
constexpr size_t WS_ROPE = 19 * MiB + 512 * 1024;
constexpr size_t WS_SSQQ = 20 * MiB;
constexpr size_t WS_SSQKV = 20 * MiB + 512 * 1024;
constexpr size_t WS_SSQX = 21 * MiB;
constexpr size_t WS_XCH = 21 * MiB + 512 * 1024;
constexpr size_t WS_CV1 = 22 * MiB;
constexpr size_t WS_CV2 = 24 * MiB;
constexpr size_t WS_W = 32 * MiB, WL_STRIDE = 141 * MiB;
constexpr size_t WO_IN = 0, WO_UQ = 54 * MiB, WO_UKV = WO_UQ + 3 * MiB / 2, WO_A = WO_UKV + 1 * MiB, WO_B = WO_A + 4 * MiB, WO_C = WO_B + 4 * MiB, WO_O = WO_C + 4 * MiB, WO_UP = WO_O + 8 * MiB, WO_DN = WO_UP + 43 * MiB;
static_assert(WO_DN + (size_t)2048 * DFF * 2 <= WL_STRIDE, "weights per layer");
constexpr size_t WS_BKV = 596 * MiB;
constexpr size_t WS_KR = 614 * MiB;
constexpr size_t WS_KC = 619 * MiB;
constexpr size_t WS_VC = 637 * MiB;
constexpr size_t WS_H = 656 * MiB;
constexpr size_t WS_QA = 688 * MiB;
constexpr size_t WS_LG = 704 * MiB;
constexpr size_t WS_KK = 768 * MiB;
constexpr size_t WS_VA = 800 * MiB;
constexpr size_t WS_AG = 816 * MiB;
constexpr size_t WS_BQ = 832 * MiB;
constexpr size_t WS_QC = 840 * MiB;
constexpr size_t WS_GT = 856 * MiB;
constexpr size_t WS_QF = 952 * MiB;
constexpr size_t WS_KV = 976 * MiB;
constexpr size_t WS_OF = 1012 * MiB;
constexpr size_t WS_OB = 1044 * MiB;
constexpr size_t WS_OA = 1076 * MiB;
constexpr size_t WS_OBB = 1092 * MiB;
constexpr size_t WS_OC = 1108 * MiB;
constexpr size_t WS_MS = 1124 * MiB;
constexpr size_t WS_MG = 1188 * MiB;
constexpr size_t WS_Y = 1220 * MiB;
constexpr size_t WS_HALO = 1220 * MiB;
constexpr size_t WS_U = 688 * MiB;
constexpr size_t WS_ACT = 860 * MiB;
constexpr size_t WS_XB = 1284 * MiB;
constexpr size_t WS_END = 1316 * MiB;
static_assert(WS_U + (size_t)MT * NUP * 2 <= WS_ACT && WS_ACT + (size_t)MT * DFF * 2 <= WS_QF, "ffn overlay");

constexpr int CW_TMO = 0, CW_BAR = 4096, CW_CNT = 16384, CW_SPL = 65536;
constexpr size_t WS_SPL = 704 * MiB;

constexpr int RING_BYTES = 131072, LDSCTL_OFF = RING_BYTES, MISC_OFF = LDSCTL_OFF + 320, HALO_OFF = RING_BYTES + 1024, LDS_BYTES = 147456;

#define RLX_AGENT __ATOMIC_RELAXED, __HIP_MEMORY_SCOPE_AGENT
#define LDS_WAIT() asm volatile("s_waitcnt lgkmcnt(0)" ::: "memory")
#define VM_WAIT() asm volatile("s_waitcnt vmcnt(0)" ::: "memory")
__host__ __device__ __forceinline__ unsigned f2bf(float f) { unsigned u = __builtin_bit_cast(unsigned, f); return (u + 0x7fffu + ((u >> 16) & 1u)) >> 16; }
typedef float f32x2c_t __attribute__((ext_vector_type(2)));
typedef __bf16 bf16x2c_t __attribute__((ext_vector_type(2)));
__device__ __forceinline__ unsigned pk2(float lo, float hi) { const f32x2c_t v = {lo, hi}; const bf16x2c_t b = __builtin_convertvector(v, bf16x2c_t); return __builtin_bit_cast(unsigned, b); }
__device__ __forceinline__ float bf_lo(unsigned u) { return __builtin_bit_cast(float, u << 16); }
__device__ __forceinline__ float bf_hi(unsigned u) { return __builtin_bit_cast(float, u & 0xffff0000u); }
__device__ __forceinline__ float bf2f(bf16 b) { return __builtin_bit_cast(float, (unsigned)b << 16); }
__device__ __forceinline__ float sigmoidf_(float x) { return __builtin_amdgcn_rcpf(1.f + __expf(-x)); }
__device__ __forceinline__ float rsq_(float x) { return __builtin_amdgcn_rsqf(x); }
__device__ __forceinline__ float shx(float v, int mask, int lane) { return __builtin_bit_cast(float, __builtin_amdgcn_ds_bpermute((lane ^ mask) << 2, __builtin_bit_cast(int, v))); }
__device__ __forceinline__ float wave_sum(float v, int lane) {
#pragma unroll
    for (int o = 1; o < 64; o <<= 1) v += shx(v, o, lane);
    return v;
}
__device__ __forceinline__ int tid_now(int wave) { int t; asm volatile("v_mbcnt_lo_u32_b32 %0, -1, 0\n\tv_mbcnt_hi_u32_b32 %0, -1, %0" : "=v"(t)); return wave * 64 + t; }
#define XB_TMO      128
#define XB_XCNT(j)  (256  + 64 * (j))
#define XB_XSUB(j)  (1280 + 64 * (j))
#define XB_XGEN(j)  (2304 + 64 * (j))
#define XB_TOP      3328
#define XB_TOPGEN   3392
#define XCD_BAR_WORDS 3456
#define XB_SPIN_CAP (1u << 22)
__device__ __forceinline__ unsigned xb_ld(unsigned* p)              { return __hip_atomic_load(p, __ATOMIC_RELAXED, __HIP_MEMORY_SCOPE_AGENT); }
__device__ __forceinline__ unsigned xb_add(unsigned* p, unsigned v) { return __hip_atomic_fetch_add(p, v, __ATOMIC_RELAXED, __HIP_MEMORY_SCOPE_AGENT); }
__device__ __forceinline__ unsigned xb_xcc_id() { return (unsigned)__builtin_amdgcn_s_getreg((3 << 11) | 20) & 0xFu; }
#define XB_SPIN(cond, bar) do { unsigned _sp = 0; while (cond) { __builtin_amdgcn_s_sleep(1); \
    if ((++_sp & 255u) == 0u) { if (xb_ld(&(bar)[XB_TMO])) break; if (_sp > XB_SPIN_CAP) { atomicAdd(&(bar)[XB_TMO], 1u); break; } } } } while (0)
struct XcdBarrier { unsigned* bar; unsigned x; volatile LAS unsigned* st; };
__device__ __forceinline__ XcdBarrier xcd_barrier_post(unsigned* bar, volatile LAS unsigned* st) {
    XcdBarrier b; b.bar = bar; b.x = xb_xcc_id(); b.st = st;
    if (threadIdx.x == 0) (void)xb_add(&bar[XB_XCNT(b.x)], 1u);
    return b;
}
__device__ __forceinline__ void xcd_barrier_complete(unsigned* bar, unsigned x, unsigned& nloc, unsigned& nx) {
    const unsigned G = gridDim.x * gridDim.y * gridDim.z;
    unsigned sum, cnt, mine, sp = 0u;
    for (;;) {
        sum = 0u; cnt = 0u; mine = 0u;
#pragma unroll
        for (unsigned j = 0; j < 16; ++j) { const unsigned c = xb_ld(&bar[XB_XCNT(j)]); sum += c; cnt += (c > 0u) ? 1u : 0u; mine = (j == x) ? c : mine; }
        if (sum == G) break;
        __builtin_amdgcn_s_sleep(1);
        if ((++sp & 255u) == 0u) { if (xb_ld(&bar[XB_TMO])) break; if (sp > XB_SPIN_CAP) { atomicAdd(&bar[XB_TMO], 1u); break; } }
    }
    nloc = mine > 0u ? mine : 1u; nx = cnt > 0u ? cnt : 1u;
}
__device__ __forceinline__ void xcd_barrier(const XcdBarrier& b) {
    asm volatile("s_waitcnt vmcnt(0)" ::: "memory");
    __syncthreads();
    if (threadIdx.x == 0) {
        unsigned* bar = b.bar;
        __builtin_amdgcn_s_waitcnt(0);
        unsigned nloc = b.st[0], nx = b.st[1];
        if (nloc == 0u) { xcd_barrier_complete(bar, b.x, nloc, nx); b.st[0] = nloc; b.st[1] = nx; }
        const unsigned old = xb_add(&bar[XB_XSUB(b.x)], 1u);
        const unsigned gen = old / nloc;
        if (old + 1u == (gen + 1u) * nloc) {
            __builtin_amdgcn_fence(__ATOMIC_RELEASE, "agent");
            asm volatile("s_waitcnt vmcnt(0)" ::: "memory");
            const unsigned og = xb_add(&bar[XB_TOP], 1u);
            const unsigned tg = og / nx;
            if (og + 1u == (tg + 1u) * nx) xb_add(&bar[XB_TOPGEN], 1u);
            else XB_SPIN(xb_ld(&bar[XB_TOPGEN]) == tg, bar);
            __builtin_amdgcn_fence(__ATOMIC_ACQUIRE, "agent");
            xb_add(&bar[XB_XGEN(b.x)], 1u);
            asm volatile("s_waitcnt vmcnt(0)" ::: "memory");
        } else {
            XB_SPIN(xb_ld(&bar[XB_XGEN(b.x)]) == gen, bar);
            __builtin_amdgcn_fence(__ATOMIC_ACQUIRE, "agent");
            asm volatile("s_waitcnt vmcnt(0)" ::: "memory");
        }
    }
    __syncthreads();
}

namespace pg8 {
constexpr int BM = 256, BK = 64, HALF = 128, HTB = HALF * BK * 2, NXCD = 8, WGM = 4;
__host__ __device__ __forceinline__ int lds_byte(int r, int c) { const int st = (r >> 4) * 2 + (c >> 5), rr = r & 15, cc = c & 31, ob = rr * 64 + cc * 2; return st * 1024 + (ob ^ (((ob >> 9) & 1) << 5)); }
__host__ __device__ __forceinline__ void stage_rc(int b, int& R, int& C) { const int st = b / 1024, sb = b % 1024, swz = sb ^ (((sb >> 9) & 1) << 5); R = (st >> 1) * 16 + swz / 64; C = (st & 1) * 32 + (swz % 64) / 2; }
__host__ __device__ __forceinline__ int perm32(int rho) { const int n = rho >> 4, i = rho & 15; return 8 * (i >> 2) + 4 * n + (i & 3); }
struct Unit { int pm, pn, sub; };
struct Gemm { const bf16* A; const bf16* Bt; int M, N, K, lda; const bf16* A1; const bf16* Bt1; const bf16* A2; const bf16* Bt2; };
struct StaticOrder {
    static constexpr bool SPLIT = false;
    int nM, nN, nwg, G, c;
    __device__ __forceinline__ void init(int M, int N, int G_, int c_) { nM = M / BM; nN = N / BM; nwg = nM * nN; G = G_; c = c_; }
    __device__ __forceinline__ bool next(int i, Unit& u) const {
        const long L = (long)i * G + c; if (L >= nwg) return false;
        int wgid = (int)L; { const int q = nwg / NXCD, r = nwg % NXCD, xcd = wgid % NXCD, off = wgid / NXCD; wgid = (xcd < r ? xcd * (q + 1) : r * (q + 1) + (xcd - r) * q) + off; }
        const int nig = WGM * nN, gid = wgid / nig, fm = gid * WGM, gsz = (nM - fm) < WGM ? (nM - fm) : WGM;
        u.pm = fm + ((wgid % nig) % gsz); u.pn = (wgid % nig) / gsz; u.sub = 0; return true;
    }
};
struct SplitOrder {
    static constexpr bool SPLIT = true;
    int nM, nN, nwg, G, c, nfull, tail;
    __device__ __forceinline__ void init(int M, int N, int G_, int c_) { nM = M / BM; nN = N / BM; nwg = nM * nN; G = G_; c = c_; nfull = (nwg / G) * G; tail = nwg - nfull; if (2 * tail > G) { nfull = nwg; tail = 0; } }
    __device__ __forceinline__ bool next(int i, Unit& u) const {
        long L = (long)i * G + c; int sub = 0;
        if (L >= nfull) { if (tail == 0 || i != nfull / G || c >= 2 * tail) return false; const int j = (c >= tail) ? c - tail : c; sub = (c >= tail) ? 2 * j + 1 : 2 * j + 2; L = nfull + j; }
        int wgid = (int)L; { const int q = nwg / NXCD, r = nwg % NXCD, xcd = wgid % NXCD, off = wgid / NXCD; wgid = (xcd < r ? xcd * (q + 1) : r * (q + 1) + (xcd - r) * q) + off; }
        const int nig = WGM * nN, gid = wgid / nig, fm = gid * WGM, gsz = (nM - fm) < WGM ? (nM - fm) : WGM;
        u.pm = fm + ((wgid % nig) % gsz); u.pn = (wgid % nig) / gsz; u.sub = sub; return true;
    }
};
template <class Epi, class Ord>
__device__ __forceinline__ void gemm_phase(LAS unsigned char* lds, const Gemm g, const Ord& S, const Epi& E, int wave) {
    constexpr bool SPL = Ord::SPLIT;
    const int tid = tid_now(wave), wid = __builtin_amdgcn_readfirstlane(tid >> 6), lane = tid & 63, wr = wid >> 2, wc = wid & 3, fr = lane & 15, fq = lane >> 4;
    const int K = g.K, nt = K / BK, lda = g.lda;
    unsigned voffA[2], voffB[2];
#pragma unroll
    for (int i = 0; i < 2; ++i) { int R, C; stage_rc(tid * 16 + i * 8192, R, C); const int Rb = (R & ~31) + perm32(R & 31);
        voffA[i] = (unsigned)(R * lda + C) * 2u; voffB[i] = (unsigned)(Rb * K + C) * 2u; }
    const size_t kstep = (size_t)(BK * 2);
    const size_t hstepA = (size_t)HALF * lda * 2, hstepB = (size_t)HALF * K * 2;
    const size_t tstepA = 2 * hstepA, tstepB = 2 * hstepB;
    const unsigned ldsw = (unsigned)wid * 1024u;
    const int aoff = lds_byte(wr * 64 + fr, fq * 8), boff = lds_byte(wc * 32 + fr, fq * 8);
#define PG8_SA(b, h) (((b) * 2 + (h)) * HTB)
#define PG8_SB(b, h) ((4 + (b) * 2 + (h)) * HTB)
#define PG8_STAGE(bufoff, gbase, voff) do { _Pragma("unroll") for (int _i = 0; _i < 2; ++_i) \
        __builtin_amdgcn_global_load_lds((const unsigned*)((const char*)(gbase) + (voff)[_i]), (LAS unsigned*)(lds + (bufoff) + ldsw + _i * 8192), 16, 0, 0); } while (0)
#define PG8_LDA(dst, b, h) do { _Pragma("unroll") for (int m = 0; m < 4; ++m) _Pragma("unroll") for (int k = 0; k < 2; ++k) dst[m][k] = *(const LAS bf16x8*)(lds + PG8_SA(b, h) + aoff + m * 2048 + k * 1024); } while (0)
#define PG8_LDB(dst, b, h) do { _Pragma("unroll") for (int n = 0; n < 2; ++n) _Pragma("unroll") for (int k = 0; k < 2; ++k) dst[n][k] = *(const LAS bf16x8*)(lds + PG8_SB(b, h) + boff + n * 2048 + k * 1024); } while (0)
#define PG8_MMA(ai, bj, At, Bt) do { __builtin_amdgcn_s_setprio(1); _Pragma("unroll") for (int m = 0; m < 4; ++m) _Pragma("unroll") for (int n = 0; n < 2; ++n) _Pragma("unroll") for (int k = 0; k < 2; ++k) \
        acc[ai][bj][m][n] = __builtin_amdgcn_mfma_f32_16x16x32_bf16(Bt[n][k], At[m][k], acc[ai][bj][m][n], 0, 0, 0); __builtin_amdgcn_s_setprio(0); } while (0)
#define PG8_WAIT_V(n) asm volatile("s_waitcnt vmcnt(" #n ")" ::: "memory")
#define PG8_WAIT_L(n) asm volatile("s_waitcnt lgkmcnt(" #n ")" ::: "memory")
#define PG8_BAR __builtin_amdgcn_s_barrier()
#define PG8_SCHED __builtin_amdgcn_sched_barrier(0)
    constexpr int CH = Epi::CHAIN;
    Unit cur, nxt; int ui = 0;
    if (!S.next(0, cur)) return;
    f32x4 acc[2][2][4][2];
#pragma unroll
    for (int a = 0; a < 2; ++a)
#pragma unroll
        for (int b = 0; b < 2; ++b)
#pragma unroll
            for (int m = 0; m < 4; ++m)
#pragma unroll
                for (int n = 0; n < 2; ++n) acc[a][b][m][n] = (f32x4){0.f, 0.f, 0.f, 0.f};
    bf16x8 At[4][2], B0[2][2], B1[2][2];
#define PG8_AP(sub) ((const char*)((CH == 1 || (sub) == 0) ? g.A : ((sub) == 1 ? g.A1 : g.A2)))
#define PG8_BP(sub) ((const char*)((CH == 1 || (sub) == 0) ? g.Bt : ((sub) == 1 ? g.Bt1 : g.Bt2)))
#define PG8_KOFF(u) ((SPL && ((u).sub & 1)) ? (size_t)K : (size_t)0)
    const char* cA = PG8_AP(0) + (size_t)cur.pm * tstepA + PG8_KOFF(cur); const char* cB = PG8_BP(0) + (size_t)cur.pn * tstepB + PG8_KOFF(cur);
    PG8_STAGE(PG8_SB(0, 0), cB, voffB); PG8_STAGE(PG8_SB(0, 1), cB + hstepB, voffB); PG8_STAGE(PG8_SA(0, 0), cA, voffA); PG8_STAGE(PG8_SA(0, 1), cA + hstepA, voffA);
    if (wr == 1) PG8_BAR;
    PG8_WAIT_V(2); PG8_BAR;
    PG8_STAGE(PG8_SB(1, 0), cB + kstep, voffB); PG8_STAGE(PG8_SA(1, 0), cA + kstep, voffA); PG8_STAGE(PG8_SB(1, 1), cB + hstepB + kstep, voffB);
    PG8_WAIT_V(6); PG8_BAR;
    for (;;) {
        const bool has_next = S.next((ui + 1) / CH, nxt); if constexpr (!SPL) nxt.sub = (ui + 1) % CH;
        const char* nA = has_next ? PG8_AP(SPL ? 0 : nxt.sub) + (size_t)nxt.pm * tstepA + PG8_KOFF(nxt) : cA; const char* nB = has_next ? PG8_BP(SPL ? 0 : nxt.sub) + (size_t)nxt.pn * tstepB + PG8_KOFF(nxt) : cB;
        const int ntc = (SPL && cur.sub) ? (nt >> 1) : nt;
        for (int t = 0; t < ntc; t += 2) {
            const bool last = (t == ntc - 2);
            const char* a1 = cA + (size_t)(t + 1) * kstep;
            const char* a2 = last ? nA : cA + (size_t)(t + 2) * kstep; const char* b2 = last ? nB : cB + (size_t)(t + 2) * kstep;
            const char* a3 = a2 + kstep; const char* b3 = b2 + kstep;
            PG8_LDB(B0, 0, 0); PG8_LDB(B1, 0, 1); PG8_SCHED; PG8_LDA(At, 0, 0); PG8_STAGE(PG8_SA(1, 1), a1 + hstepA, voffA);
            PG8_WAIT_V(8); PG8_WAIT_L(0); PG8_BAR; PG8_MMA(0, 0, At, B0); PG8_MMA(0, 1, At, B1); PG8_BAR; PG8_SCHED;
            PG8_LDA(At, 0, 1); PG8_STAGE(PG8_SB(0, 0), b2, voffB); PG8_STAGE(PG8_SB(0, 1), b2 + hstepB, voffB); PG8_STAGE(PG8_SA(0, 0), a2, voffA);
            PG8_WAIT_V(8); PG8_WAIT_L(0); PG8_BAR; PG8_MMA(1, 0, At, B0); PG8_MMA(1, 1, At, B1); PG8_BAR; PG8_SCHED;
            PG8_LDB(B0, 1, 0); PG8_LDB(B1, 1, 1); PG8_SCHED; PG8_LDA(At, 1, 0); PG8_STAGE(PG8_SA(0, 1), a2 + hstepA, voffA);
            PG8_WAIT_V(8); PG8_WAIT_L(0); PG8_BAR; PG8_MMA(0, 0, At, B0); PG8_MMA(0, 1, At, B1); PG8_BAR; PG8_SCHED;
            PG8_LDA(At, 1, 1); PG8_STAGE(PG8_SB(1, 0), b3, voffB); PG8_STAGE(PG8_SB(1, 1), b3 + hstepB, voffB); PG8_STAGE(PG8_SA(1, 0), a3, voffA);
            PG8_WAIT_V(8); PG8_WAIT_L(0); PG8_BAR; PG8_MMA(1, 0, At, B0); PG8_MMA(1, 1, At, B1); PG8_BAR; PG8_SCHED;
        }
        if (wr == 0) PG8_BAR;
        if constexpr (SPL) {
            if (cur.sub & 1) E.put_partial(acc, cur, wave);
            else { if (cur.sub) E.get_partial(acc, cur, wave); E(acc, cur, wr, wc, fr, fq); }
        } else if constexpr (!Epi::AFTER_DRAIN) E(acc, cur, wr, wc, fr, fq);
        if (!has_next) break;
        if (CH == 1 || cur.sub == CH - 1) {
#pragma unroll
        for (int a = 0; a < 2; ++a)
#pragma unroll
            for (int b = 0; b < 2; ++b)
#pragma unroll
                for (int m = 0; m < 4; ++m)
#pragma unroll
                    for (int n = 0; n < 2; ++n) acc[a][b][m][n] = (f32x4){0.f, 0.f, 0.f, 0.f};
        }
        cur = nxt; cA = nA; cB = nB; ++ui;
        if (wr == 1) PG8_BAR;
    }
    PG8_WAIT_V(0);
    PG8_BAR;
    if constexpr (Epi::AFTER_DRAIN) E.fused(acc, cur, wr, wc, fr, fq, lds, tid);
#undef PG8_AP
#undef PG8_BP
#undef PG8_KOFF
#undef PG8_SA
#undef PG8_SB
#undef PG8_STAGE
#undef PG8_LDA
#undef PG8_LDB
#undef PG8_MMA
#undef PG8_WAIT_V
#undef PG8_WAIT_L
#undef PG8_BAR
#undef PG8_SCHED
}
}
using pg8::Unit;

struct Args { const float* in[30]; float* out; unsigned char* ws; int ph_lo, ph_hi, use_bar, pad; };
#define CAS __attribute__((address_space(4)))
typedef const CAS Args* ArgP;

__device__ __forceinline__ int src_win(int n) {
    const int t = n >> 8, g = n & 255;
    if (t < 20) return n;
    if (t < 22) return 5120 + (n - 20 * 256);
    if (t == 22) return 5632 + g;
    if (t < 28) { const int half = g >> 7, hd = (g >> 6) & 1, part = (g >> 5) & 1, i = g & 31; const int base = (t < 27) ? 5952 + (t - 23) * 256 : 6976; return base + hd * 128 + part * 64 + half * 32 + i; }
    if (t == 28) return 7232 + g;
    if (t < 53) return 7488 + (n - 29 * 256);
    { const int half = g >> 7, r = g & 127; if (r >= 32) return -1; const int part = r >> 4, i = r & 15; return 5888 + part * 32 + half * 16 + i; }
}
__device__ __forceinline__ int src_uq(int n) {
    const int t = n >> 8, g = n & 255;
    if (t < 4) { const int hd = n >> 7, d = n & 127; return hd * 192 + d; }
    const int half = g >> 7, hl = (g >> 5) & 3, part = (g >> 4) & 1, i = g & 15; const int hd = (t - 4) * 4 + hl;
    return hd * 192 + 128 + part * 32 + half * 16 + i;
}
__device__ __forceinline__ int src_ukv(int n) { const int v = n >> 10, r = n & 1023, hd = r >> 7, d = r & 127; return hd * 256 + v * 128 + d; }
__device__ __forceinline__ int src_up(int n) { const int j = n >> 8, g = n & 255; return (g < 128) ? 128 * j + g : DFF + 128 * j + (g - 128); }

typedef short s16x4p __attribute__((ext_vector_type(4)));
typedef short v4i16p __attribute__((ext_vector_type(4)));
__device__ __forceinline__ unsigned cvtpk_p(float lo, float hi) { return pk2(lo, hi); }
struct TDesc { const float* W; const float* fold; bf16* WT; int K, Nsrc, map, k0, n0; };
constexpr int J_IN = 32 * (NINP / 64), J_UQ = 8 * 24, J_UKV = 4 * 32, J_BR = 16 * 32, J_O = 32 * 32, J_UP = 32 * (NUP / 64), J_DN = (DFF / 64) * 32;
constexpr int J_L = J_IN + J_UQ + J_UKV + 3 * J_BR + J_O + J_UP + J_DN;
__device__ __forceinline__ TDesc t_desc(ArgP a, unsigned char* ws, int it) {
    const int l = it / J_L; int r = it % J_L; unsigned char* wl = ws + WS_W + (size_t)l * WL_STRIDE;
    TDesc d; d.fold = nullptr; int N;
    if (r < J_IN) { d.W = a->in[15] + (size_t)l * D * NIN; d.K = D; d.Nsrc = NIN; N = NINP; d.WT = (bf16*)(wl + WO_IN); d.map = 1; }
    else if ((r -= J_IN) < J_UQ) { d.W = a->in[19] + (size_t)l * 512 * 1536; d.K = 512; d.Nsrc = 1536; N = 1536; d.WT = (bf16*)(wl + WO_UQ); d.map = 2; d.fold = a->in[18] + l * 512; }
    else if ((r -= J_UQ) < J_UKV) { d.W = a->in[21] + (size_t)l * 256 * 2048; d.K = 256; d.Nsrc = 2048; N = 2048; d.WT = (bf16*)(wl + WO_UKV); d.map = 3; d.fold = a->in[20] + l * 256; }
    else if ((r -= J_UKV) < J_BR) { d.W = a->in[23] + (size_t)l * 1024 * 2048; d.K = 1024; d.Nsrc = 2048; N = 2048; d.WT = (bf16*)(wl + WO_A); d.map = 0; }
    else if ((r -= J_BR) < J_BR) { d.W = a->in[24] + (size_t)l * 1024 * 2048; d.K = 1024; d.Nsrc = 2048; N = 2048; d.WT = (bf16*)(wl + WO_B); d.map = 0; }
    else if ((r -= J_BR) < J_BR) { d.W = a->in[25] + (size_t)l * 1024 * 2048; d.K = 1024; d.Nsrc = 2048; N = 2048; d.WT = (bf16*)(wl + WO_C); d.map = 0; }
    else if ((r -= J_BR) < J_O) { d.W = a->in[26] + (size_t)l * 2048 * 2048; d.K = 2048; d.Nsrc = 2048; N = 2048; d.WT = (bf16*)(wl + WO_O); d.map = 0; }
    else if ((r -= J_O) < J_UP) { d.W = a->in[27] + (size_t)l * 2048 * NUP; d.K = 2048; d.Nsrc = NUP; N = NUP; d.WT = (bf16*)(wl + WO_UP); d.map = 4; }
    else { r -= J_UP; d.W = a->in[29] + (size_t)l * DFF * 2048; d.K = DFF; d.Nsrc = 2048; N = 2048; d.WT = (bf16*)(wl + WO_DN); d.map = 0; }
    const int nblk = N / 64; d.k0 = 64 * (r / nblk); d.n0 = 64 * (r % nblk);
    return d;
}
__device__ __forceinline__ void t_load(const TDesc& d, f32x4 (&v)[16], int lane) {
    const int kk = lane >> 4, n = d.n0 + 4 * (lane & 15);
    int sc; if (d.map == 0) sc = n; else if (d.map == 1) sc = src_win(n); else if (d.map == 2) sc = src_uq(n); else if (d.map == 3) sc = src_ukv(n); else sc = src_up(n);
    const float* p = d.W + (size_t)(d.k0 + kk) * d.Nsrc + (sc < 0 ? 0 : sc);
#pragma unroll
    for (int i = 0; i < 16; ++i) { f32x4 x = *(const f32x4*)(p + (size_t)(4 * i) * d.Nsrc); if (sc < 0) x = (f32x4){0.f, 0.f, 0.f, 0.f}; if (d.fold) x = x * d.fold[d.k0 + 4 * i + kk]; v[i] = x; }
}
__device__ __forceinline__ void t_store(const TDesc& d, const f32x4 (&v)[16], LAS unsigned char* scr, int lane) {
    const int kk = lane >> 4, n4 = lane & 15, g = lane >> 4, i16 = lane & 15, q = i16 >> 2, p = i16 & 3;
#pragma unroll
    for (int i = 0; i < 16; ++i) { u32x2 w; w.x = cvtpk_p(v[i].x, v[i].y); w.y = cvtpk_p(v[i].z, v[i].w); *(LAS u32x2*)(scr + (4 * i + kk) * 144 + 8 * n4) = w; }
#pragma unroll
    for (int j = 0; j < 8; ++j) { const int nb = j >> 1, k8 = 4 * (j & 1) + g;
        LAS unsigned char* p0 = scr + (8 * k8 + q) * 144 + (16 * nb + 4 * p) * 2;
        const s16x4p v0 = __builtin_bit_cast(s16x4p, __builtin_amdgcn_ds_read_tr16_b64_v4i16((LAS v4i16p*)p0));
        const s16x4p v1 = __builtin_bit_cast(s16x4p, __builtin_amdgcn_ds_read_tr16_b64_v4i16((LAS v4i16p*)(p0 + 4 * 144)));
        const bf16x8 o = (bf16x8){v0.x, v0.y, v0.z, v0.w, v1.x, v1.y, v1.z, v1.w};
        *(bf16x8*)(d.WT + (size_t)(d.n0 + 16 * nb + i16) * d.K + d.k0 + 8 * k8) = o; }
}

__device__ __forceinline__ void phase_prologue(ArgP a, LAS unsigned char* lds, int wave) {
    const int tidn = tid_now(wave), lane = tidn & 63;
    LAS unsigned char* scr = lds + wave * 9216;
    const int gw = blockIdx.x * 8 + wave, NGW = gridDim.x * 8;
    unsigned char* ws = a->ws;
    for (int it = gw; it < NL * 16 * 48; it += NGW) {
        const int l = it / 768, r = it % 768, kc = r / 48, jb = r % 48;
        const float* W = a->in[9] + (size_t)l * D * 12288 + (size_t)(kc * 128) * 12288 + jb * 256 + lane * 4;
        f32x4 acc[5];
#pragma unroll
        for (int s = 0; s < 5; ++s) acc[s] = (f32x4){0.f, 0.f, 0.f, 0.f};
        for (int k = 0; k < 128; ++k) {
            const f32x4 w = *(const f32x4*)(W + (size_t)k * 12288);
            const int kk = kc * 128 + k;
#pragma unroll
            for (int s = 0; s < 5; ++s) { const float cv = (s == 0) ? a->in[8][kk] : a->in[7][(s - 1) * D + kk]; const float sv = cv * sigmoidf_(cv); acc[s] += w * sv; }
        }
        float* P = (float*)(ws + WS_MODP) + ((size_t)(l * 16 + kc) * 5) * 12288 + jb * 256 + lane * 4;
#pragma unroll
        for (int s = 0; s < 5; ++s) *(f32x4*)(P + (size_t)s * 12288) = acc[s];
    }
    {
        const int NT = NL * J_L; int it = gw; TDesc dA, dB; f32x4 A[16], B[16];
        if (it < NT) { dA = t_desc(a, ws, it); t_load(dA, A, lane); }
        while (it < NT) {
            const int nx = it + NGW; const bool more = nx < NT;
            if (more) { dB = t_desc(a, ws, nx); t_load(dB, B, lane); }
            t_store(dA, A, scr, lane);
            if (more) { dA = dB;
#pragma unroll
                for (int i = 0; i < 16; ++i) A[i] = B[i]; }
            it = nx;
        }
    }
    const int gt = blockIdx.x * 512 + tidn, NGT = gridDim.x * 512;
    for (int i = gt; i < 2048; i += NGT) {
        float v[4], mx = -1e30f;
#pragma unroll
        for (int l = 0; l < 4; ++l) { v[l] = a->in[16][l * 2048 + i]; mx = fmaxf(mx, v[l]); }
        float e[4], s = 0.f;
#pragma unroll
        for (int l = 0; l < 4; ++l) { e[l] = expf(v[l] - mx); s += e[l]; }
        float cs = 0.f; float* LB = (float*)(ws + WS_LB);
        LB[i] = 0.f;
#pragma unroll
        for (int l = 1; l < 4; ++l) { cs += e[l] / s; LB[l * 2048 + i] = cs; }
    }
    for (int i = gt; i < 64 * 32; i += NGT) { const int pos = i >> 5, j = i & 31; const float inv = powf(10000.f, -(float)(2 * j) / 64.f); const float ang = (float)pos * inv;
        float* R = (float*)(ws + WS_ROPE); R[i] = cosf(ang); R[2048 + i] = sinf(ang); }
    for (int i = gt; i < 64 * 16; i += NGT) { const int pos = i >> 4, j = i & 15; const float inv = powf(10000.f, -(float)(2 * j) / 32.f); const float ang = (float)pos * inv;
        float* R = (float*)(ws + WS_ROPE) + 4096; R[i] = cosf(ang); R[1024 + i] = sinf(ang); }
    for (int i = gt; i < 4 * 4 * 256 * 256; i += NGT) {
        const int c = i & 255, t = (i >> 8) & 255, l = (i >> 16) & 3, b = i >> 18; const size_t row = 8192 + b * 256 + t;
        ((bf16*)(ws + WS_BKV))[((size_t)l * MKV + row) * 256 + c] = (bf16)f2bf(a->in[3][i] / a->in[20][l * 256 + c]);
        ((bf16*)(ws + WS_KC))[((size_t)l * MKV + row) * 256 + c] = (bf16)f2bf(a->in[5][i]);
        ((bf16*)(ws + WS_VC))[((size_t)l * MKV + row) * 256 + c] = (bf16)f2bf(a->in[6][i]);
    }
    for (int i = gt; i < 1024 * 4; i += NGT) ((float*)(ws + WS_SSQKV))[8192 * 4 + i] = 64.f * (1.f - EPS);
    for (int i = gt; i < 4 * 4 * 256 * 64; i += NGT) {
        const int c = i & 63, t = (i >> 6) & 255, l = (i >> 14) & 3, b = i >> 16; const size_t row = 8192 + b * 256 + t;
        ((bf16*)(ws + WS_KR))[((size_t)l * MKV + row) * 64 + c] = (bf16)f2bf(a->in[4][i]);
    }
}
__device__ __forceinline__ void phase_modreduce(ArgP a, int wave) {
    const int gt = blockIdx.x * 512 + tid_now(wave), NGT = gridDim.x * 512;
    for (int i4 = gt; i4 < NL * 5 * 12288 / 4; i4 += NGT) {
        const int i = i4 * 4, j = i % 12288, s = (i / 12288) % 5, l = i / (5 * 12288);
        f32x4 v = *(const f32x4*)(a->in[10] + l * 12288 + j);
        const float* P = (const float*)(a->ws + WS_MODP) + ((size_t)(l * 16) * 5 + s) * 12288 + j;
#pragma unroll
        for (int kc = 0; kc < 16; ++kc) v += *(const f32x4*)(P + (size_t)kc * 5 * 12288);
        *(f32x4*)((float*)(a->ws + WS_MOD) + i) = v;
    }
}

__device__ __forceinline__ int mod_sel(int m) { return (m < MC) ? 0 : 1 + ((m - MC) >> 10); }
__device__ __forceinline__ const float* x_input_row(ArgP a, int m) { return (m < MC) ? a->in[0] + (size_t)m * D : a->in[1] + (size_t)(m - MC) * D; }

__device__ __forceinline__ void phase_h0(ArgP a, int wave) {
    const int tidn = tid_now(wave), lane = tidn & 63;
    const int gw = blockIdx.x * 8 + wave, NGW = gridDim.x * 8;
    unsigned char* ws = a->ws;
    const float* MOD = (const float*)(ws + WS_MOD);
    for (int m = gw; m < MT; m += NGW) {
        const int sl = mod_sel(m); const float* xr = x_input_row(a, m); const float* mod = MOD + (size_t)sl * 12288; bf16* ho = (bf16*)(ws + WS_H) + (size_t)m * D;
        f32x4 x[8]; float sq = 0.f;
#pragma unroll
        for (int j = 0; j < 8; ++j) { x[j] = *(const f32x4*)(xr + lane * 4 + 256 * j); sq += (x[j].x * x[j].x + x[j].y * x[j].y) + (x[j].z * x[j].z + x[j].w * x[j].w); }
        const float rs = rsq_(wave_sum(sq, lane) * (1.f / D) + EPS);
#pragma unroll
        for (int j = 0; j < 8; ++j) { const f32x4 h = (x[j] * rs) * (*(const f32x4*)(a->in[11] + lane * 4 + 256 * j) * (*(const f32x4*)(mod + D + lane * 4 + 256 * j) + 1.f)) + *(const f32x4*)(mod + lane * 4 + 256 * j);
            u32x2 o; o.x = pk2(h.x, h.y); o.y = pk2(h.z, h.w); *(u32x2*)(ho + lane * 4 + 256 * j) = o; }
    }
}

__device__ __forceinline__ float gelu_tanh(float x) { const float u = 0.7978845608028654f * (x + 0.044715f * x * x * x); return x * sigmoidf_(2.f * u); }
__device__ __forceinline__ void st8bf(bf16* p, const f32x4 v0, const f32x4 v1) { u32x4 w; w.x = pk2(v0.x, v0.y); w.y = pk2(v0.z, v0.w); w.z = pk2(v1.x, v1.y); w.w = pk2(v1.z, v1.w); *(u32x4*)p = w; }

#define ROWV() f32x4 V[2][2]; _Pragma("unroll") for (int bj_ = 0; bj_ < 2; ++bj_) _Pragma("unroll") for (int n_ = 0; n_ < 2; ++n_) V[bj_][n_] = acc[ai][bj_][m][n_];
struct EpiWin {
    static constexpr bool AFTER_DRAIN = false; static constexpr int CHAIN = 1;
    unsigned char* ws; float* out; int l;
    __device__ __forceinline__ void operator()(const f32x4 (&acc)[2][2][4][2], const Unit& u, int wr, int wc, int fr, int fq) const {
        { int ln_; asm volatile("v_mbcnt_lo_u32_b32 %0, -1, 0\n\tv_mbcnt_hi_u32_b32 %0, -1, %0" : "=v"(ln_)); fr = ln_ & 15; fq = ln_ >> 4; }
        const int l = this->l;
        const int t = u.pn, row0 = u.pm * 256 + wr * 64 + fr, cl = wc * 32 + 8 * fq;
        const bool ctx = u.pm < 16;
        if (t < 4) {
            bf16* O = (bf16*)(ws + WS_QA);
#pragma unroll
            for (int ai = 0; ai < 2; ++ai)
#pragma unroll
                for (int m = 0; m < 4; ++m) { asm volatile("" ::: "memory"); const unsigned r = (unsigned)(row0 + ai * 128 + m * 16); ROWV();
#pragma unroll
                    for (int bj = 0; bj < 2; ++bj) st8bf(O + r * 1024 + t * 256 + bj * 128 + cl, V[bj][0], V[bj][1]); }
        } else if (t < 12) {
            const int cb = (t - 4) * 256;
            const float* LB = (const float*)(ws + WS_LB) + l * 2048;
            bf16* LG = (bf16*)(ws + WS_LG); bf16* KK = (bf16*)(ws + WS_KK);
#pragma unroll
            for (int bj = 0; bj < 2; ++bj) {
                const int c0 = cb + bj * 128 + cl;
                const f32x4 lb0 = *(const f32x4*)(LB + c0), lb1 = *(const f32x4*)(LB + c0 + 4);
#pragma unroll
                for (int ai = 0; ai < 2; ++ai)
#pragma unroll
                    for (int m = 0; m < 4; ++m) { asm volatile("" ::: "memory"); const unsigned r = (unsigned)(row0 + ai * 128 + m * 16); ROWV();
                        f32x4 lg[2];
#pragma unroll
                        for (int n = 0; n < 2; ++n) { const f32x4 lb = n ? lb1 : lb0; const f32x4 x = V[bj][n];
#pragma unroll
                            for (int e = 0; e < 4; ++e) { const float sg = sigmoidf_(x[e]); const float f = lb[e] + (1.f - lb[e]) * sg; lg[n][e] = __logf(f); } }
                        st8bf(LG + r * 2048 + c0, lg[0], lg[1]);
                        }
            }
        } else if (t < 16) {
            bf16* O = (bf16*)(ws + WS_VA);
#pragma unroll
            for (int ai = 0; ai < 2; ++ai)
#pragma unroll
                for (int m = 0; m < 4; ++m) { asm volatile("" ::: "memory"); const unsigned r = (unsigned)(row0 + ai * 128 + m * 16); ROWV();
#pragma unroll
                    for (int bj = 0; bj < 2; ++bj) st8bf(O + r * 1024 + (t - 12) * 256 + bj * 128 + cl, V[bj][0], V[bj][1]); }
        } else if (t < 20) {
            bf16* O = (bf16*)(ws + WS_AG);
#pragma unroll
            for (int ai = 0; ai < 2; ++ai)
#pragma unroll
                for (int m = 0; m < 4; ++m) { asm volatile("" ::: "memory"); const unsigned r = (unsigned)(row0 + ai * 128 + m * 16); ROWV();
#pragma unroll
                    for (int bj = 0; bj < 2; ++bj) { f32x4 v0 = V[bj][0], v1 = V[bj][1];
#pragma unroll
                        for (int e = 0; e < 4; ++e) { v0[e] = v0[e] * sigmoidf_(v0[e]); v1[e] = v1[e] * sigmoidf_(v1[e]); }
                        st8bf(O + r * 1024 + (t - 16) * 256 + bj * 128 + cl, v0, v1); } }
        } else if (t < 23) {
            const bool isq = t < 22;
            bf16* O = isq ? (bf16*)(ws + WS_BQ) : (bf16*)(ws + WS_BKV) + (size_t)l * MKV * 256;
            const int ld = isq ? 512 : 256, cb = isq ? (t - 20) * 256 : 0;
            float* SS = isq ? (float*)(ws + WS_SSQQ) : (float*)(ws + WS_SSQKV);
#pragma unroll
            for (int ai = 0; ai < 2; ++ai)
#pragma unroll
                for (int m = 0; m < 4; ++m) { asm volatile("" ::: "memory"); const unsigned r = (unsigned)(row0 + ai * 128 + m * 16); ROWV(); float s = 0.f;
#pragma unroll
                    for (int bj = 0; bj < 2; ++bj) { const f32x4 v0 = V[bj][0], v1 = V[bj][1];
                        s += (v0.x * v0.x + v0.y * v0.y) + (v0.z * v0.z + v0.w * v0.w) + (v1.x * v1.x + v1.y * v1.y) + (v1.z * v1.z + v1.w * v1.w);
                        st8bf(O + r * ld + cb + bj * 128 + cl, v0, v1);
                        if (!isq && ctx) { float* oc = out + OUT_CKV + (((r >> 8) * 4 + l) * 256 + (r & 255)) * 256 + bj * 128 + cl; *(f32x4*)oc = v0; *(f32x4*)(oc + 4) = v1; } }
                    s += shx(s, 16, fq * 16 + fr); s += shx(s, 32, fq * 16 + fr);
                    if (fq == 0) { if (isq) SS[r * 8 + (t - 20) * 4 + wc] = s; else SS[r * 4 + wc] = s; } }
        } else if (t < 28) {
            const bool isq = t < 27;
            const float* CS = (const float*)(ws + WS_ROPE);
            const int hd = wc >> 1, part = wc & 1, i0 = 8 * fq;
            const int ncol = hd * 128 + part * 64 + i0;
            bf16* O = isq ? (bf16*)(ws + WS_QC) : (bf16*)(ws + WS_KC) + (size_t)l * MKV * 256;
            const int ld = isq ? 1024 : 256, cb = isq ? (t - 23) * 256 : 0;
            const float qs = isq ? SCALE_C * 1.4426950408889634f : 1.f;
#pragma unroll
            for (int ai = 0; ai < 2; ++ai)
#pragma unroll
                for (int m = 0; m < 4; ++m) { asm volatile("" ::: "memory"); const unsigned r = (unsigned)(row0 + ai * 128 + m * 16); ROWV();
                    f32x4 o1[2], o2[2];
                    if (ctx) { o1[0] = V[0][0]; o1[1] = V[0][1]; o2[0] = V[1][0]; o2[1] = V[1][1]; }
                    else { const int tt = ((int)r - MC) & 1023; const int pos = part ? (tt & 63) : (tt >> 6);
#pragma unroll
                        for (int n = 0; n < 2; ++n) { const f32x4 c = *(const f32x4*)(CS + pos * 32 + i0 + 4 * n), s = *(const f32x4*)(CS + 2048 + pos * 32 + i0 + 4 * n);
                            const f32x4 x1 = V[0][n], x2 = V[1][n]; o1[n] = x1 * c - x2 * s; o2[n] = x1 * s + x2 * c; } }
                    if (!isq && ctx) { float* oc = out + OUT_K + (((r >> 8) * 4 + l) * 256 + (r & 255)) * 256 + ncol; *(f32x4*)oc = o1[0]; *(f32x4*)(oc + 4) = o1[1]; *(f32x4*)(oc + 32) = o2[0]; *(f32x4*)(oc + 36) = o2[1]; }
                    st8bf(O + r * ld + cb + ncol, o1[0] * qs, o1[1] * qs); st8bf(O + r * ld + cb + ncol + 32, o2[0] * qs, o2[1] * qs); }
        } else if (t == 28) {
            bf16* O = (bf16*)(ws + WS_VC) + (size_t)l * MKV * 256;
#pragma unroll
            for (int ai = 0; ai < 2; ++ai)
#pragma unroll
                for (int m = 0; m < 4; ++m) { asm volatile("" ::: "memory"); const unsigned r = (unsigned)(row0 + ai * 128 + m * 16); ROWV();
#pragma unroll
                    for (int bj = 0; bj < 2; ++bj) { st8bf(O + r * 256 + bj * 128 + cl, V[bj][0], V[bj][1]);
                        if (ctx) { float* oc = out + OUT_V + (((r >> 8) * 4 + l) * 256 + (r & 255)) * 256 + bj * 128 + cl; *(f32x4*)oc = V[bj][0]; *(f32x4*)(oc + 4) = V[bj][1]; } } }
        } else if (t < 53) {
            unsigned char* O = ws + WS_GT;
#pragma unroll
            for (int ai = 0; ai < 2; ++ai)
#pragma unroll
                for (int m = 0; m < 4; ++m) { asm volatile("" ::: "memory"); const unsigned r = (unsigned)(row0 + ai * 128 + m * 16); ROWV();
                    u32x4 w4 = (u32x4){0u, 0u, 0u, 0u};
#pragma unroll
                    for (int bj = 0; bj < 2; ++bj) { f32x4 v0 = V[bj][0], v1 = V[bj][1];
#pragma unroll
                        for (int e = 0; e < 4; ++e) { v0[e] = 255.f * sigmoidf_(v0[e]); v1[e] = 255.f * sigmoidf_(v1[e]); }
                        unsigned wx = 0u, wy = 0u;
#pragma unroll
                        for (int e = 0; e < 4; ++e) { wx = __builtin_amdgcn_cvt_pk_u8_f32(v0[e], e, wx); wy = __builtin_amdgcn_cvt_pk_u8_f32(v1[e], e, wy); }
                        if (bj == 0) { w4.x = wx; w4.y = wy; } else { w4.z = wx; w4.w = wy; } }
                    *(u32x4*)(O + r * 6144 + (t - 29) * 256 + 2 * cl) = w4; }
        } else {
            if (wc == 0) {
                const float* CS = (const float*)(ws + WS_ROPE) + 4096;
                const int part = fq >> 1, i0 = 8 * (fq & 1); const int ncol = part * 32 + i0;
                bf16* O = (bf16*)(ws + WS_KR) + (size_t)l * MKV * 64;
#pragma unroll
                for (int ai = 0; ai < 2; ++ai)
#pragma unroll
                    for (int m = 0; m < 4; ++m) { asm volatile("" ::: "memory"); const unsigned r = (unsigned)(row0 + ai * 128 + m * 16); ROWV();
                        f32x4 o1[2], o2[2];
                        if (ctx) { o1[0] = V[0][0]; o1[1] = V[0][1]; o2[0] = V[1][0]; o2[1] = V[1][1]; }
                        else { const int tt = ((int)r - MC) & 1023; const int pos = part ? (tt & 63) : (tt >> 6);
#pragma unroll
                            for (int n = 0; n < 2; ++n) { const f32x4 c = *(const f32x4*)(CS + pos * 16 + i0 + 4 * n), s = *(const f32x4*)(CS + 1024 + pos * 16 + i0 + 4 * n);
                                const f32x4 x1 = V[0][n], x2 = V[1][n]; o1[n] = x1 * c - x2 * s; o2[n] = x1 * s + x2 * c; } }
                        if (ctx) { float* oc = out + OUT_KR + (((r >> 8) * 4 + l) * 256 + (r & 255)) * 64 + ncol; *(f32x4*)oc = o1[0]; *(f32x4*)(oc + 4) = o1[1]; *(f32x4*)(oc + 16) = o2[0]; *(f32x4*)(oc + 20) = o2[1]; }
                        st8bf(O + r * 64 + ncol, o1[0], o1[1]); st8bf(O + r * 64 + ncol + 16, o2[0], o2[1]); }
            }
        }
    }
};

struct EpiUq {
    static constexpr bool AFTER_DRAIN = false; static constexpr int CHAIN = 1;
    unsigned char* ws;
    __device__ __forceinline__ void operator()(const f32x4 (&acc)[2][2][4][2], const Unit& u, int wr, int wc, int fr, int fq) const {
        { int ln_; asm volatile("v_mbcnt_lo_u32_b32 %0, -1, 0\n\tv_mbcnt_hi_u32_b32 %0, -1, %0" : "=v"(ln_)); fr = ln_ & 15; fq = ln_ >> 4; }
        const int t = u.pn, row0 = u.pm * 256 + wr * 64 + fr, cl = wc * 32 + 8 * fq; const bool ctx = u.pm < 16;
        const float* SS = (const float*)(ws + WS_SSQQ); bf16* O = (bf16*)(ws + WS_QF);
        const float* CS = (const float*)(ws + WS_ROPE) + 4096;
        float rsv[2][4];
#pragma unroll
        for (int ai = 0; ai < 2; ++ai)
#pragma unroll
            for (int m = 0; m < 4; ++m) { const unsigned r = (unsigned)(row0 + ai * 128 + m * 16); const f32x4 s0 = *(const f32x4*)(SS + r * 8), s1 = *(const f32x4*)(SS + r * 8 + 4);
                rsv[ai][m] = (SCALE_B * 1.4426950408889634f) * rsq_(((s0.x + s0.y) + (s0.z + s0.w) + (s1.x + s1.y) + (s1.z + s1.w)) * (1.f / 512.f) + EPS); }
#pragma unroll
        for (int ai = 0; ai < 2; ++ai)
#pragma unroll
            for (int m = 0; m < 4; ++m) { asm volatile("" ::: "memory"); const unsigned r = (unsigned)(row0 + ai * 128 + m * 16);
                const float rs = rsv[ai][m];
                if (t < 4) {
#pragma unroll
                    for (int bj = 0; bj < 2; ++bj) { const int hd = t * 2 + bj; st8bf(O + r * 1536 + hd * 192 + cl, acc[ai][bj][m][0] * rs, acc[ai][bj][m][1] * rs); }
                } else {
                    const int hd = (t - 4) * 4 + wc, part = fq >> 1, i0 = 8 * (fq & 1); const int ncol = hd * 192 + 128 + part * 32 + i0;
                    f32x4 o1[2], o2[2];
                    if (ctx) { o1[0] = acc[ai][0][m][0]; o1[1] = acc[ai][0][m][1]; o2[0] = acc[ai][1][m][0]; o2[1] = acc[ai][1][m][1]; }
                    else { const int tt = ((int)r - MC) & 1023; const int pos = part ? (tt & 63) : (tt >> 6);
#pragma unroll
                        for (int n = 0; n < 2; ++n) { const f32x4 c = *(const f32x4*)(CS + pos * 16 + i0 + 4 * n), s = *(const f32x4*)(CS + 1024 + pos * 16 + i0 + 4 * n);
                            const f32x4 x1 = acc[ai][0][m][n], x2 = acc[ai][1][m][n]; o1[n] = x1 * c - x2 * s; o2[n] = x1 * s + x2 * c; } }
                    st8bf(O + r * 1536 + ncol, o1[0] * rs, o1[1] * rs); st8bf(O + r * 1536 + ncol + 16, o2[0] * rs, o2[1] * rs);
                }
            }
    }
};

struct EpiKv {
    static constexpr bool AFTER_DRAIN = false; static constexpr int CHAIN = 1;
    unsigned char* ws;
    __device__ __forceinline__ void operator()(const f32x4 (&acc)[2][2][4][2], const Unit& u, int wr, int wc, int fr, int fq) const {
        { int ln_; asm volatile("v_mbcnt_lo_u32_b32 %0, -1, 0\n\tv_mbcnt_hi_u32_b32 %0, -1, %0" : "=v"(ln_)); fr = ln_ & 15; fq = ln_ >> 4; }
        const int row0 = u.pm * 256 + wr * 64 + fr, cl = wc * 32 + 8 * fq;
        const float* SS = (const float*)(ws + WS_SSQKV); bf16* O = (bf16*)(ws + WS_KV);
        float rsv[2][4];
#pragma unroll
        for (int ai = 0; ai < 2; ++ai)
#pragma unroll
            for (int m = 0; m < 4; ++m) { const unsigned r = (unsigned)(row0 + ai * 128 + m * 16); const f32x4 s0 = *(const f32x4*)(SS + r * 4);
                rsv[ai][m] = rsq_(((s0.x + s0.y) + (s0.z + s0.w)) * (1.f / 256.f) + EPS); }
#pragma unroll
        for (int ai = 0; ai < 2; ++ai)
#pragma unroll
            for (int m = 0; m < 4; ++m) { asm volatile("" ::: "memory"); const unsigned r = (unsigned)(row0 + ai * 128 + m * 16);
                const float rs = rsv[ai][m];
#pragma unroll
                for (int bj = 0; bj < 2; ++bj) st8bf(O + r * 2048 + u.pn * 256 + bj * 128 + cl, acc[ai][bj][m][0] * rs, acc[ai][bj][m][1] * rs); }
    }
};

struct EpiBranch {
    static constexpr bool AFTER_DRAIN = false; static constexpr int CHAIN = 3;
    unsigned char* ws;
    __device__ __forceinline__ void operator()(f32x4 (&acc)[2][2][4][2], const Unit& u, int wr, int wc, int fr, int fq) const {
        { int ln_; asm volatile("v_mbcnt_lo_u32_b32 %0, -1, 0\n\tv_mbcnt_hi_u32_b32 %0, -1, %0" : "=v"(ln_)); fr = ln_ & 15; fq = ln_ >> 4; }
        const int row0 = u.pm * 256 + wr * 64 + fr, cl = wc * 32 + 8 * fq;
        const unsigned char* G = ws + WS_GT; bf16* O = (bf16*)(ws + WS_MG);
        const int sub = u.sub;
#pragma unroll
        for (int ai = 0; ai < 2; ++ai) { asm volatile("" ::: "memory");
            u32x4 ga4[4], gb4[4];
#pragma unroll
            for (int m = 0; m < 4; ++m) { const unsigned r = (unsigned)(row0 + ai * 128 + m * 16); const int c16 = u.pn * 256 + 2 * cl;
                ga4[m] = *(const u32x4*)(G + r * 6144 + sub * 2048 + c16);
                gb4[m] = (sub < 2) ? *(const u32x4*)(G + r * 6144 + (sub + 1) * 2048 + c16) : (u32x4){0u, 0u, 0u, 0u}; }
#pragma unroll
            for (int m = 0; m < 4; ++m)
#pragma unroll
                for (int bj = 0; bj < 2; ++bj) { const unsigned r = (unsigned)(row0 + ai * 128 + m * 16); const int c = u.pn * 256 + bj * 128 + cl;
                    const u32x2 a4 = bj ? (u32x2){ga4[m].z, ga4[m].w} : (u32x2){ga4[m].x, ga4[m].y}, b4 = bj ? (u32x2){gb4[m].z, gb4[m].w} : (u32x2){gb4[m].x, gb4[m].y};
#define UB_(w, k) ((float)(((w) >> (8 * (k))) & 0xffu))
                    float s[8] = {UB_(a4.x, 0), UB_(a4.x, 1), UB_(a4.x, 2), UB_(a4.x, 3), UB_(a4.y, 0), UB_(a4.y, 1), UB_(a4.y, 2), UB_(a4.y, 3)};
#pragma unroll
                    for (int e = 0; e < 8; ++e) s[e] = fmaxf(s[e], 255e-6f);
                    if (sub < 2) { const float d[8] = {UB_(b4.x, 0), UB_(b4.x, 1), UB_(b4.x, 2), UB_(b4.x, 3), UB_(b4.y, 0), UB_(b4.y, 1), UB_(b4.y, 2), UB_(b4.y, 3)};
#pragma unroll
                        for (int e = 0; e < 8; ++e) s[e] *= __builtin_amdgcn_rcpf(fmaxf(d[e], 255e-6f)); }
                    else {
#pragma unroll
                        for (int e = 0; e < 8; ++e) s[e] *= (1.f / 255.f); }
#undef UB_
                    f32x4 v0 = acc[ai][bj][m][0], v1 = acc[ai][bj][m][1];
                    v0.x *= s[0]; v0.y *= s[1]; v0.z *= s[2]; v0.w *= s[3]; v1.x *= s[4]; v1.y *= s[5]; v1.z *= s[6]; v1.w *= s[7];
                    if (sub < 2) { acc[ai][bj][m][0] = v0; acc[ai][bj][m][1] = v1; }
                    else st8bf(O + r * 2048 + c, v0, v1); } }
    }
};

struct EpiF32 {
    static constexpr bool AFTER_DRAIN = false; static constexpr int CHAIN = 1;
    float* O; int ld;
    __device__ __forceinline__ void operator()(const f32x4 (&acc)[2][2][4][2], const Unit& u, int wr, int wc, int fr, int fq) const {
        { int ln_; asm volatile("v_mbcnt_lo_u32_b32 %0, -1, 0\n\tv_mbcnt_hi_u32_b32 %0, -1, %0" : "=v"(ln_)); fr = ln_ & 15; fq = ln_ >> 4; }
        const int row0 = u.pm * 256 + wr * 64 + fr, cl = wc * 32 + 8 * fq;
#pragma unroll
        for (int ai = 0; ai < 2; ++ai)
#pragma unroll
            for (int m = 0; m < 4; ++m) { asm volatile("" ::: "memory"); const unsigned r = (unsigned)(row0 + ai * 128 + m * 16);
#pragma unroll
                for (int bj = 0; bj < 2; ++bj) { float* p = O + r * ld + u.pn * 256 + bj * 128 + cl; *(f32x4*)p = acc[ai][bj][m][0]; *(f32x4*)(p + 4) = acc[ai][bj][m][1]; } }
    }
};
struct EpiBf {
    static constexpr bool AFTER_DRAIN = false; static constexpr int CHAIN = 1;
    bf16* O; int ld;
    __device__ __forceinline__ void operator()(const f32x4 (&acc)[2][2][4][2], const Unit& u, int wr, int wc, int fr, int fq) const {
        { int ln_; asm volatile("v_mbcnt_lo_u32_b32 %0, -1, 0\n\tv_mbcnt_hi_u32_b32 %0, -1, %0" : "=v"(ln_)); fr = ln_ & 15; fq = ln_ >> 4; }
        const int row0 = u.pm * 256 + wr * 64 + fr, cl = wc * 32 + 8 * fq;
#pragma unroll
        for (int ai = 0; ai < 2; ++ai)
#pragma unroll
            for (int m = 0; m < 4; ++m) { asm volatile("" ::: "memory"); const unsigned r = (unsigned)(row0 + ai * 128 + m * 16);
#pragma unroll
                for (int bj = 0; bj < 2; ++bj) st8bf(O + r * ld + u.pn * 256 + bj * 128 + cl, acc[ai][bj][m][0], acc[ai][bj][m][1]); }
    }
};

__device__ __forceinline__ float dpp_prev(float x) { return __builtin_bit_cast(float, __builtin_amdgcn_update_dpp(0, __builtin_bit_cast(int, x), 0x121, 0xf, 0xf, false)); }
__device__ __forceinline__ float dpp_next(float x) { return __builtin_bit_cast(float, __builtin_amdgcn_update_dpp(0, __builtin_bit_cast(int, x), 0x12f, 0xf, 0xf, false)); }
__device__ __forceinline__ float dpp_up(float e, float x) { return __builtin_bit_cast(float, __builtin_amdgcn_update_dpp(__builtin_bit_cast(int, e), __builtin_bit_cast(int, x), 0x111, 0xf, 0xf, false)); }
__device__ __forceinline__ float dpp_dn(float e, float x) { return __builtin_bit_cast(float, __builtin_amdgcn_update_dpp(__builtin_bit_cast(int, e), __builtin_bit_cast(int, x), 0x101, 0xf, 0xf, false)); }
struct EpiUp {
    static constexpr bool AFTER_DRAIN = false; static constexpr int CHAIN = 1;
    unsigned char* ws; const float* cw; LAS unsigned char* hl; int l;
    __device__ __forceinline__ void put_partial(const f32x4 (&acc)[2][2][4][2], const Unit& u, int wave) const {
        const int tid = tid_now(wave), j = (u.sub - 1) >> 1;
        float* P = (float*)(ws + WS_SPL) + (size_t)j * 65536 + tid * 4;
#pragma unroll
        for (int ai = 0; ai < 2; ++ai)
#pragma unroll
            for (int bj = 0; bj < 2; ++bj)
#pragma unroll
                for (int m = 0; m < 4; ++m)
#pragma unroll
                    for (int n = 0; n < 2; ++n) *(f32x4*)(P + (((ai * 2 + bj) * 4 + m) * 2 + n) * 2048) = acc[ai][bj][m][n];
        asm volatile("s_waitcnt vmcnt(0)" ::: "memory");
        __syncthreads();
        if (tid == 0) { __builtin_amdgcn_fence(__ATOMIC_RELEASE, "agent"); asm volatile("s_waitcnt vmcnt(0)" ::: "memory"); __hip_atomic_store((unsigned*)ws + CW_SPL + l * 128 + j, 1u, RLX_AGENT); }
    }
    __device__ __forceinline__ void get_partial(f32x4 (&acc)[2][2][4][2], const Unit& u, int wave) const {
        const int tid = tid_now(wave), j = (u.sub - 1) >> 1;
        if (tid == 0) { unsigned* f = (unsigned*)ws + CW_SPL + l * 128 + j; unsigned sp = 0; while (__hip_atomic_load(f, RLX_AGENT) == 0u) { __builtin_amdgcn_s_sleep(1); if (++sp > (1u << 22)) break; }
            __builtin_amdgcn_fence(__ATOMIC_ACQUIRE, "agent"); asm volatile("s_waitcnt vmcnt(0)" ::: "memory"); }
        __syncthreads();
        const float* P = (const float*)(ws + WS_SPL) + (size_t)j * 65536 + tid * 4;
#pragma unroll
        for (int ai = 0; ai < 2; ++ai) { f32x4 p[2][4][2];
#pragma unroll
            for (int bj = 0; bj < 2; ++bj)
#pragma unroll
                for (int m = 0; m < 4; ++m)
#pragma unroll
                    for (int n = 0; n < 2; ++n) p[bj][m][n] = *(const f32x4*)(P + (((ai * 2 + bj) * 4 + m) * 2 + n) * 2048);
#pragma unroll
            for (int bj = 0; bj < 2; ++bj)
#pragma unroll
                for (int m = 0; m < 4; ++m)
#pragma unroll
                    for (int n = 0; n < 2; ++n) acc[ai][bj][m][n] += p[bj][m][n]; }
    }
    __device__ __forceinline__ void operator()(const f32x4 (&acc)[2][2][4][2], const Unit& u, int wr, int wc, int fr, int fq) const {
        { int ln_; asm volatile("v_mbcnt_lo_u32_b32 %0, -1, 0\n\tv_mbcnt_hi_u32_b32 %0, -1, %0" : "=v"(ln_)); fr = ln_ & 15; fq = ln_ >> 4; }
        const int cl = wc * 32 + 8 * fq;
        LAS f32x4* HL = (LAS f32x4*)hl;
#pragma unroll
        for (int ai = 0; ai < 2; ++ai) {
            if (fr == 0) {
#pragma unroll
                for (int bj = 0; bj < 2; ++bj)
#pragma unroll
                    for (int n = 0; n < 2; ++n) HL[((((ai * 2 + wr) * 4 + wc) * 2 + 0) * 4 + fq) * 4 + bj * 2 + n] = acc[ai][bj][0][n]; }
            if (fr == 15) {
#pragma unroll
                for (int bj = 0; bj < 2; ++bj)
#pragma unroll
                    for (int n = 0; n < 2; ++n) HL[((((ai * 2 + wr) * 4 + wc) * 2 + 1) * 4 + fq) * 4 + bj * 2 + n] = acc[ai][bj][3][n]; }
        }
        if (u.pm >= 16) {
            bf16* HU = (bf16*)(ws + WS_HALO) + (size_t)(u.pm - 16) * 4 * NUP + u.pn * 256 + cl;
            if (wr == 0 && fr < 2) {
#pragma unroll
                for (int bj = 0; bj < 2; ++bj) st8bf(HU + (size_t)fr * NUP + bj * 128, acc[0][bj][0][0], acc[0][bj][0][1]); }
            if (wr == 1 && fr >= 14) {
#pragma unroll
                for (int bj = 0; bj < 2; ++bj) st8bf(HU + (size_t)(fr - 12) * NUP + bj * 128, acc[1][bj][3][0], acc[1][bj][3][1]); }
        }
        asm volatile("s_waitcnt lgkmcnt(0)" ::: "memory");
        __builtin_amdgcn_s_barrier();
        bf16* ACT = (bf16*)(ws + WS_ACT);
        LAS u32x2* KEEP = (LAS u32x2*)(hl - HALO_OFF + 3 * 16384) + (wr * 4 + wc) * 64 + (fq * 16 + fr);
#pragma unroll
        for (int ai = 0; ai < 2; ++ai) {
#pragma unroll
            for (int n = 0; n < 2; ++n) { asm volatile("" ::: "memory");
                f32x4 wa[3], wg[3];
#pragma unroll
                for (int tap = 0; tap < 3; ++tap) { const float* p = cw + tap * NUP + u.pn * 128 + cl + 4 * n; wa[tap] = *(const f32x4*)p; wg[tap] = *(const f32x4*)(p + DFF); }
                f32x4 top[2], bot[2];
#pragma unroll
                for (int bj = 0; bj < 2; ++bj) {
                    const int tsrc = (wr == 1) ? (ai * 2 + 0) : 1;
                    const int bsrc = (wr == 0) ? (ai * 2 + 1) : 2;
                    const f32x4 tv = HL[(((tsrc * 4 + wc) * 2 + 1) * 4 + fq) * 4 + bj * 2 + n], bv = HL[(((bsrc * 4 + wc) * 2 + 0) * 4 + fq) * 4 + bj * 2 + n];
                    top[bj] = (wr == 1 || ai == 1) ? tv : (f32x4){0.f, 0.f, 0.f, 0.f};
                    bot[bj] = (wr == 0 || ai == 0) ? bv : (f32x4){0.f, 0.f, 0.f, 0.f}; }
#pragma unroll
                for (int m = 0; m < 4; ++m) { asm volatile("" ::: "memory");
                    const unsigned r = (unsigned)(u.pm * 256 + ai * 128 + wr * 64 + m * 16 + fr);
                    f32x4 res;
#pragma unroll
                    for (int e = 0; e < 4; ++e) {
                        float v[2];
#pragma unroll
                        for (int bj = 0; bj < 2; ++bj) {
                            const float x = acc[ai][bj][m][n][e];
                            const float pe_ = (m == 0) ? top[bj][e] : dpp_prev(acc[ai][bj][m == 0 ? 0 : m - 1][n][e]);
                            const float ne_ = (m == 3) ? bot[bj][e] : dpp_next(acc[ai][bj][m == 3 ? 3 : m + 1][n][e]);
                            const float up = dpp_up(pe_, x), dn = dpp_dn(ne_, x);
                            const float w0 = bj ? wg[0][e] : wa[0][e], w1 = bj ? wg[1][e] : wa[1][e], w2 = bj ? wg[2][e] : wa[2][e];
                            v[bj] = w0 * up + w1 * x + w2 * dn; }
                        res[e] = v[0] * gelu_tanh(v[1]); }
                    u32x2 o; o.x = cvtpk_p(res.x, res.y); o.y = cvtpk_p(res.z, res.w);
                    if (n == 0) KEEP[m * 512] = o;
                    else { const u32x2 k0 = KEEP[m * 512]; const u32x4 o4 = (u32x4){k0.x, k0.y, o.x, o.y}; *(u32x4*)(ACT + r * DFF + u.pn * 128 + cl) = o4; } }
            }
        }
        __builtin_amdgcn_s_barrier();
    }
};
__device__ __forceinline__ void conv_fixup(ArgP a, int l, int pm, int wave) {
    if (pm < 16) return;
    const int tid = tid_now(wave); const int tl = pm - 16;
    const bf16* HU = (const bf16*)(a->ws + WS_HALO); bf16* ACT = (bf16*)(a->ws + WS_ACT); const float* CW = a->in[28] + (size_t)l * 3 * NUP;
    for (int it = tid; it < 2 * (DFF / 8); it += 512) {
        const int which = it / (DFF / 8), c = (it % (DFF / 8)) * 8; const int j = c >> 7, i = c & 127;
        if (which == 0 ? ((tl & 3) == 0) : ((tl & 3) == 3)) continue;
        const bf16* r0 = which == 0 ? HU + ((size_t)(tl - 1) * 4 + 3) * NUP : HU + ((size_t)tl * 4 + 2) * NUP;
        const bf16* r1 = which == 0 ? HU + ((size_t)tl * 4 + 0) * NUP : HU + ((size_t)tl * 4 + 3) * NUP;
        const bf16* r2 = which == 0 ? HU + ((size_t)tl * 4 + 1) * NUP : HU + ((size_t)(tl + 1) * 4 + 0) * NUP;
        const bf16* rr[3] = {r0, r1, r2};
        f32x4 ra0 = (f32x4){0.f, 0.f, 0.f, 0.f}, ra1 = ra0, rg0 = ra0, rg1 = ra0;
#pragma unroll
        for (int tap = 0; tap < 3; ++tap) { const u32x4 xa = *(const u32x4*)(rr[tap] + 256 * j + i), xg = *(const u32x4*)(rr[tap] + 256 * j + i + 128);
            const float* p = CW + tap * NUP + c; const f32x4 wa0 = *(const f32x4*)p, wa1 = *(const f32x4*)(p + 4), wg0 = *(const f32x4*)(p + DFF), wg1 = *(const f32x4*)(p + DFF + 4);
            ra0 += wa0 * (f32x4){bf_lo(xa.x), bf_hi(xa.x), bf_lo(xa.y), bf_hi(xa.y)}; ra1 += wa1 * (f32x4){bf_lo(xa.z), bf_hi(xa.z), bf_lo(xa.w), bf_hi(xa.w)};
            rg0 += wg0 * (f32x4){bf_lo(xg.x), bf_hi(xg.x), bf_lo(xg.y), bf_hi(xg.y)}; rg1 += wg1 * (f32x4){bf_lo(xg.z), bf_hi(xg.z), bf_lo(xg.w), bf_hi(xg.w)}; }
        u32x4 o; o.x = pk2(ra0.x * gelu_tanh(rg0.x), ra0.y * gelu_tanh(rg0.y)); o.y = pk2(ra0.z * gelu_tanh(rg0.z), ra0.w * gelu_tanh(rg0.w));
        o.z = pk2(ra1.x * gelu_tanh(rg1.x), ra1.y * gelu_tanh(rg1.y)); o.w = pk2(ra1.z * gelu_tanh(rg1.z), ra1.w * gelu_tanh(rg1.w));
        *(u32x4*)(ACT + (size_t)(pm * 256 + (which ? 255 : 0)) * DFF + c) = o;
    }
    asm volatile("s_waitcnt vmcnt(0)" ::: "memory");
    __syncthreads();
}

#define RLX_AG __ATOMIC_RELAXED, __HIP_MEMORY_SCOPE_AGENT
__device__ __forceinline__ void panel_exchange(LAS float* P, LAS float* R, unsigned* X, unsigned* cnt, int pm, int pn, int tid) {
    if (tid < 256) { const f32x4 p = *(const LAS f32x4*)(P + tid * 4); const float tot = (p.x + p.y) + (p.z + p.w);
        __hip_atomic_store(X + ((size_t)(pm * 256 + tid)) * 8 + pn, __builtin_bit_cast(unsigned, tot), RLX_AG); }
    asm volatile("s_waitcnt vmcnt(0)" ::: "memory");
    __syncthreads();
    if (tid == 0) { (void)__hip_atomic_fetch_add(cnt, 1u, RLX_AG);
        unsigned sp = 0; while (__hip_atomic_load(cnt, RLX_AG) < 8u) { __builtin_amdgcn_s_sleep(1); if (++sp > (1u << 22)) break; } }
    __syncthreads();
    if (tid < 256) { float tot = 0.f;
#pragma unroll
        for (int j = 0; j < 8; ++j) tot += __builtin_bit_cast(float, __hip_atomic_load(X + ((size_t)(pm * 256 + tid)) * 8 + j, RLX_AG));
        R[tid] = rsq_(tot * (1.f / D) + EPS); }
    __syncthreads();
}
template <int WHICH, bool XF32>
struct EpiResid {
    static constexpr bool AFTER_DRAIN = true; static constexpr int CHAIN = 1;
    unsigned char* ws; float* out; const float* xin0; const float* xin1; const float* npost; const float* nnext; int l; int mk_next;
    __device__ __forceinline__ void operator()(const f32x4 (&acc)[2][2][4][2], const Unit& u, int wr, int wc, int fr, int fq) const {}
    __device__ __forceinline__ void fused(f32x4 (&acc)[2][2][4][2], const Unit& u, int wr, int wc, int fr, int fq, LAS unsigned char* lds, int tid) const {
        { int ln_; asm volatile("v_mbcnt_lo_u32_b32 %0, -1, 0\n\tv_mbcnt_hi_u32_b32 %0, -1, %0" : "=v"(ln_)); fr = ln_ & 15; fq = ln_ >> 4; tid = (wr * 4 + wc) * 64 + ln_; }
        LAS float* P = (LAS float*)lds; LAS float* R = (LAS float*)(lds + 4096);
        const int lr0 = wr * 64 + fr, cl = wc * 32 + 8 * fq, ln = fq * 16 + fr;
#pragma unroll
        for (int ai = 0; ai < 2; ++ai)
#pragma unroll
            for (int m = 0; m < 4; ++m) { float sq = 0.f;
#pragma unroll
                for (int bj = 0; bj < 2; ++bj)
#pragma unroll
                    for (int n = 0; n < 2; ++n) { const f32x4 v = acc[ai][bj][m][n]; sq += (v.x * v.x + v.y * v.y) + (v.z * v.z + v.w * v.w); }
                sq += shx(sq, 16, ln); sq += shx(sq, 32, ln);
                if (fq == 0) P[(ai * 128 + lr0 + m * 16) * 4 + wc] = sq; }
        __syncthreads();
        unsigned* X = (unsigned*)(ws + WS_XCH) + (size_t)(WHICH * 2) * MT * 8;
        unsigned* cnt = (unsigned*)(ws + WS_CTL) + CW_CNT + (((l * 2 + WHICH) * 2) * 32 + u.pm) * 64;
        const int sel = (u.pm < 16) ? 0 : 1 + ((u.pm - 16) >> 2);
        const float* MODL = (const float*)(ws + WS_MOD) + (size_t)(l * 5 + sel) * 12288;
        const unsigned cb = (unsigned)(u.pn * 256 + cl);
        const bf16* XB = (const bf16*)(ws + WS_XB);
        u32x4 xraw[4][2];
#pragma unroll
        for (int m = 0; m < 4; ++m)
#pragma unroll
            for (int bj = 0; bj < 2; ++bj) xraw[m][bj] = (u32x4){0u, 0u, 0u, 0u};
        if constexpr (!XF32) {
#pragma unroll
            for (int m = 0; m < 4; ++m) { const unsigned r = (unsigned)(u.pm * 256 + lr0 + m * 16);
#pragma unroll
                for (int bj = 0; bj < 2; ++bj) xraw[m][bj] = *(const u32x4*)(XB + r * D + cb + bj * 128); } }
        panel_exchange(P, R, X, cnt, u.pm, u.pn, tid);
        {
        f32x4 gw[2][2];
#pragma unroll
        for (int bj = 0; bj < 2; ++bj)
#pragma unroll
            for (int n = 0; n < 2; ++n) gw[bj][n] = *(const f32x4*)(MODL + (WHICH ? 5 : 2) * D + cb + (bj * 128 + 4 * n)) * *(const f32x4*)(npost + cb + (bj * 128 + 4 * n));
#pragma unroll
        for (int ai = 0; ai < 2; ++ai) { asm volatile("" ::: "memory");
            f32x4 xa[4][2][2];
            if constexpr (XF32) {
#pragma unroll
                for (int m = 0; m < 4; ++m) { const size_t r = (size_t)u.pm * 256 + ai * 128 + lr0 + m * 16; const float* xr = ((r < (size_t)MC) ? xin0 + r * D : xin1 + (r - MC) * D) + cb;
#pragma unroll
                    for (int bj = 0; bj < 2; ++bj)
#pragma unroll
                        for (int n = 0; n < 2; ++n) xa[m][bj][n] = *(const f32x4*)(xr + (bj * 128 + 4 * n)); }
            } else {
                if (ai == 1) {
#pragma unroll
                    for (int m = 0; m < 4; ++m) { const unsigned r = (unsigned)(u.pm * 256 + 128 + lr0 + m * 16);
#pragma unroll
                        for (int bj = 0; bj < 2; ++bj) xraw[m][bj] = *(const u32x4*)(XB + r * D + cb + bj * 128); } }
#pragma unroll
                for (int m = 0; m < 4; ++m)
#pragma unroll
                    for (int bj = 0; bj < 2; ++bj) { const u32x4 w = xraw[m][bj];
                        xa[m][bj][0] = (f32x4){bf_lo(w.x), bf_hi(w.x), bf_lo(w.y), bf_hi(w.y)}; xa[m][bj][1] = (f32x4){bf_lo(w.z), bf_hi(w.z), bf_lo(w.w), bf_hi(w.w)}; } }
#pragma unroll
            for (int m = 0; m < 4; ++m) { const int lr = ai * 128 + lr0 + m * 16; const float rs = R[lr]; float sq = 0.f;
#pragma unroll
                for (int bj = 0; bj < 2; ++bj)
#pragma unroll
                    for (int n = 0; n < 2; ++n) { const f32x4 xn = xa[m][bj][n] + gw[bj][n] * (acc[ai][bj][m][n] * rs); acc[ai][bj][m][n] = xn;
                        sq += (xn.x * xn.x + xn.y * xn.y) + (xn.z * xn.z + xn.w * xn.w); }
                sq += shx(sq, 16, ln); sq += shx(sq, 32, ln);
                if (fq == 0) P[lr * 4 + wc] = sq; } }
        }
        if (!mk_next) {
#pragma unroll
            for (int ai = 0; ai < 2; ++ai)
#pragma unroll
                for (int m = 0; m < 4; ++m) { const size_t r = (size_t)u.pm * 256 + ai * 128 + lr0 + m * 16; float* orow = out + r * D + cb;
#pragma unroll
                    for (int bj = 0; bj < 2; ++bj)
#pragma unroll
                        for (int n = 0; n < 2; ++n) *(f32x4*)(orow + (bj * 128 + 4 * n)) = acc[ai][bj][m][n]; }
            return; }
        const float* MODN = (const float*)(ws + WS_MOD) + (size_t)((WHICH ? l + 1 : l) * 5 + sel) * 12288;
        f32x4 va[2][2], vb[2][2], sh[2][2];
#pragma unroll
        for (int bj = 0; bj < 2; ++bj)
#pragma unroll
            for (int n = 0; n < 2; ++n) { const unsigned c = cb + (unsigned)(bj * 128 + 4 * n);
                va[bj][n] = *(const f32x4*)(nnext + c); vb[bj][n] = *(const f32x4*)(MODN + (WHICH ? 1 : 4) * D + c); sh[bj][n] = *(const f32x4*)(MODN + (WHICH ? 0 : 3) * D + c); }
        __syncthreads();
        panel_exchange(P, R, X + (size_t)MT * 8, cnt + 32 * 64, u.pm, u.pn, tid);
        f32x4 vv[2][2];
#pragma unroll
        for (int bj = 0; bj < 2; ++bj)
#pragma unroll
            for (int n = 0; n < 2; ++n) vv[bj][n] = va[bj][n] * (vb[bj][n] + 1.f);
        bf16* H = (bf16*)(ws + WS_H); bf16* XO = (bf16*)(ws + WS_XB);
#pragma unroll
        for (int ai = 0; ai < 2; ++ai)
#pragma unroll
            for (int m = 0; m < 4; ++m) { const int lr = ai * 128 + lr0 + m * 16; const unsigned r = (unsigned)(u.pm * 256 + lr); const float rs = R[lr];
#pragma unroll
                for (int bj = 0; bj < 2; ++bj) {
                    st8bf(XO + r * D + cb + bj * 128, acc[ai][bj][m][0], acc[ai][bj][m][1]);
                    st8bf(H + r * D + cb + bj * 128, (acc[ai][bj][m][0] * rs) * vv[bj][0] + sh[bj][0], (acc[ai][bj][m][1] * rs) * vv[bj][1] + sh[bj][1]); } }
        __syncthreads();
    }
};

__device__ __forceinline__ void job_ckv_norm(ArgP a, int l, int wave) {
    const int tidn = tid_now(wave), lane = tidn & 63;
    const int gw = blockIdx.x * 8 + wave, NGW = gridDim.x * 8;
    const float* SS = (const float*)(a->ws + WS_SSQKV);
    const f32x4 g = *(const f32x4*)(a->in[20] + l * 256 + lane * 4);
    for (int m = gw; m < MC; m += NGW) {
        const f32x4 s0 = *(const f32x4*)(SS + (size_t)m * 4); const float rs = rsq_(((s0.x + s0.y) + (s0.z + s0.w)) * (1.f / 256.f) + EPS);
        float* p = a->out + OUT_CKV + ((size_t)((m >> 8) * 4 + l) * 256 + (m & 255)) * 256 + lane * 4;
        *(f32x4*)p = *(const f32x4*)p * rs * g;
    }
}

typedef short s16x4 __attribute__((ext_vector_type(4)));
typedef short v4i16_t __attribute__((ext_vector_type(4)));
constexpr float LOG2E = 1.4426950408889634f;
__device__ __forceinline__ unsigned k_swz(unsigned ob) { return ob ^ (((ob >> 9) & 1u) << 5); }
__device__ __forceinline__ unsigned offb(unsigned row, unsigned ch) { return 256u * row + 16u * (ch ^ (((row & 3u) << 2) | ((row >> 2) & 3u))); }
__device__ __forceinline__ unsigned cvtpk(float lo, float hi) { return pk2(lo, hi); }

template <int DK>
__device__ __forceinline__ void attn_stage_load(u32x4 (&kr)[DK / 64], u32x4 (&vr)[2], const bf16* K1, int ldk1, const bf16* K2, int ldk2, const bf16* V, int ldv, int row0, int tid) {
#pragma unroll
    for (int i = 0; i < DK / 64; ++i) { const int c = tid + 512 * i, key = c / (DK / 8), ch = c % (DK / 8);
        if (DK == 128 || ch < 16) kr[i] = *(const u32x4*)(K1 + (unsigned)((row0 + key) * ldk1 + ch * 8)); else kr[i] = *(const u32x4*)(K2 + (unsigned)((row0 + key) * ldk2 + (ch - 16) * 8)); }
#pragma unroll
    for (int i = 0; i < 2; ++i) { const int c = tid + 512 * i, row = c >> 4, ch = c & 15; vr[i] = *(const u32x4*)(V + (unsigned)((row0 + row) * ldv + ch * 8)); }
}
template <int DK>
__device__ __forceinline__ void attn_stage_store(LAS unsigned char* kb, LAS unsigned char* vb, const u32x4 (&kr)[DK / 64], const u32x4 (&vr)[2], int tid) {
#pragma unroll
    for (int i = 0; i < DK / 64; ++i) { const int c = tid + 512 * i, key = c / (DK / 8), ch = c % (DK / 8);
        const int w = key & 31, lr = (key & 32) + ((w >> 2) & 1) * 16 + (w >> 3) * 4 + (w & 3);
        *(LAS u32x4*)(kb + ((lr >> 4) * (DK / 32) + (ch >> 2)) * 1024 + k_swz((unsigned)((lr & 15) * 64 + (ch & 3) * 16))) = kr[i]; }
#pragma unroll
    for (int i = 0; i < 2; ++i) { const int c = tid + 512 * i, row = c >> 4, ch = c & 15; *(LAS u32x4*)(vb + offb((unsigned)row, (unsigned)ch)) = vr[i]; }
}
template <int DK>
__device__ __forceinline__ void attn_unit(LAS unsigned char* lds, int wave, int tid, const bf16* Q, int ldq, const bf16* K1, int ldk1, const bf16* K2, int ldk2, const bf16* V, int ldv,
                                          int s0_row, int s0_tiles, int s1_row, int s1_tiles, bool masked, int qpos0, int kpos0, float sink2, bool has_sink, bf16* O, int ldo) {
    constexpr int KS = DK / 32, KBYTES = 64 * DK * 2, BUF = KBYTES + 16384;
    const int lane = tid & 63, g = lane >> 4, i = lane & 15, q = i >> 2, p = i & 3;
    bf16x8 qf[KS];
    { const bf16* qp = Q + (size_t)(16 * wave + i) * ldq + g * 8;
#pragma unroll
      for (int ks = 0; ks < KS; ++ks) qf[ks] = *(const bf16x8*)(qp + ks * 32); }
    const unsigned koff = k_swz((unsigned)(i * 64 + g * 16));
    unsigned voff[2], vsw[2];
#pragma unroll
    for (int h = 0; h < 2; ++h) { voff[h] = 256u * (unsigned)(8 * g + 4 * h + q) + 8u * (unsigned)(p & 1); vsw[h] = (unsigned)((q << 2) | ((2 * g + h) & 3)); }
    f32x4 o[8];
#pragma unroll
    for (int d = 0; d < 8; ++d) o[d] = (f32x4){0.f, 0.f, 0.f, 0.f};
    float mrun = has_sink ? sink2 : -1e30f, lsum = (has_sink && g == 0) ? 1.f : 0.f;
    const int nt = s0_tiles + s1_tiles, tq = qpos0 + 16 * wave + i;
    u32x4 kr[2][DK / 64], vr[2][2];
    attn_stage_load<DK>(kr[0], vr[0], K1, ldk1, K2, ldk2, V, ldv, s0_row, tid);
    attn_stage_store<DK>(lds, lds + KBYTES, kr[0], vr[0], tid);
    { const int rown = 1 < s0_tiles ? s0_row + 64 : s1_row + 64 * (1 - s0_tiles); attn_stage_load<DK>(kr[1], vr[1], K1, ldk1, K2, ldk2, V, ldv, rown, tid); }
    asm volatile("s_waitcnt lgkmcnt(0)" ::: "memory"); __builtin_amdgcn_s_barrier();
    for (int t2 = 0; t2 < nt; t2 += 2) {
#pragma unroll
      for (int par = 0; par < 2; ++par) {
        const int t = t2 + par;
        if (t + 2 < nt) { const int tn = t + 2; const int rown = tn < s0_tiles ? s0_row + 64 * tn : s1_row + 64 * (tn - s0_tiles); attn_stage_load<DK>(kr[par], vr[par], K1, ldk1, K2, ldk2, V, ldv, rown, tid); }
        LAS unsigned char* kb = lds + par * BUF; LAS unsigned char* vb = kb + KBYTES;
        f32x4 s[2][2];
        constexpr int KQB = (KS <= 4) ? 2 : 1;
        bf16x8 kq[KQB][KS];
#define ATT_LOADK(blk, dst) _Pragma("unroll") for (int ks = 0; ks < KS; ++ks) dst[ks] = *(const LAS bf16x8*)(kb + ((blk) * KS + ks) * 1024 + koff)
        if (KQB == 2) { ATT_LOADK(0, kq[0]); }
#pragma unroll
        for (int bq = 0; bq < 4; ++bq) {
            if (KQB == 2) { if (bq < 3) { ATT_LOADK(bq + 1, kq[(bq + 1) & (KQB - 1)]); } } else { ATT_LOADK(bq, kq[0]); }
            __builtin_amdgcn_sched_barrier(0);
            f32x4 acc = (f32x4){0.f, 0.f, 0.f, 0.f};
#pragma unroll
            for (int ks = 0; ks < KS; ++ks) acc = __builtin_amdgcn_mfma_f32_16x16x32_bf16(kq[bq & (KQB - 1)][ks], qf[ks], acc, 0, 0, 0);
            s[bq >> 1][bq & 1] = acc;
            __builtin_amdgcn_sched_barrier(0);
        }
#undef ATT_LOADK
        bf16x8 vq[1][8];
#define ATT_LOADV(kh_, dst) _Pragma("unroll") for (int d = 0; d < 8; ++d) { \
            const s16x4 v0_ = __builtin_bit_cast(s16x4, __builtin_amdgcn_ds_read_tr16_b64_v4i16((LAS v4i16_t*)(vb + (kh_) * 8192 + voff[0] + 16u * ((unsigned)(2 * d + (p >> 1)) ^ vsw[0])))); \
            const s16x4 v1_ = __builtin_bit_cast(s16x4, __builtin_amdgcn_ds_read_tr16_b64_v4i16((LAS v4i16_t*)(vb + (kh_) * 8192 + voff[1] + 16u * ((unsigned)(2 * d + (p >> 1)) ^ vsw[1])))); \
            dst[d] = (bf16x8){v0_.x, v0_.y, v0_.z, v0_.w, v1_.x, v1_.y, v1_.z, v1_.w}; }
        if (KS <= 4) { ATT_LOADV(0, vq[0]); }
        __builtin_amdgcn_sched_barrier(0);
        if (masked && t < s0_tiles) { const int kp = kpos0 + 64 * t + 8 * g;
#pragma unroll
            for (int kh = 0; kh < 2; ++kh)
#pragma unroll
                for (int hi = 0; hi < 2; ++hi)
#pragma unroll
                    for (int e = 0; e < 4; ++e) { const int d = tq - (kp + 32 * kh + 4 * hi + e); if (d > 128 || d < -128) s[kh][hi][e] = -1e30f; } }
        float tm = fmaxf(fmaxf(fmaxf(s[0][0].x, s[0][0].y), fmaxf(s[0][0].z, s[0][0].w)), fmaxf(fmaxf(s[0][1].x, s[0][1].y), fmaxf(s[0][1].z, s[0][1].w)));
        tm = fmaxf(tm, fmaxf(fmaxf(fmaxf(s[1][0].x, s[1][0].y), fmaxf(s[1][0].z, s[1][0].w)), fmaxf(fmaxf(s[1][1].x, s[1][1].y), fmaxf(s[1][1].z, s[1][1].w))));
        tm = fmaxf(tm, shx(tm, 16, lane)); tm = fmaxf(tm, shx(tm, 32, lane));
        const float mnew = fmaxf(mrun, tm), alpha = __builtin_amdgcn_exp2f(mrun - mnew); mrun = mnew;
        float ps = 0.f; bf16x8 pf[2];
#pragma unroll
        for (int kh = 0; kh < 2; ++kh) { float pv[8];
#pragma unroll
            for (int hi = 0; hi < 2; ++hi)
#pragma unroll
                for (int e = 0; e < 4; ++e) { const float pe = __builtin_amdgcn_exp2f(s[kh][hi][e] - mnew); pv[hi * 4 + e] = pe; ps += pe; }
            u32x4 w; w.x = cvtpk(pv[0], pv[1]); w.y = cvtpk(pv[2], pv[3]); w.z = cvtpk(pv[4], pv[5]); w.w = cvtpk(pv[6], pv[7]); pf[kh] = __builtin_bit_cast(bf16x8, w); }
        lsum = lsum * alpha + ps;
#pragma unroll
        for (int d = 0; d < 8; ++d) o[d] = o[d] * alpha;
        if (KS > 4) { ATT_LOADV(0, vq[0]); __builtin_amdgcn_sched_barrier(0); }
#pragma unroll
        for (int d = 0; d < 8; ++d) o[d] = __builtin_amdgcn_mfma_f32_16x16x32_bf16(vq[0][d], pf[0], o[d], 0, 0, 0);
        __builtin_amdgcn_sched_barrier(0);
        ATT_LOADV(1, vq[0]);
        __builtin_amdgcn_sched_barrier(0);
#pragma unroll
        for (int d = 0; d < 8; ++d) o[d] = __builtin_amdgcn_mfma_f32_16x16x32_bf16(vq[0][d], pf[1], o[d], 0, 0, 0);
#undef ATT_LOADV
        if (t + 1 < nt) attn_stage_store<DK>(lds + (1 - par) * BUF, lds + (1 - par) * BUF + KBYTES, kr[1 - par], vr[1 - par], tid);
        asm volatile("s_waitcnt lgkmcnt(0)" ::: "memory"); __builtin_amdgcn_s_barrier();
      }
    }
    lsum += shx(lsum, 16, lane); lsum += shx(lsum, 32, lane);
    const float inv = 1.f / lsum;
    const int lane_e = tid_now(wave) & 63;
    bf16* op = O + (unsigned)((16 * wave + (lane_e & 15)) * ldo + 4 * (lane_e >> 4));
#pragma unroll
    for (int d = 0; d < 8; ++d) { u32x2 w; w.x = cvtpk(o[d].x * inv, o[d].y * inv); w.y = cvtpk(o[d].z * inv, o[d].w * inv); *(u32x2*)(op + 16 * d) = w; }
}
__device__ __forceinline__ void job_attn_c(ArgP a, int l, LAS unsigned char* lds, int wave, int u_first, int u_end, int u_stride) {
    const int tid = tid_now(wave); unsigned char* ws = a->ws;
    const bf16* Q = (const bf16*)(ws + WS_QC); const bf16* K = (const bf16*)(ws + WS_KC) + (size_t)l * MKV * 256; const bf16* V = (const bf16*)(ws + WS_VC) + (size_t)l * MKV * 256;
    bf16* O = (bf16*)(ws + WS_OC);
    for (int u = u_first; u < u_end; u += u_stride) {
        int h, m0, s0r, s0t, s1r, s1t, qp, kp; bool mk;
        if (u < 256) { const int b = u >> 6, qb = u & 7; h = (u >> 3) & 7; const int lo = qb * 128 - 128 < 0 ? 0 : qb * 128 - 128, hi = qb * 128 + 256 > 1024 ? 1024 : qb * 128 + 256;
            m0 = MC + b * 1024 + qb * 128; s0r = MC + b * 1024 + lo; s0t = (hi - lo) >> 6; s1r = MT + b * 256; s1t = 4; mk = true; qp = qb * 128; kp = lo; }
        else { const int v = u - 256, b = v >> 4, qb = v & 1; h = (v >> 1) & 7; m0 = b * 256 + qb * 128; s0r = b * 256; s0t = 4; s1r = 0; s1t = 0; mk = false; qp = 0; kp = 0; }
        const int kg = h >> 2;
        attn_unit<128>(lds, wave, tid, Q + (size_t)m0 * 1024 + h * 128, 1024, K + kg * 128, 256, nullptr, 0, V + kg * 128, 256, s0r, s0t, s1r, s1t, mk, qp, kp,
                       a->in[22][l * 8 + h] * LOG2E, true, O + (size_t)m0 * 1024 + h * 128, 1024);
    }
}
__device__ __forceinline__ void job_attn_b(ArgP a, int l, LAS unsigned char* lds, int wave) {
    const int tid = tid_now(wave); unsigned char* ws = a->ws;
    const bf16* Q = (const bf16*)(ws + WS_QF); const bf16* KV = (const bf16*)(ws + WS_KV); const bf16* KR = (const bf16*)(ws + WS_KR) + (size_t)l * MKV * 64;
    bf16* O = (bf16*)(ws + WS_OBB);
    for (int u = blockIdx.x; u < 512; u += gridDim.x) {
        int h, m0, s0r, s0t, s1r, s1t;
        if (u < 256) { const int b = u >> 6, qb = u & 7; h = (u >> 3) & 7; m0 = MC + b * 1024 + qb * 128; s0r = MC + b * 1024; s0t = 16; s1r = MT + b * 256; s1t = 4; }
        else { const int v = u - 256, b = v >> 4, qb = v & 1; h = (v >> 1) & 7; m0 = b * 256 + qb * 128; s0r = b * 256; s0t = 4; s1r = 0; s1t = 0; }
        attn_unit<192>(lds, wave, tid, Q + (size_t)m0 * 1536 + h * 192, 1536, KV + h * 128, 2048, KR, 64, KV + 1024 + h * 128, 2048, s0r, s0t, s1r, s1t, false, 0, 0, 0.f, false,
                       O + (size_t)m0 * 1024 + h * 128, 1024);
    }
}
constexpr int SC_QG = 0, SC_KG = 8192, SC_KD = 16384, SC_VV = 24576, SC_EL = 32768, SC_SEG = 33280, SC_BUF = 38912;
__device__ __forceinline__ bf16x8 tr2(LAS unsigned char* p0, LAS unsigned char* p1) {
    const s16x4 v0 = __builtin_bit_cast(s16x4, __builtin_amdgcn_ds_read_tr16_b64_v4i16((LAS v4i16_t*)p0));
    const s16x4 v1 = __builtin_bit_cast(s16x4, __builtin_amdgcn_ds_read_tr16_b64_v4i16((LAS v4i16_t*)p1));
    return (bf16x8){v0.x, v0.y, v0.z, v0.w, v1.x, v1.y, v1.z, v1.w};
}
struct ScanRegs { unsigned lg[4]; unsigned qv[4]; u32x4 vv; };
__device__ __forceinline__ void scan_stage_load(ScanRegs& R, const bf16* LG, const bf16* KK, const bf16* QA, const bf16* VA, int m0, int n, int dir, int h, int c, int wave, int lane, int tid) {
#pragma unroll
    for (int tt = 0; tt < 4; ++tt) { const int j = 32 * c + 4 * wave + tt; const size_t m = m0 + (dir ? n - 1 - j : j);
        R.lg[tt] = *(const unsigned*)(LG + m * 2048 + dir * 1024 + h * 128 + 2 * lane);
        R.qv[tt] = *(const unsigned*)(QA + m * 1024 + h * 128 + 2 * lane); }
    { const int j = 32 * c + (tid >> 4); const size_t m = m0 + (dir ? n - 1 - j : j); R.vv = *(const u32x4*)(VA + m * 1024 + h * 128 + (tid & 15) * 8); }
}
__device__ __forceinline__ void scan_stage_finish(const ScanRegs& R, LAS unsigned char* buf, int wave, int lane, int tid) {
    f32x2 cs[4]; cs[0] = (f32x2){bf_lo(R.lg[0]), bf_hi(R.lg[0])}; cs[1] = cs[0] + (f32x2){bf_lo(R.lg[1]), bf_hi(R.lg[1])}; cs[2] = cs[1] + (f32x2){bf_lo(R.lg[2]), bf_hi(R.lg[2])}; cs[3] = cs[2] + (f32x2){bf_lo(R.lg[3]), bf_hi(R.lg[3])};
    LAS f32x2* SEG = (LAS f32x2*)(buf + SC_SEG);
    SEG[wave * 64 + lane] = cs[3];
    asm volatile("s_waitcnt lgkmcnt(0)" ::: "memory"); __builtin_amdgcn_s_barrier();
    f32x2 pre = (f32x2){0.f, 0.f}, tot = (f32x2){0.f, 0.f};
#pragma unroll
    for (int s = 0; s < 8; ++s) { const f32x2 v = SEG[s * 64 + lane]; tot += v; if (s < wave) pre += v; }
#pragma unroll
    for (int tt = 0; tt < 4; ++tt) { const int j = 4 * wave + tt; const f32x2 G = pre + cs[tt];
        const float e0 = __expf(G.x), e1 = __expf(G.y), i0 = __expf(fminf(-G.x, 80.f)), i1 = __expf(fminf(-G.y, 80.f)), d0 = __expf(tot.x - G.x), d1 = __expf(tot.y - G.y);
        const float k0 = 1.f - __expf(bf_lo(R.lg[tt])), k1 = 1.f - __expf(bf_hi(R.lg[tt])), q0 = bf_lo(R.qv[tt]), q1 = bf_hi(R.qv[tt]);
        const unsigned o = offb((unsigned)j, (unsigned)(lane >> 2)) + 4u * (unsigned)(lane & 3);
        *(LAS unsigned*)(buf + SC_QG + o) = cvtpk(q0 * e0, q1 * e1);
        *(LAS unsigned*)(buf + SC_KG + o) = cvtpk(k0 * i0, k1 * i1);
        *(LAS unsigned*)(buf + SC_KD + o) = cvtpk(k0 * d0, k1 * d1); }
    *(LAS u32x4*)(buf + SC_VV + offb((unsigned)(tid >> 4), (unsigned)(tid & 15))) = R.vv;
    if (wave == 0) ((LAS f32x2*)(buf + SC_EL))[lane] = (f32x2){__expf(tot.x), __expf(tot.y)};
    asm volatile("s_waitcnt lgkmcnt(0)" ::: "memory"); __builtin_amdgcn_s_barrier();
}
__device__ __forceinline__ void scan_item(ArgP a, int l, int item, LAS unsigned char* lds, int wave, int tid) {
    const int lane = tid & 63, g = lane >> 4, i = lane & 15, q = i >> 2, p = i & 3;
    const int dir = item & 1, h = (item >> 1) & 7, sq = item >> 4;
    const bool lat = sq >= 16; const int n = lat ? 1024 : 256; const int m0 = lat ? MC + (sq - 16) * 1024 : sq * 256; const int nc = n >> 5;
    unsigned char* ws = a->ws;
    const bf16* QA = (const bf16*)(ws + WS_QA); const bf16* KK = (const bf16*)(ws + WS_KK); const bf16* VA = (const bf16*)(ws + WS_VA); const bf16* LG = (const bf16*)(ws + WS_LG);
    bf16* OO = (bf16*)(ws + (dir ? WS_OB : WS_OF));
    f32x4 S[8];
    if (lat) { const float* s0 = a->in[2] + ((((size_t)(sq - 16) * 4 + l) * 2 + dir) * 8 + h) * 16384 + 16 * wave + i;
#pragma unroll
        for (int aa = 0; aa < 8; ++aa)
#pragma unroll
            for (int e = 0; e < 4; ++e) S[aa][e] = s0[(16 * aa + 4 * g + e) * 128]; }
    else {
#pragma unroll
        for (int aa = 0; aa < 8; ++aa) S[aa] = (f32x4){0.f, 0.f, 0.f, 0.f}; }
    ScanRegs R0, R1;
    scan_stage_load(R0, LG, KK, QA, VA, m0, n, dir, h, 0, wave, lane, tid);
    scan_stage_load(R1, LG, KK, QA, VA, m0, n, dir, h, 1, wave, lane, tid);
    scan_stage_finish(R0, lds, wave, lane, tid);
    unsigned rro[2][4];
#pragma unroll
    for (int b = 0; b < 2; ++b)
#pragma unroll
        for (int ks = 0; ks < 4; ++ks) rro[b][ks] = offb((unsigned)(16 * b + i), (unsigned)(4 * ks + g));
    for (int c2 = 0; c2 < nc; c2 += 2) {
#pragma unroll
      for (int par = 0; par < 2; ++par) {
        const int c = c2 + par;
        const bool more = c + 1 < nc;
        if (c + 2 < nc) { if (par == 0) scan_stage_load(R0, LG, KK, QA, VA, m0, n, dir, h, c + 2, wave, lane, tid); else scan_stage_load(R1, LG, KK, QA, VA, m0, n, dir, h, c + 2, wave, lane, tid); }
        LAS unsigned char* buf = lds + par * SC_BUF;
        f32x4 at[2][2];
#pragma unroll
        for (int sb = 0; sb < 2; ++sb)
#pragma unroll
            for (int tb = 0; tb < 2; ++tb) at[sb][tb] = (f32x4){0.f, 0.f, 0.f, 0.f};
        { bf16x8 kf[4][2], qf[4][2];
#pragma unroll
          for (int ks = 0; ks < 4; ++ks)
#pragma unroll
              for (int b = 0; b < 2; ++b) { kf[ks][b] = *(const LAS bf16x8*)(buf + SC_KG + rro[b][ks]); qf[ks][b] = *(const LAS bf16x8*)(buf + SC_QG + rro[b][ks]); }
          __builtin_amdgcn_sched_barrier(0);
#pragma unroll
          for (int ks = 0; ks < 4; ++ks)
#pragma unroll
              for (int sb = 0; sb < 2; ++sb)
#pragma unroll
                  for (int tb = 0; tb < 2; ++tb) at[sb][tb] = __builtin_amdgcn_mfma_f32_16x16x32_bf16(kf[ks][sb], qf[ks][tb], at[sb][tb], 0, 0, 0); }
        bf16x8 pb[2];
#pragma unroll
        for (int tb = 0; tb < 2; ++tb) { float v[8];
#pragma unroll
            for (int sb = 0; sb < 2; ++sb)
#pragma unroll
                for (int e = 0; e < 4; ++e) v[sb * 4 + e] = (16 * sb + 4 * g + e > 16 * tb + i) ? 0.f : at[sb][tb][e];
            u32x4 w; w.x = cvtpk(v[0], v[1]); w.y = cvtpk(v[2], v[3]); w.z = cvtpk(v[4], v[5]); w.w = cvtpk(v[6], v[7]); pb[tb] = __builtin_bit_cast(bf16x8, w); }
        f32x4 ot[2];
        u32x4 qb[4][2];
        const bf16x8 vfi = tr2(buf + SC_VV + offb((unsigned)(4 * g + q), (unsigned)(2 * wave + (p >> 1))) + 8 * (p & 1), buf + SC_VV + offb((unsigned)(16 + 4 * g + q), (unsigned)(2 * wave + (p >> 1))) + 8 * (p & 1));
#pragma unroll
        for (int ks = 0; ks < 4; ++ks)
#pragma unroll
            for (int tb = 0; tb < 2; ++tb) {
                const u32x2 b0 = *(const LAS u32x2*)(buf + SC_QG + offb((unsigned)(16 * tb + i), (unsigned)(4 * ks + (g >> 1))) + 8 * (g & 1));
                const u32x2 b1 = *(const LAS u32x2*)(buf + SC_QG + offb((unsigned)(16 * tb + i), (unsigned)(4 * ks + 2 + (g >> 1))) + 8 * (g & 1));
                qb[ks][tb] = (u32x4){b0.x, b0.y, b1.x, b1.y}; }
        __builtin_amdgcn_sched_barrier(0);
#pragma unroll
        for (int tb = 0; tb < 2; ++tb) ot[tb] = __builtin_amdgcn_mfma_f32_16x16x32_bf16(vfi, pb[tb], (f32x4){0.f, 0.f, 0.f, 0.f}, 0, 0, 0);
#pragma unroll
        for (int ks = 0; ks < 4; ++ks) {
            u32x4 w; w.x = cvtpk(S[2 * ks].x, S[2 * ks].y); w.y = cvtpk(S[2 * ks].z, S[2 * ks].w); w.z = cvtpk(S[2 * ks + 1].x, S[2 * ks + 1].y); w.w = cvtpk(S[2 * ks + 1].z, S[2 * ks + 1].w);
            const bf16x8 sa = __builtin_bit_cast(bf16x8, w);
#pragma unroll
            for (int tb = 0; tb < 2; ++tb) ot[tb] = __builtin_amdgcn_mfma_f32_16x16x32_bf16(sa, __builtin_bit_cast(bf16x8, qb[ks][tb]), ot[tb], 0, 0, 0); }
        bf16x8 kdf[8]; f32x4 el[8];
        const bf16x8 vfu = tr2(buf + SC_VV + offb((unsigned)(8 * g + q), (unsigned)(2 * wave + (p >> 1))) + 8 * (p & 1), buf + SC_VV + offb((unsigned)(8 * g + 4 + q), (unsigned)(2 * wave + (p >> 1))) + 8 * (p & 1));
#pragma unroll
        for (int aa = 0; aa < 8; ++aa) { el[aa] = *(const LAS f32x4*)(buf + SC_EL + (16 * aa + 4 * g) * 4);
            kdf[aa] = tr2(buf + SC_KD + offb((unsigned)(8 * g + q), (unsigned)(2 * aa + (p >> 1))) + 8 * (p & 1), buf + SC_KD + offb((unsigned)(8 * g + 4 + q), (unsigned)(2 * aa + (p >> 1))) + 8 * (p & 1)); }
        __builtin_amdgcn_sched_barrier(0);
#pragma unroll
        for (int tb = 0; tb < 2; ++tb) { const int j = 32 * c + 16 * tb + i; const size_t m = m0 + (dir ? n - 1 - j : j);
            u32x2 w2; w2.x = cvtpk(ot[tb].x, ot[tb].y); w2.y = cvtpk(ot[tb].z, ot[tb].w); *(u32x2*)(OO + m * 1024 + h * 128 + 16 * wave + 4 * g) = w2; }
#pragma unroll
        for (int aa = 0; aa < 8; ++aa) S[aa] = __builtin_amdgcn_mfma_f32_16x16x32_bf16(kdf[aa], vfu, S[aa] * el[aa], 0, 0, 0);
        if (more) { if (par == 0) scan_stage_finish(R1, lds + SC_BUF, wave, lane, tid); else scan_stage_finish(R0, lds, wave, lane, tid); }
      }
    }
    if (!lat) { float* so = a->out + OUT_ST + ((((size_t)sq * 4 + l) * 2 + dir) * 8 + h) * 16384 + 16 * wave + i;
#pragma unroll
        for (int aa = 0; aa < 8; ++aa)
#pragma unroll
            for (int e = 0; e < 4; ++e) so[(16 * aa + 4 * g + e) * 128] = S[aa][e]; }
    __syncthreads();
}
__device__ __forceinline__ void job_oa_post(ArgP a, int l, int wave) {
    const int tidn = tid_now(wave), lane = tidn & 63;
    const int gw = blockIdx.x * 8 + wave, NGW = gridDim.x * 8;
    const bf16* OF = (const bf16*)(a->ws + WS_OF); const bf16* OB = (const bf16*)(a->ws + WS_OB); const bf16* AG = (const bf16*)(a->ws + WS_AG); bf16* O = (bf16*)(a->ws + WS_OA);
    const float* gn = a->in[17] + l * 128 + (lane & 7) * 16;
    for (int m = gw; m < MT; m += NGW) {
        const size_t o = (size_t)m * 1024 + lane * 16; f32x4 v[4]; float s = 0.f;
#pragma unroll
        for (int j = 0; j < 4; ++j) { const u32x2 fa = *(const u32x2*)(OF + o + 4 * j), fb = *(const u32x2*)(OB + o + 4 * j); v[j] = (f32x4){bf_lo(fa.x) + bf_lo(fb.x), bf_hi(fa.x) + bf_hi(fb.x), bf_lo(fa.y) + bf_lo(fb.y), bf_hi(fa.y) + bf_hi(fb.y)}; s += (v[j].x * v[j].x + v[j].y * v[j].y) + (v[j].z * v[j].z + v[j].w * v[j].w); }
        s += shx(s, 1, lane); s += shx(s, 2, lane); s += shx(s, 4, lane);
        const float rs = rsq_(s * (1.f / 128.f) + EPS);
        const u32x4 g0 = *(const u32x4*)(AG + o), g1 = *(const u32x4*)(AG + o + 8);
        const unsigned gg[8] = {g0.x, g0.y, g0.z, g0.w, g1.x, g1.y, g1.z, g1.w};
        unsigned ow[8];
#pragma unroll
        for (int j = 0; j < 4; ++j) { const f32x4 w = *(const f32x4*)(gn + 4 * j); const f32x4 r = v[j] * rs * w;
            ow[2 * j] = pk2(r.x * bf_lo(gg[2 * j]), r.y * bf_hi(gg[2 * j])); ow[2 * j + 1] = pk2(r.z * bf_lo(gg[2 * j + 1]), r.w * bf_hi(gg[2 * j + 1])); }
        *(u32x4*)(O + o) = (u32x4){ow[0], ow[1], ow[2], ow[3]}; *(u32x4*)(O + o + 8) = (u32x4){ow[4], ow[5], ow[6], ow[7]};
    }
}
constexpr int PH_PER_LAYER = 7, PH_PRE = 3, PH_TOTAL = PH_PRE + NL * PH_PER_LAYER;
__global__ void __launch_bounds__(512, 2) mega(Args args) {
    extern __shared__ __attribute__((aligned(16))) unsigned char lds_raw[];
    LAS unsigned char* lds = (LAS unsigned char*)lds_raw;
    const int tid = threadIdx.x, lane = tid & 63, wave = __builtin_amdgcn_readfirstlane(tid >> 6);
    volatile LAS unsigned* MISC = (volatile LAS unsigned*)(lds + MISC_OFF);
    for (int u = tid; u < (LDS_BYTES - LDSCTL_OFF) / 4; u += 512) ((LAS unsigned*)(lds + LDSCTL_OFF))[u] = 0u;
    __syncthreads();
    unsigned* barw = (unsigned*)(args.ws + WS_CTL) + CW_BAR;
    XcdBarrier bar; bar.bar = barw; bar.x = 0; bar.st = nullptr;
    if (args.use_bar) bar = xcd_barrier_post(barw, MISC + 8);
    const int lo = args.ph_lo, hi = args.ph_hi;
#ifndef PHMASK
#define PHMASK 0xFFFF
#endif
#define EN(j) ((PHMASK >> (j)) & 1)
#ifndef P2MASK
#define P2MASK 0xFF
#endif
#define P2EN(j) ((P2MASK >> (j)) & 1)
#ifndef DUPMASK
#define DUPMASK 0
#endif
#define REP(j) for (int rep_ = 0; rep_ < 1 + ((DUPMASK >> (j)) & 1); ++rep_)
#define IN(k) (lo <= (k) && (k) < hi)
#define SEAM(k) do { if (IN((k) + 1)) xcd_barrier(bar); } while (0)
    const int G = gridDim.x, bx = blockIdx.x;
#define LAUNDER(p) asm volatile("" : "+s"(p))

    if (EN(0) && IN(0)) { ArgP ap = (ArgP)__builtin_amdgcn_kernarg_segment_ptr(); LAUNDER(ap); REP(0) { phase_prologue(ap, lds, wave); } SEAM(0); }
    if (EN(1) && IN(1)) { ArgP ap = (ArgP)__builtin_amdgcn_kernarg_segment_ptr(); LAUNDER(ap); REP(1) { phase_modreduce(ap, wave); } SEAM(1); }
    if (EN(2) && IN(2)) { ArgP ap = (ArgP)__builtin_amdgcn_kernarg_segment_ptr(); LAUNDER(ap); REP(2) { phase_h0(ap, wave); } SEAM(2); }

    for (int l = 0; l < NL; ++l) {
        const int pb = PH_PRE + l * PH_PER_LAYER;
        if (EN(3) && IN(pb + 0)) { ArgP ap = (ArgP)__builtin_amdgcn_kernarg_segment_ptr(); LAUNDER(ap); unsigned char* ws = ap->ws; unsigned char* wl = ws + WS_W + (size_t)l * WL_STRIDE; float* outp = ap->out; REP(3) {
            pg8::Gemm g{(const bf16*)(ws + WS_H), (const bf16*)(wl + WO_IN), MT, NINP, D, D, nullptr, nullptr, nullptr, nullptr}; int bxl = bx, Gl = G; asm volatile("" : "+s"(bxl), "+s"(Gl)); pg8::StaticOrder S; S.init(MT, NINP, Gl, bxl);
            EpiWin E{ws, outp, l}; pg8::gemm_phase(lds, g, S, E, wave);
            }
            SEAM(pb + 0);
        }
        if (EN(4) && IN(pb + 1)) { ArgP ap = (ArgP)__builtin_amdgcn_kernarg_segment_ptr(); LAUNDER(ap); unsigned char* ws = ap->ws; unsigned char* wl = ws + WS_W + (size_t)l * WL_STRIDE; float* outp = ap->out; REP(4) {
            if (bx >= 64) { const int cb = bx - 64, GB = G - 64;
                if (P2EN(0)) { pg8::Gemm g{(const bf16*)(ws + WS_BQ), (const bf16*)(wl + WO_UQ), MT, 1536, 512, 512, nullptr, nullptr, nullptr, nullptr}; pg8::StaticOrder S; S.init(MT, 1536, GB, cb); EpiUq E{ws}; pg8::gemm_phase(lds, g, S, E, wave); }
                LAUNDER(ap); ws = ap->ws; wl = ws + WS_W + (size_t)l * WL_STRIDE;
                if (P2EN(1)) { pg8::Gemm g{(const bf16*)(ws + WS_BKV) + (size_t)l * MKV * 256, (const bf16*)(wl + WO_UKV), MKV, 2048, 256, 256, nullptr, nullptr, nullptr, nullptr}; pg8::StaticOrder S; S.init(MKV, 2048, GB, cb); EpiKv E{ws}; pg8::gemm_phase(lds, g, S, E, wave); }
                __syncthreads();
                LAUNDER(ap);
                if (P2EN(3)) { scan_item(ap, l, cb, lds, wave, tid_now(wave)); if (cb >= 96 && cb < 160) scan_item(ap, l, 192 + (cb - 96), lds, wave, tid_now(wave)); }
                __syncthreads();
                LAUNDER(ap);
            } else {
                if (P2EN(3)) scan_item(ap, l, 256 + bx, lds, wave, tid_now(wave));
            }
            __syncthreads();
            LAUNDER(ap);
            if (P2EN(2) && rep_ == 0) job_ckv_norm(ap, l, wave);
            }
            SEAM(pb + 1);
        }
        if (EN(5) && IN(pb + 2)) { ArgP ap = (ArgP)__builtin_amdgcn_kernarg_segment_ptr(); LAUNDER(ap); unsigned char* ws = ap->ws; unsigned char* wl = ws + WS_W + (size_t)l * WL_STRIDE; float* outp = ap->out; REP(5) {
            job_attn_c(ap, l, lds, wave, bx, 512, G);
            LAUNDER(ap);
            job_attn_b(ap, l, lds, wave);
            LAUNDER(ap);
            job_oa_post(ap, l, wave);
            }
            SEAM(pb + 2);
        }
        if (EN(6) && IN(pb + 3)) { ArgP ap = (ArgP)__builtin_amdgcn_kernarg_segment_ptr(); LAUNDER(ap); unsigned char* ws = ap->ws; unsigned char* wl = ws + WS_W + (size_t)l * WL_STRIDE; float* outp = ap->out; REP(6) {
            pg8::StaticOrder S; S.init(MT, D, G, bx);
            { pg8::Gemm g{(const bf16*)(ws + WS_OA), (const bf16*)(wl + WO_A), MT, D, 1024, 1024, (const bf16*)(ws + WS_OBB), (const bf16*)(wl + WO_B), (const bf16*)(ws + WS_OC), (const bf16*)(wl + WO_C)}; EpiBranch E{ws}; pg8::gemm_phase(lds, g, S, E, wave); }
            }
            SEAM(pb + 3);
        }
        if (EN(7) && IN(pb + 4)) { ArgP ap = (ArgP)__builtin_amdgcn_kernarg_segment_ptr(); LAUNDER(ap); unsigned char* ws = ap->ws; unsigned char* wl = ws + WS_W + (size_t)l * WL_STRIDE; float* outp = ap->out;
            pg8::Gemm g{(const bf16*)(ws + WS_MG), (const bf16*)(wl + WO_O), MT, D, D, D, nullptr, nullptr, nullptr, nullptr}; pg8::StaticOrder S; S.init(MT, D, G, bx);
            const float* x0 = (l == 0) ? ap->in[0] : outp; const float* x1 = (l == 0) ? ap->in[1] : outp + (size_t)MC * D;
            if (l == 0) { EpiResid<0, true> E{ws, outp, x0, x1, ap->in[12] + l * D, ap->in[13] + l * D, l, 1}; pg8::gemm_phase(lds, g, S, E, wave); }
            else { EpiResid<0, false> E{ws, outp, x0, x1, ap->in[12] + l * D, ap->in[13] + l * D, l, 1}; pg8::gemm_phase(lds, g, S, E, wave); }
            SEAM(pb + 4);
        }
        if (EN(9) && IN(pb + 5)) { ArgP ap = (ArgP)__builtin_amdgcn_kernarg_segment_ptr(); LAUNDER(ap); unsigned char* ws = ap->ws; unsigned char* wl = ws + WS_W + (size_t)l * WL_STRIDE; float* outp = ap->out; REP(9) {
            pg8::Gemm g{(const bf16*)(ws + WS_H), (const bf16*)(wl + WO_UP), MT, NUP, D, D, nullptr, nullptr, nullptr, nullptr}; pg8::SplitOrder S; S.init(MT, NUP, G, bx);
            EpiUp E{ws, ap->in[28] + (size_t)l * 3 * NUP, lds + HALO_OFF, l}; pg8::gemm_phase(lds, g, S, E, wave);
            }
            SEAM(pb + 5);
        }
        if (EN(11) && IN(pb + 6)) { ArgP ap = (ArgP)__builtin_amdgcn_kernarg_segment_ptr(); LAUNDER(ap); unsigned char* ws = ap->ws; unsigned char* wl = ws + WS_W + (size_t)l * WL_STRIDE; float* outp = ap->out;
            pg8::Gemm g{(const bf16*)(ws + WS_ACT), (const bf16*)(wl + WO_DN), MT, D, DFF, DFF, nullptr, nullptr, nullptr, nullptr}; pg8::StaticOrder S; S.init(MT, D, G, bx);
            { Unit u0; if (S.next(0, u0)) conv_fixup(ap, l, u0.pm, wave); }
            LAUNDER(ap); ws = ap->ws; wl = ws + WS_W + (size_t)l * WL_STRIDE; outp = ap->out;
            const int nx = (l < NL - 1) ? 1 : 0;
            EpiResid<1, false> E{ws, outp, outp, outp + (size_t)MC * D, ap->in[14] + l * D, ap->in[11] + (nx ? l + 1 : l) * D, l, nx}; pg8::gemm_phase(lds, g, S, E, wave);
            if (l < NL - 1) SEAM(pb + 6);
        }
    }
#undef IN
#undef SEAM
}

extern "C" void kernel_launch(void* const* d_in, const int* in_sizes, int n_in, void* d_out, int out_size, void* d_ws, size_t ws_size, hipStream_t stream) {
    static int grid = 0;
    if (grid == 0) {
        if (n_in != 30 || (size_t)out_size != OUT_END || ws_size < WS_END) { fprintf(stderr, "kernel_launch: unexpected sizes n_in %d out %d ws %zu\n", n_in, out_size, ws_size); grid = -1; return; }
        int dev = 0, cus = 0, per_cu = 0;
        if (hipGetDevice(&dev) != hipSuccess || hipDeviceGetAttribute(&cus, hipDeviceAttributeMultiprocessorCount, dev) != hipSuccess) { grid = -1; return; }
        if (hipFuncSetAttribute((const void*)mega, hipFuncAttributeMaxDynamicSharedMemorySize, LDS_BYTES) != hipSuccess) { fprintf(stderr, "kernel_launch: hipFuncSetAttribute failed\n"); grid = -1; return; }
        if (hipOccupancyMaxActiveBlocksPerMultiprocessor(&per_cu, (const void*)mega, 512, LDS_BYTES) != hipSuccess || per_cu < 1) fprintf(stderr, "kernel_launch: occupancy query reports %d\n", per_cu);
        (void)hipGetLastError();
        grid = cus;
    }
    if (grid < 0) return;
    (void)hipMemsetAsync((char*)d_ws + WS_CTL, 0, CTL_ZERO_BYTES, stream);
    Args a{};
    for (int i = 0; i < 30; ++i) a.in[i] = (const float*)d_in[i];
    a.out = (float*)d_out; a.ws = (unsigned char*)d_ws; a.pad = 0;
#if MK_ONE_LAUNCH
    a.ph_lo = 0; a.ph_hi = PH_TOTAL; a.use_bar = 1;
    hipLaunchKernelGGL(mega, dim3(grid), dim3(512), LDS_BYTES, stream, a);
#else
    a.use_bar = 0;
    for (int p = 0; p < PH_TOTAL; ++p) { a.ph_lo = p; a.ph_hi = p + 1; hipLaunchKernelGGL(mega, dim3(grid), dim3(512), LDS_BYTES, stream, a); }
#endif
}
```

```cpp
#include <hip/hip_runtime.h>
#include <cstdio>
#include <cstdint>

#ifndef MK_ONE_LAUNCH
#define MK_ONE_LAUNCH 1
#endif

#define GAS __attribute__((address_space(1)))
#define LAS __attribute__((address_space(3)))
typedef unsigned short bf16;
typedef short bf16x8 __attribute__((ext_vector_type(8)));
typedef float f32x4 __attribute__((ext_vector_type(4)));
typedef float f32x2 __attribute__((ext_vector_type(2)));
typedef unsigned u32x4 __attribute__((ext_vector_type(4)));
typedef unsigned u32x2 __attribute__((ext_vector_type(2)));
typedef GAS unsigned gu32;

constexpr int D = 2048, NL = 4, MC = 4096, MT = 8192, MKV = 9216;
constexpr int NIN = 13632, NINP = 13824, DFF = 5504, NUP = 11008;
constexpr float EPS = 1e-6f;
constexpr float SCALE_B = 0.07216878364870322f;
constexpr float SCALE_C = 0.08838834764831845f;

constexpr size_t OUT_Y = 0, OUT_ST = 16777216, OUT_CKV = OUT_ST + 16777216, OUT_KR = OUT_CKV + 4194304, OUT_K = OUT_KR + 1048576, OUT_V = OUT_K + 4194304, OUT_END = OUT_V + 4194304;

constexpr size_t MiB = 1u << 20;
constexpr size_t WS_CTL = 0, CTL_ZERO_BYTES = 1 * MiB;
constexpr size_t WS_MODP = 2 * MiB;
constexpr size_t WS_MOD = 18 * MiB;
constexpr size_t WS_LB = 19 * MiB;
constexpr size_t WS_ROPE = 19 * MiB + 512 * 1024;
constexpr size_t WS_SSQQ = 20 * MiB;
constexpr size_t WS_SSQKV = 20 * MiB + 512 * 1024;
constexpr size_t WS_SSQX = 21 * MiB;
constexpr size_t WS_XCH = 21 * MiB + 512 * 1024;
constexpr size_t WS_CV1 = 22 * MiB;
constexpr size_t WS_CV2 = 24 * MiB;
constexpr size_t WS_W = 32 * MiB, WL_STRIDE = 141 * MiB;
constexpr size_t WO_IN = 0, WO_UQ = 54 * MiB, WO_UKV = WO_UQ + 3 * MiB / 2, WO_A = WO_UKV + 1 * MiB, WO_B = WO_A + 4 * MiB, WO_C = WO_B + 4 * MiB, WO_O = WO_C + 4 * MiB, WO_UP = WO_O + 8 * MiB, WO_DN = WO_UP + 43 * MiB;
static_assert(WO_DN + (size_t)2048 * DFF * 2 <= WL_STRIDE, "weights per layer");
constexpr size_t WS_BKV = 596 * MiB;
constexpr size_t WS_KR = 614 * MiB;
constexpr size_t WS_KC = 619 * MiB;
constexpr size_t WS_VC = 637 * MiB;
constexpr size_t WS_H = 656 * MiB;
constexpr size_t WS_QA = 688 * MiB;
constexpr size_t WS_LG = 704 * MiB;
constexpr size_t WS_KK = 768 * MiB;
constexpr size_t WS_VA = 800 * MiB;
constexpr size_t WS_AG = 816 * MiB;
constexpr size_t WS_BQ = 832 * MiB;
constexpr size_t WS_QC = 840 * MiB;
constexpr size_t WS_GT = 856 * MiB;
constexpr size_t WS_QF = 952 * MiB;
constexpr size_t WS_KV = 976 * MiB;
constexpr size_t WS_OF = 1012 * MiB;
constexpr size_t WS_OB = 1044 * MiB;
constexpr size_t WS_OA = 1076 * MiB;
constexpr size_t WS_OBB = 1092 * MiB;
constexpr size_t WS_OC = 1108 * MiB;
constexpr size_t WS_MS = 1124 * MiB;
constexpr size_t WS_MG = 1188 * MiB;
constexpr size_t WS_Y = 1220 * MiB;
constexpr size_t WS_HALO = 1220 * MiB;
constexpr size_t WS_U = 688 * MiB;
constexpr size_t WS_ACT = 860 * MiB;
constexpr size_t WS_XB = 1284 * MiB;
constexpr size_t WS_END = 1316 * MiB;
static_assert(WS_U + (size_t)MT * NUP * 2 <= WS_ACT && WS_ACT + (size_t)MT * DFF * 2 <= WS_QF, "ffn overlay");

constexpr int CW_TMO = 0, CW_BAR = 4096, CW_CNT = 16384, CW_SPL = 65536;
constexpr size_t WS_SPL = 704 * MiB;

constexpr int RING_BYTES = 131072, LDSCTL_OFF = RING_BYTES, MISC_OFF = LDSCTL_OFF + 320, HALO_OFF = RING_BYTES + 1024, LDS_BYTES = 147456;

#define RLX_AGENT __ATOMIC_RELAXED, __HIP_MEMORY_SCOPE_AGENT
#define LDS_WAIT() asm volatile("s_waitcnt lgkmcnt(0)" ::: "memory")
#define VM_WAIT() asm volatile("s_waitcnt vmcnt(0)" ::: "memory")
__host__ __device__ __forceinline__ unsigned f2bf(float f) { unsigned u = __builtin_bit_cast(unsigned, f); return (u + 0x7fffu + ((u >> 16) & 1u)) >> 16; }
typedef float f32x2c_t __attribute__((ext_vector_type(2)));
typedef __bf16 bf16x2c_t __attribute__((ext_vector_type(2)));
__device__ __forceinline__ unsigned pk2(float lo, float hi) { const f32x2c_t v = {lo, hi}; const bf16x2c_t b = __builtin_convertvector(v, bf16x2c_t); return __builtin_bit_cast(unsigned, b); }
__device__ __forceinline__ float bf_lo(unsigned u) { return __builtin_bit_cast(float, u << 16); }
__device__ __forceinline__ float bf_hi(unsigned u) { return __builtin_bit_cast(float, u & 0xffff0000u); }
__device__ __forceinline__ float bf2f(bf16 b) { return __builtin_bit_cast(float, (unsigned)b << 16); }
__device__ __forceinline__ float sigmoidf_(float x) { return __builtin_amdgcn_rcpf(1.f + __expf(-x)); }
__device__ __forceinline__ float rsq_(float x) { return __builtin_amdgcn_rsqf(x); }
__device__ __forceinline__ float shx(float v, int mask, int lane) { return __builtin_bit_cast(float, __builtin_amdgcn_ds_bpermute((lane ^ mask) << 2, __builtin_bit_cast(int, v))); }
__device__ __forceinline__ float wave_sum(float v, int lane) {
#pragma unroll
    for (int o = 1; o < 64; o <<= 1) v += shx(v, o, lane);
    return v;
}
__device__ __forceinline__ int tid_now(int wave) { int t; asm volatile("v_mbcnt_lo_u32_b32 %0, -1, 0\n\tv_mbcnt_hi_u32_b32 %0, -1, %0" : "=v"(t)); return wave * 64 + t; }
#define XB_TMO      128
#define XB_XCNT(j)  (256  + 64 * (j))
#define XB_XSUB(j)  (1280 + 64 * (j))
#define XB_XGEN(j)  (2304 + 64 * (j))
#define XB_TOP      3328
#define XB_TOPGEN   3392
#define XCD_BAR_WORDS 3456
#define XB_SPIN_CAP (1u << 22)
__device__ __forceinline__ unsigned xb_ld(unsigned* p)              { return __hip_atomic_load(p, __ATOMIC_RELAXED, __HIP_MEMORY_SCOPE_AGENT); }
__device__ __forceinline__ unsigned xb_add(unsigned* p, unsigned v) { return __hip_atomic_fetch_add(p, v, __ATOMIC_RELAXED, __HIP_MEMORY_SCOPE_AGENT); }
__device__ __forceinline__ unsigned xb_xcc_id() { return (unsigned)__builtin_amdgcn_s_getreg((3 << 11) | 20) & 0xFu; }
#define XB_SPIN(cond, bar) do { unsigned _sp = 0; while (cond) { __builtin_amdgcn_s_sleep(1); \
    if ((++_sp & 255u) == 0u) { if (xb_ld(&(bar)[XB_TMO])) break; if (_sp > XB_SPIN_CAP) { atomicAdd(&(bar)[XB_TMO], 1u); break; } } } } while (0)
struct XcdBarrier { unsigned* bar; unsigned x; volatile LAS unsigned* st; };
__device__ __forceinline__ XcdBarrier xcd_barrier_post(unsigned* bar, volatile LAS unsigned* st) {
    XcdBarrier b; b.bar = bar; b.x = xb_xcc_id(); b.st = st;
    if (threadIdx.x == 0) (void)xb_add(&bar[XB_XCNT(b.x)], 1u);
    return b;
}
__device__ __forceinline__ void xcd_barrier_complete(unsigned* bar, unsigned x, unsigned& nloc, unsigned& nx) {
    const unsigned G = gridDim.x * gridDim.y * gridDim.z;
    unsigned sum, cnt, mine, sp = 0u;
    for (;;) {
        sum = 0u; cnt = 0u; mine = 0u;
#pragma unroll
        for (unsigned j = 0; j < 16; ++j) { const unsigned c = xb_ld(&bar[XB_XCNT(j)]); sum += c; cnt += (c > 0u) ? 1u : 0u; mine = (j == x) ? c : mine; }
        if (sum == G) break;
        __builtin_amdgcn_s_sleep(1);
        if ((++sp & 255u) == 0u) { if (xb_ld(&bar[XB_TMO])) break; if (sp > XB_SPIN_CAP) { atomicAdd(&bar[XB_TMO], 1u); break; } }
    }
    nloc = mine > 0u ? mine : 1u; nx = cnt > 0u ? cnt : 1u;
}
__device__ __forceinline__ void xcd_barrier(const XcdBarrier& b) {
    asm volatile("s_waitcnt vmcnt(0)" ::: "memory");
    __syncthreads();
    if (threadIdx.x == 0) {
        unsigned* bar = b.bar;
        __builtin_amdgcn_s_waitcnt(0);
        unsigned nloc = b.st[0], nx = b.st[1];
        if (nloc == 0u) { xcd_barrier_complete(bar, b.x, nloc, nx); b.st[0] = nloc; b.st[1] = nx; }
        const unsigned old = xb_add(&bar[XB_XSUB(b.x)], 1u);
        const unsigned gen = old / nloc;
        if (old + 1u == (gen + 1u) * nloc) {
            __builtin_amdgcn_fence(__ATOMIC_RELEASE, "agent");
            asm volatile("s_waitcnt vmcnt(0)" ::: "memory");
            const unsigned og = xb_add(&bar[XB_TOP], 1u);
            const unsigned tg = og / nx;
            if (og + 1u == (tg + 1u) * nx) xb_add(&bar[XB_TOPGEN], 1u);
            else XB_SPIN(xb_ld(&bar[XB_TOPGEN]) == tg, bar);
            __builtin_amdgcn_fence(__ATOMIC_ACQUIRE, "agent");
            xb_add(&bar[XB_XGEN(b.x)], 1u);
            asm volatile("s_waitcnt vmcnt(0)" ::: "memory");
        } else {
            XB_SPIN(xb_ld(&bar[XB_XGEN(b.x)]) == gen, bar);
            __builtin_amdgcn_fence(__ATOMIC_ACQUIRE, "agent");
            asm volatile("s_waitcnt vmcnt(0)" ::: "memory");
        }
    }
    __syncthreads();
}

namespace pg8 {
constexpr int BM = 256, BK = 64, HALF = 128, HTB = HALF * BK * 2, NXCD = 8, WGM = 8;
__host__ __device__ __forceinline__ int lds_byte(int r, int c) { const int st = (r >> 4) * 2 + (c >> 5), rr = r & 15, cc = c & 31, ob = rr * 64 + cc * 2; return st * 1024 + (ob ^ (((ob >> 9) & 1) << 5)); }
__host__ __device__ __forceinline__ void stage_rc(int b, int& R, int& C) { const int st = b / 1024, sb = b % 1024, swz = sb ^ (((sb >> 9) & 1) << 5); R = (st >> 1) * 16 + swz / 64; C = (st & 1) * 32 + (swz % 64) / 2; }
__host__ __device__ __forceinline__ int perm32(int rho) { const int n = rho >> 4, i = rho & 15; return 8 * (i >> 2) + 4 * n + (i & 3); }
struct Unit { int pm, pn, sub; };
struct Gemm { const bf16* A; const bf16* Bt; int M, N, K, lda; const bf16* A1; const bf16* Bt1; const bf16* A2; const bf16* Bt2; };
struct StaticOrder {
    static constexpr bool SPLIT = false;
    int nM, nN, nwg, G, c;
    __device__ __forceinline__ void init(int M, int N, int G_, int c_) { nM = M / BM; nN = N / BM; nwg = nM * nN; G = G_; c = c_; }
    __device__ __forceinline__ bool next(int i, Unit& u) const {
        const long L = (long)i * G + c; if (L >= nwg) return false;
        int wgid = (int)L; { const int q = nwg / NXCD, r = nwg % NXCD, xcd = wgid % NXCD, off = wgid / NXCD; wgid = (xcd < r ? xcd * (q + 1) : r * (q + 1) + (xcd - r) * q) + off; }
        const int nig = WGM * nN, gid = wgid / nig, fm = gid * WGM, gsz = (nM - fm) < WGM ? (nM - fm) : WGM;
        u.pm = fm + ((wgid % nig) % gsz); u.pn = (wgid % nig) / gsz; u.sub = 0; return true;
    }
};
struct SplitOrder {
    static constexpr bool SPLIT = true;
    int nM, nN, nwg, G, c, nfull, tail;
    __device__ __forceinline__ void init(int M, int N, int G_, int c_) { nM = M / BM; nN = N / BM; nwg = nM * nN; G = G_; c = c_; nfull = (nwg / G) * G; tail = nwg - nfull; if (2 * tail > G) { nfull = nwg; tail = 0; } }
    __device__ __forceinline__ bool next(int i, Unit& u) const {
        long L = (long)i * G + c; int sub = 0;
        if (L >= nfull) { if (tail == 0 || i != nfull / G || c >= 2 * tail) return false; const int j = (c >= tail) ? c - tail : c; sub = (c >= tail) ? 2 * j + 1 : 2 * j + 2; L = nfull + j; }
        int wgid = (int)L; { const int q = nwg / NXCD, r = nwg % NXCD, xcd = wgid % NXCD, off = wgid / NXCD; wgid = (xcd < r ? xcd * (q + 1) : r * (q + 1) + (xcd - r) * q) + off; }
        const int nig = WGM * nN, gid = wgid / nig, fm = gid * WGM, gsz = (nM - fm) < WGM ? (nM - fm) : WGM;
        u.pm = fm + ((wgid % nig) % gsz); u.pn = (wgid % nig) / gsz; u.sub = sub; return true;
    }
};
template <class Epi, class Ord>
__device__ __forceinline__ void gemm_phase(LAS unsigned char* lds, const Gemm g, const Ord& S, const Epi& E, int wave) {
    constexpr bool SPL = Ord::SPLIT;
    const int tid = tid_now(wave), wid = __builtin_amdgcn_readfirstlane(tid >> 6), lane = tid & 63, wr = wid >> 2, wc = wid & 3, fr = lane & 15, fq = lane >> 4;
    const int K = g.K, nt = K / BK, lda = g.lda;
    unsigned voffA[2], voffB[2];
#pragma unroll
    for (int i = 0; i < 2; ++i) { int R, C; stage_rc(tid * 16 + i * 8192, R, C); const int Rb = (R & ~31) + perm32(R & 31);
        voffA[i] = (unsigned)(R * lda + C) * 2u; voffB[i] = (unsigned)(Rb * K + C) * 2u; }
    const size_t kstep = (size_t)(BK * 2);
    const size_t hstepA = (size_t)HALF * lda * 2, hstepB = (size_t)HALF * K * 2;
    const size_t tstepA = 2 * hstepA, tstepB = 2 * hstepB;
    const unsigned ldsw = (unsigned)wid * 1024u;
    const int aoff = lds_byte(wr * 64 + fr, fq * 8), boff = lds_byte(wc * 32 + fr, fq * 8);
#define PG8_SA(b, h) (((b) * 2 + (h)) * HTB)
#define PG8_SB(b, h) ((4 + (b) * 2 + (h)) * HTB)
#define PG8_STAGE(bufoff, gbase, voff) do { _Pragma("unroll") for (int _i = 0; _i < 2; ++_i) \
        __builtin_amdgcn_global_load_lds((const unsigned*)((const char*)(gbase) + (voff)[_i]), (LAS unsigned*)(lds + (bufoff) + ldsw + _i * 8192), 16, 0, 0); } while (0)
#define PG8_LDA(dst, b, h) do { _Pragma("unroll") for (int m = 0; m < 4; ++m) _Pragma("unroll") for (int k = 0; k < 2; ++k) dst[m][k] = *(const LAS bf16x8*)(lds + PG8_SA(b, h) + aoff + m * 2048 + k * 1024); } while (0)
#define PG8_LDB(dst, b, h) do { _Pragma("unroll") for (int n = 0; n < 2; ++n) _Pragma("unroll") for (int k = 0; k < 2; ++k) dst[n][k] = *(const LAS bf16x8*)(lds + PG8_SB(b, h) + boff + n * 2048 + k * 1024); } while (0)
#define PG8_MMA(ai, bj, At, Bt) do { __builtin_amdgcn_s_setprio(1); _Pragma("unroll") for (int m = 0; m < 4; ++m) _Pragma("unroll") for (int n = 0; n < 2; ++n) _Pragma("unroll") for (int k = 0; k < 2; ++k) \
        acc[ai][bj][m][n] = __builtin_amdgcn_mfma_f32_16x16x32_bf16(Bt[n][k], At[m][k], acc[ai][bj][m][n], 0, 0, 0); __builtin_amdgcn_s_setprio(0); } while (0)
#define PG8_WAIT_V(n) asm volatile("s_waitcnt vmcnt(" #n ")" ::: "memory")
#define PG8_WAIT_L(n) asm volatile("s_waitcnt lgkmcnt(" #n ")" ::: "memory")
#define PG8_BAR __builtin_amdgcn_s_barrier()
#define PG8_SCHED __builtin_amdgcn_sched_barrier(0)
    constexpr int CH = Epi::CHAIN;
    Unit cur, nxt; int ui = 0;
    if (!S.next(0, cur)) return;
    f32x4 acc[2][2][4][2];
#pragma unroll
    for (int a = 0; a < 2; ++a)
#pragma unroll
        for (int b = 0; b < 2; ++b)
#pragma unroll
            for (int m = 0; m < 4; ++m)
#pragma unroll
                for (int n = 0; n < 2; ++n) acc[a][b][m][n] = (f32x4){0.f, 0.f, 0.f, 0.f};
    bf16x8 At[4][2], B0[2][2], B1[2][2];
#define PG8_AP(sub) ((const char*)((CH == 1 || (sub) == 0) ? g.A : ((sub) == 1 ? g.A1 : g.A2)))
#define PG8_BP(sub) ((const char*)((CH == 1 || (sub) == 0) ? g.Bt : ((sub) == 1 ? g.Bt1 : g.Bt2)))
#define PG8_KOFF(u) ((SPL && ((u).sub & 1)) ? (size_t)K : (size_t)0)
    const char* cA = PG8_AP(0) + (size_t)cur.pm * tstepA + PG8_KOFF(cur); const char* cB = PG8_BP(0) + (size_t)cur.pn * tstepB + PG8_KOFF(cur);
    PG8_STAGE(PG8_SB(0, 0), cB, voffB); PG8_STAGE(PG8_SB(0, 1), cB + hstepB, voffB); PG8_STAGE(PG8_SA(0, 0), cA, voffA); PG8_STAGE(PG8_SA(0, 1), cA + hstepA, voffA);
    if (wr == 1) PG8_BAR;
    PG8_WAIT_V(2); PG8_BAR;
    PG8_STAGE(PG8_SB(1, 0), cB + kstep, voffB); PG8_STAGE(PG8_SA(1, 0), cA + kstep, voffA); PG8_STAGE(PG8_SB(1, 1), cB + hstepB + kstep, voffB);
    PG8_WAIT_V(6); PG8_BAR;
    for (;;) {
        const bool has_next = S.next((ui + 1) / CH, nxt); if constexpr (!SPL) nxt.sub = (ui + 1) % CH;
        const char* nA = has_next ? PG8_AP(SPL ? 0 : nxt.sub) + (size_t)nxt.pm * tstepA + PG8_KOFF(nxt) : cA; const char* nB = has_next ? PG8_BP(SPL ? 0 : nxt.sub) + (size_t)nxt.pn * tstepB + PG8_KOFF(nxt) : cB;
        const int ntc = (SPL && cur.sub) ? (nt >> 1) : nt;
        for (int t = 0; t < ntc; t += 2) {
            const bool last = (t == ntc - 2);
            const char* a1 = cA + (size_t)(t + 1) * kstep;
            const char* a2 = last ? nA : cA + (size_t)(t + 2) * kstep; const char* b2 = last ? nB : cB + (size_t)(t + 2) * kstep;
            const char* a3 = a2 + kstep; const char* b3 = b2 + kstep;
            PG8_LDB(B0, 0, 0); PG8_LDB(B1, 0, 1); PG8_SCHED; PG8_LDA(At, 0, 0); PG8_STAGE(PG8_SA(1, 1), a1 + hstepA, voffA);
            PG8_WAIT_V(8); PG8_WAIT_L(0); PG8_BAR; PG8_MMA(0, 0, At, B0); PG8_MMA(0, 1, At, B1); PG8_BAR; PG8_SCHED;
            PG8_LDA(At, 0, 1); PG8_STAGE(PG8_SB(0, 0), b2, voffB); PG8_STAGE(PG8_SB(0, 1), b2 + hstepB, voffB); PG8_STAGE(PG8_SA(0, 0), a2, voffA);
            PG8_WAIT_V(8); PG8_WAIT_L(0); PG8_BAR; PG8_MMA(1, 0, At, B0); PG8_MMA(1, 1, At, B1); PG8_BAR; PG8_SCHED;
            PG8_LDB(B0, 1, 0); PG8_LDB(B1, 1, 1); PG8_SCHED; PG8_LDA(At, 1, 0); PG8_STAGE(PG8_SA(0, 1), a2 + hstepA, voffA);
            PG8_WAIT_V(8); PG8_WAIT_L(0); PG8_BAR; PG8_MMA(0, 0, At, B0); PG8_MMA(0, 1, At, B1); PG8_BAR; PG8_SCHED;
            PG8_LDA(At, 1, 1); PG8_STAGE(PG8_SB(1, 0), b3, voffB); PG8_STAGE(PG8_SB(1, 1), b3 + hstepB, voffB); PG8_STAGE(PG8_SA(1, 0), a3, voffA);
            PG8_WAIT_V(8); PG8_WAIT_L(0); PG8_BAR; PG8_MMA(1, 0, At, B0); PG8_MMA(1, 1, At, B1); PG8_BAR; PG8_SCHED;
        }
        if (wr == 0) PG8_BAR;
        if constexpr (SPL) {
            if (cur.sub & 1) E.put_partial(acc, cur, wave);
            else { if (cur.sub) E.get_partial(acc, cur, wave); E(acc, cur, wr, wc, fr, fq); }
        } else if constexpr (!Epi::AFTER_DRAIN) E(acc, cur, wr, wc, fr, fq);
        if (!has_next) break;
        if (CH == 1 || cur.sub == CH - 1) {
#pragma unroll
        for (int a = 0; a < 2; ++a)
#pragma unroll
            for (int b = 0; b < 2; ++b)
#pragma unroll
                for (int m = 0; m < 4; ++m)
#pragma unroll
                    for (int n = 0; n < 2; ++n) acc[a][b][m][n] = (f32x4){0.f, 0.f, 0.f, 0.f};
        }
        cur = nxt; cA = nA; cB = nB; ++ui;
        if (wr == 1) PG8_BAR;
    }
    PG8_WAIT_V(0);
    PG8_BAR;
    if constexpr (Epi::AFTER_DRAIN) E.fused(acc, cur, wr, wc, fr, fq, lds, tid);
#undef PG8_AP
#undef PG8_BP
#undef PG8_KOFF
#undef PG8_SA
#undef PG8_SB
#undef PG8_STAGE
#undef PG8_LDA
#undef PG8_LDB
#undef PG8_MMA
#undef PG8_WAIT_V
#undef PG8_WAIT_L
#undef PG8_BAR
#undef PG8_SCHED
}
}
using pg8::Unit;

struct Args { const float* in[30]; float* out; unsigned char* ws; int ph_lo, ph_hi, use_bar, pad; };
#define CAS __attribute__((address_space(4)))
typedef const CAS Args* ArgP;

__device__ __forceinline__ int src_win(int n) {
    const int t = n >> 8, g = n & 255;
    if (t < 20) return n;
    if (t < 22) return 5120 + (n - 20 * 256);
    if (t == 22) return 5632 + g;
    if (t < 28) { const int half = g >> 7, hd = (g >> 6) & 1, part = (g >> 5) & 1, i = g & 31; const int base = (t < 27) ? 5952 + (t - 23) * 256 : 6976; return base + hd * 128 + part * 64 + half * 32 + i; }
    if (t == 28) return 7232 + g;
    if (t < 53) return 7488 + (n - 29 * 256);
    { const int half = g >> 7, r = g & 127; if (r >= 32) return -1; const int part = r >> 4, i = r & 15; return 5888 + part * 32 + half * 16 + i; }
}
__device__ __forceinline__ int src_uq(int n) {
    const int t = n >> 8, g = n & 255;
    if (t < 4) { const int hd = n >> 7, d = n & 127; return hd * 192 + d; }
    const int half = g >> 7, hl = (g >> 5) & 3, part = (g >> 4) & 1, i = g & 15; const int hd = (t - 4) * 4 + hl;
    return hd * 192 + 128 + part * 32 + half * 16 + i;
}
__device__ __forceinline__ int src_ukv(int n) { const int v = n >> 10, r = n & 1023, hd = r >> 7, d = r & 127; return hd * 256 + v * 128 + d; }
__device__ __forceinline__ int src_up(int n) { const int j = n >> 8, g = n & 255; return (g < 128) ? 128 * j + g : DFF + 128 * j + (g - 128); }

typedef short s16x4p __attribute__((ext_vector_type(4)));
typedef short v4i16p __attribute__((ext_vector_type(4)));
__device__ __forceinline__ unsigned cvtpk_p(float lo, float hi) { return pk2(lo, hi); }
struct TDesc { const float* W; const float* fold; bf16* WT; int K, Nsrc, map, k0, n0; };
constexpr int J_IN = 32 * (NINP / 64), J_UQ = 8 * 24, J_UKV = 4 * 32, J_BR = 16 * 32, J_O = 32 * 32, J_UP = 32 * (NUP / 64), J_DN = (DFF / 64) * 32;
constexpr int J_L = J_IN + J_UQ + J_UKV + 3 * J_BR + J_O + J_UP + J_DN;
__device__ __forceinline__ TDesc t_desc(ArgP a, unsigned char* ws, int it) {
    const int l = it / J_L; int r = it % J_L; unsigned char* wl = ws + WS_W + (size_t)l * WL_STRIDE;
    TDesc d; d.fold = nullptr; int N;
    if (r < J_IN) { d.W = a->in[15] + (size_t)l * D * NIN; d.K = D; d.Nsrc = NIN; N = NINP; d.WT = (bf16*)(wl + WO_IN); d.map = 1; }
    else if ((r -= J_IN) < J_UQ) { d.W = a->in[19] + (size_t)l * 512 * 1536; d.K = 512; d.Nsrc = 1536; N = 1536; d.WT = (bf16*)(wl + WO_UQ); d.map = 2; d.fold = a->in[18] + l * 512; }
    else if ((r -= J_UQ) < J_UKV) { d.W = a->in[21] + (size_t)l * 256 * 2048; d.K = 256; d.Nsrc = 2048; N = 2048; d.WT = (bf16*)(wl + WO_UKV); d.map = 3; d.fold = a->in[20] + l * 256; }
    else if ((r -= J_UKV) < J_BR) { d.W = a->in[23] + (size_t)l * 1024 * 2048; d.K = 1024; d.Nsrc = 2048; N = 2048; d.WT = (bf16*)(wl + WO_A); d.map = 0; }
    else if ((r -= J_BR) < J_BR) { d.W = a->in[24] + (size_t)l * 1024 * 2048; d.K = 1024; d.Nsrc = 2048; N = 2048; d.WT = (bf16*)(wl + WO_B); d.map = 0; }
    else if ((r -= J_BR) < J_BR) { d.W = a->in[25] + (size_t)l * 1024 * 2048; d.K = 1024; d.Nsrc = 2048; N = 2048; d.WT = (bf16*)(wl + WO_C); d.map = 0; }
    else if ((r -= J_BR) < J_O) { d.W = a->in[26] + (size_t)l * 2048 * 2048; d.K = 2048; d.Nsrc = 2048; N = 2048; d.WT = (bf16*)(wl + WO_O); d.map = 0; }
    else if ((r -= J_O) < J_UP) { d.W = a->in[27] + (size_t)l * 2048 * NUP; d.K = 2048; d.Nsrc = NUP; N = NUP; d.WT = (bf16*)(wl + WO_UP); d.map = 4; }
    else { r -= J_UP; d.W = a->in[29] + (size_t)l * DFF * 2048; d.K = DFF; d.Nsrc = 2048; N = 2048; d.WT = (bf16*)(wl + WO_DN); d.map = 0; }
    const int nblk = N / 64; d.k0 = 64 * (r / nblk); d.n0 = 64 * (r % nblk);
    return d;
}
__device__ __forceinline__ void t_load(const TDesc& d, f32x4 (&v)[16], int lane) {
    const int kk = lane >> 4, n = d.n0 + 4 * (lane & 15);
    int sc; if (d.map == 0) sc = n; else if (d.map == 1) sc = src_win(n); else if (d.map == 2) sc = src_uq(n); else if (d.map == 3) sc = src_ukv(n); else sc = src_up(n);
    const float* p = d.W + (size_t)(d.k0 + kk) * d.Nsrc + (sc < 0 ? 0 : sc);
#pragma unroll
    for (int i = 0; i < 16; ++i) { f32x4 x = *(const f32x4*)(p + (size_t)(4 * i) * d.Nsrc); if (sc < 0) x = (f32x4){0.f, 0.f, 0.f, 0.f}; if (d.fold) x = x * d.fold[d.k0 + 4 * i + kk]; v[i] = x; }
}
__device__ __forceinline__ void t_store(const TDesc& d, const f32x4 (&v)[16], LAS unsigned char* scr, int lane) {
    const int kk = lane >> 4, n4 = lane & 15, g = lane >> 4, i16 = lane & 15, q = i16 >> 2, p = i16 & 3;
#pragma unroll
    for (int i = 0; i < 16; ++i) { u32x2 w; w.x = cvtpk_p(v[i].x, v[i].y); w.y = cvtpk_p(v[i].z, v[i].w); *(LAS u32x2*)(scr + (4 * i + kk) * 144 + 8 * n4) = w; }
#pragma unroll
    for (int j = 0; j < 8; ++j) { const int nb = j >> 1, k8 = 4 * (j & 1) + g;
        LAS unsigned char* p0 = scr + (8 * k8 + q) * 144 + (16 * nb + 4 * p) * 2;
        const s16x4p v0 = __builtin_bit_cast(s16x4p, __builtin_amdgcn_ds_read_tr16_b64_v4i16((LAS v4i16p*)p0));
        const s16x4p v1 = __builtin_bit_cast(s16x4p, __builtin_amdgcn_ds_read_tr16_b64_v4i16((LAS v4i16p*)(p0 + 4 * 144)));
        const bf16x8 o = (bf16x8){v0.x, v0.y, v0.z, v0.w, v1.x, v1.y, v1.z, v1.w};
        *(bf16x8*)(d.WT + (size_t)(d.n0 + 16 * nb + i16) * d.K + d.k0 + 8 * k8) = o; }
}

__device__ __forceinline__ void phase_prologue(ArgP a, LAS unsigned char* lds, int wave) {
    const int tidn = tid_now(wave), lane = tidn & 63;
    LAS unsigned char* scr = lds + wave * 9216;
    const int gw = blockIdx.x * 8 + wave, NGW = gridDim.x * 8;
    unsigned char* ws = a->ws;
    for (int it = gw; it < NL * 16 * 48; it += NGW) {
        const int l = it / 768, r = it % 768, kc = r / 48, jb = r % 48;
        const float* W = a->in[9] + (size_t)l * D * 12288 + (size_t)(kc * 128) * 12288 + jb * 256 + lane * 4;
        f32x4 acc[5];
#pragma unroll
        for (int s = 0; s < 5; ++s) acc[s] = (f32x4){0.f, 0.f, 0.f, 0.f};
        for (int k = 0; k < 128; ++k) {
            const f32x4 w = *(const f32x4*)(W + (size_t)k * 12288);
            const int kk = kc * 128 + k;
#pragma unroll
            for (int s = 0; s < 5; ++s) { const float cv = (s == 0) ? a->in[8][kk] : a->in[7][(s - 1) * D + kk]; const float sv = cv * sigmoidf_(cv); acc[s] += w * sv; }
        }
        float* P = (float*)(ws + WS_MODP) + ((size_t)(l * 16 + kc) * 5) * 12288 + jb * 256 + lane * 4;
#pragma unroll
        for (int s = 0; s < 5; ++s) *(f32x4*)(P + (size_t)s * 12288) = acc[s];
    }
    {
        const int NT = NL * J_L; int it = gw; TDesc dA, dB; f32x4 A[16], B[16];
        if (it < NT) { dA = t_desc(a, ws, it); t_load(dA, A, lane); }
        while (it < NT) {
            const int nx = it + NGW; const bool more = nx < NT;
            if (more) { dB = t_desc(a, ws, nx); t_load(dB, B, lane); }
            t_store(dA, A, scr, lane);
            if (more) { dA = dB;
#pragma unroll
                for (int i = 0; i < 16; ++i) A[i] = B[i]; }
            it = nx;
        }
    }
    const int gt = blockIdx.x * 512 + tidn, NGT = gridDim.x * 512;
    for (int i = gt; i < 2048; i += NGT) {
        float v[4], mx = -1e30f;
#pragma unroll
        for (int l = 0; l < 4; ++l) { v[l] = a->in[16][l * 2048 + i]; mx = fmaxf(mx, v[l]); }
        float e[4], s = 0.f;
#pragma unroll
        for (int l = 0; l < 4; ++l) { e[l] = expf(v[l] - mx); s += e[l]; }
        float cs = 0.f; float* LB = (float*)(ws + WS_LB);
        LB[i] = 0.f;
#pragma unroll
        for (int l = 1; l < 4; ++l) { cs += e[l] / s; LB[l * 2048 + i] = cs; }
    }
    for (int i = gt; i < 64 * 32; i += NGT) { const int pos = i >> 5, j = i & 31; const float inv = powf(10000.f, -(float)(2 * j) / 64.f); const float ang = (float)pos * inv;
        float* R = (float*)(ws + WS_ROPE); R[i] = cosf(ang); R[2048 + i] = sinf(ang); }
    for (int i = gt; i < 64 * 16; i += NGT) { const int pos = i >> 4, j = i & 15; const float inv = powf(10000.f, -(float)(2 * j) / 32.f); const float ang = (float)pos * inv;
        float* R = (float*)(ws + WS_ROPE) + 4096; R[i] = cosf(ang); R[1024 + i] = sinf(ang); }
    for (int i = gt; i < 4 * 4 * 256 * 256; i += NGT) {
        const int c = i & 255, t = (i >> 8) & 255, l = (i >> 16) & 3, b = i >> 18; const size_t row = 8192 + b * 256 + t;
        ((bf16*)(ws + WS_BKV))[((size_t)l * MKV + row) * 256 + c] = (bf16)f2bf(a->in[3][i] / a->in[20][l * 256 + c]);
        ((bf16*)(ws + WS_KC))[((size_t)l * MKV + row) * 256 + c] = (bf16)f2bf(a->in[5][i]);
        ((bf16*)(ws + WS_VC))[((size_t)l * MKV + row) * 256 + c] = (bf16)f2bf(a->in[6][i]);
    }
    for (int i = gt; i < 1024 * 4; i += NGT) ((float*)(ws + WS_SSQKV))[8192 * 4 + i] = 64.f * (1.f - EPS);
    for (int i = gt; i < 4 * 4 * 256 * 64; i += NGT) {
        const int c = i & 63, t = (i >> 6) & 255, l = (i >> 14) & 3, b = i >> 16; const size_t row = 8192 + b * 256 + t;
        ((bf16*)(ws + WS_KR))[((size_t)l * MKV + row) * 64 + c] = (bf16)f2bf(a->in[4][i]);
    }
}
__device__ __forceinline__ void phase_modreduce(ArgP a, int wave) {
    const int gt = blockIdx.x * 512 + tid_now(wave), NGT = gridDim.x * 512;
    for (int i4 = gt; i4 < NL * 5 * 12288 / 4; i4 += NGT) {
        const int i = i4 * 4, j = i % 12288, s = (i / 12288) % 5, l = i / (5 * 12288);
        f32x4 v = *(const f32x4*)(a->in[10] + l * 12288 + j);
        const float* P = (const float*)(a->ws + WS_MODP) + ((size_t)(l * 16) * 5 + s) * 12288 + j;
#pragma unroll
        for (int kc = 0; kc < 16; ++kc) v += *(const f32x4*)(P + (size_t)kc * 5 * 12288);
        *(f32x4*)((float*)(a->ws + WS_MOD) + i) = v;
    }
}

__device__ __forceinline__ int mod_sel(int m) { return (m < MC) ? 0 : 1 + ((m - MC) >> 10); }
__device__ __forceinline__ const float* x_input_row(ArgP a, int m) { return (m < MC) ? a->in[0] + (size_t)m * D : a->in[1] + (size_t)(m - MC) * D; }

__device__ __forceinline__ void phase_h0(ArgP a, int wave) {
    const int tidn = tid_now(wave), lane = tidn & 63;
    const int gw = blockIdx.x * 8 + wave, NGW = gridDim.x * 8;
    unsigned char* ws = a->ws;
    const float* MOD = (const float*)(ws + WS_MOD);
    for (int m = gw; m < MT; m += NGW) {
        const int sl = mod_sel(m); const float* xr = x_input_row(a, m); const float* mod = MOD + (size_t)sl * 12288; bf16* ho = (bf16*)(ws + WS_H) + (size_t)m * D;
        f32x4 x[8]; float sq = 0.f;
#pragma unroll
        for (int j = 0; j < 8; ++j) { x[j] = *(const f32x4*)(xr + lane * 4 + 256 * j); sq += (x[j].x * x[j].x + x[j].y * x[j].y) + (x[j].z * x[j].z + x[j].w * x[j].w); }
        const float rs = rsq_(wave_sum(sq, lane) * (1.f / D) + EPS);
#pragma unroll
        for (int j = 0; j < 8; ++j) { const f32x4 h = (x[j] * rs) * (*(const f32x4*)(a->in[11] + lane * 4 + 256 * j) * (*(const f32x4*)(mod + D + lane * 4 + 256 * j) + 1.f)) + *(const f32x4*)(mod + lane * 4 + 256 * j);
            u32x2 o; o.x = pk2(h.x, h.y); o.y = pk2(h.z, h.w); *(u32x2*)(ho + lane * 4 + 256 * j) = o; }
    }
}

__device__ __forceinline__ float gelu_tanh(float x) { const float u = 0.7978845608028654f * (x + 0.044715f * x * x * x); return x * sigmoidf_(2.f * u); }
__device__ __forceinline__ void st8bf(bf16* p, const f32x4 v0, const f32x4 v1) { u32x4 w; w.x = pk2(v0.x, v0.y); w.y = pk2(v0.z, v0.w); w.z = pk2(v1.x, v1.y); w.w = pk2(v1.z, v1.w); *(u32x4*)p = w; }

#define ROWV() f32x4 V[2][2]; _Pragma("unroll") for (int bj_ = 0; bj_ < 2; ++bj_) _Pragma("unroll") for (int n_ = 0; n_ < 2; ++n_) V[bj_][n_] = acc[ai][bj_][m][n_];
struct EpiWin {
    static constexpr bool AFTER_DRAIN = false; static constexpr int CHAIN = 1;
    unsigned char* ws; float* out; int l;
    __device__ __forceinline__ void operator()(const f32x4 (&acc)[2][2][4][2], const Unit& u, int wr, int wc, int fr, int fq) const {
        { int ln_; asm volatile("v_mbcnt_lo_u32_b32 %0, -1, 0\n\tv_mbcnt_hi_u32_b32 %0, -1, %0" : "=v"(ln_)); fr = ln_ & 15; fq = ln_ >> 4; }
        const int l = this->l;
        const int t = u.pn, row0 = u.pm * 256 + wr * 64 + fr, cl = wc * 32 + 8 * fq;
        const bool ctx = u.pm < 16;
        if (t < 4) {
            bf16* O = (bf16*)(ws + WS_QA);
#pragma unroll
            for (int ai = 0; ai < 2; ++ai)
#pragma unroll
                for (int m = 0; m < 4; ++m) { asm volatile("" ::: "memory"); const unsigned r = (unsigned)(row0 + ai * 128 + m * 16); ROWV();
#pragma unroll
                    for (int bj = 0; bj < 2; ++bj) st8bf(O + r * 1024 + t * 256 + bj * 128 + cl, V[bj][0], V[bj][1]); }
        } else if (t < 12) {
            const int cb = (t - 4) * 256;
            const float* LB = (const float*)(ws + WS_LB) + l * 2048;
            bf16* LG = (bf16*)(ws + WS_LG); bf16* KK = (bf16*)(ws + WS_KK);
#pragma unroll
            for (int bj = 0; bj < 2; ++bj) {
                const int c0 = cb + bj * 128 + cl;
                const f32x4 lb0 = *(const f32x4*)(LB + c0), lb1 = *(const f32x4*)(LB + c0 + 4);
#pragma unroll
                for (int ai = 0; ai < 2; ++ai)
#pragma unroll
                    for (int m = 0; m < 4; ++m) { asm volatile("" ::: "memory"); const unsigned r = (unsigned)(row0 + ai * 128 + m * 16); ROWV();
                        f32x4 lg[2];
#pragma unroll
                        for (int n = 0; n < 2; ++n) { const f32x4 lb = n ? lb1 : lb0; const f32x4 x = V[bj][n];
#pragma unroll
                            for (int e = 0; e < 4; ++e) { const float sg = sigmoidf_(x[e]); const float f = lb[e] + (1.f - lb[e]) * sg; lg[n][e] = __logf(f); } }
                        st8bf(LG + r * 2048 + c0, lg[0], lg[1]);
                        }
            }
        } else if (t < 16) {
            bf16* O = (bf16*)(ws + WS_VA);
#pragma unroll
            for (int ai = 0; ai < 2; ++ai)
#pragma unroll
                for (int m = 0; m < 4; ++m) { asm volatile("" ::: "memory"); const unsigned r = (unsigned)(row0 + ai * 128 + m * 16); ROWV();
#pragma unroll
                    for (int bj = 0; bj < 2; ++bj) st8bf(O + r * 1024 + (t - 12) * 256 + bj * 128 + cl, V[bj][0], V[bj][1]); }
        } else if (t < 20) {
            bf16* O = (bf16*)(ws + WS_AG);
#pragma unroll
            for (int ai = 0; ai < 2; ++ai)
#pragma unroll
                for (int m = 0; m < 4; ++m) { asm volatile("" ::: "memory"); const unsigned r = (unsigned)(row0 + ai * 128 + m * 16); ROWV();
#pragma unroll
                    for (int bj = 0; bj < 2; ++bj) { f32x4 v0 = V[bj][0], v1 = V[bj][1];
#pragma unroll
                        for (int e = 0; e < 4; ++e) { v0[e] = v0[e] * sigmoidf_(v0[e]); v1[e] = v1[e] * sigmoidf_(v1[e]); }
                        st8bf(O + r * 1024 + (t - 16) * 256 + bj * 128 + cl, v0, v1); } }
        } else if (t < 23) {
            const bool isq = t < 22;
            bf16* O = isq ? (bf16*)(ws + WS_BQ) : (bf16*)(ws + WS_BKV) + (size_t)l * MKV * 256;
            const int ld = isq ? 512 : 256, cb = isq ? (t - 20) * 256 : 0;
            float* SS = isq ? (float*)(ws + WS_SSQQ) : (float*)(ws + WS_SSQKV);
#pragma unroll
            for (int ai = 0; ai < 2; ++ai)
#pragma unroll
                for (int m = 0; m < 4; ++m) { asm volatile("" ::: "memory"); const unsigned r = (unsigned)(row0 + ai * 128 + m * 16); ROWV(); float s = 0.f;
#pragma unroll
                    for (int bj = 0; bj < 2; ++bj) { const f32x4 v0 = V[bj][0], v1 = V[bj][1];
                        s += (v0.x * v0.x + v0.y * v0.y) + (v0.z * v0.z + v0.w * v0.w) + (v1.x * v1.x + v1.y * v1.y) + (v1.z * v1.z + v1.w * v1.w);
                        st8bf(O + r * ld + cb + bj * 128 + cl, v0, v1);
                        if (!isq && ctx) { float* oc = out + OUT_CKV + (((r >> 8) * 4 + l) * 256 + (r & 255)) * 256 + bj * 128 + cl; *(f32x4*)oc = v0; *(f32x4*)(oc + 4) = v1; } }
                    s += shx(s, 16, fq * 16 + fr); s += shx(s, 32, fq * 16 + fr);
                    if (fq == 0) { if (isq) SS[r * 8 + (t - 20) * 4 + wc] = s; else SS[r * 4 + wc] = s; } }
        } else if (t < 28) {
            const bool isq = t < 27;
            const float* CS = (const float*)(ws + WS_ROPE);
            const int hd = wc >> 1, part = wc & 1, i0 = 8 * fq;
            const int ncol = hd * 128 + part * 64 + i0;
            bf16* O = isq ? (bf16*)(ws + WS_QC) : (bf16*)(ws + WS_KC) + (size_t)l * MKV * 256;
            const int ld = isq ? 1024 : 256, cb = isq ? (t - 23) * 256 : 0;
            const float qs = isq ? SCALE_C * 1.4426950408889634f : 1.f;
#pragma unroll
            for (int ai = 0; ai < 2; ++ai)
#pragma unroll
                for (int m = 0; m < 4; ++m) { asm volatile("" ::: "memory"); const unsigned r = (unsigned)(row0 + ai * 128 + m * 16); ROWV();
                    f32x4 o1[2], o2[2];
                    if (ctx) { o1[0] = V[0][0]; o1[1] = V[0][1]; o2[0] = V[1][0]; o2[1] = V[1][1]; }
                    else { const int tt = ((int)r - MC) & 1023; const int pos = part ? (tt & 63) : (tt >> 6);
#pragma unroll
                        for (int n = 0; n < 2; ++n) { const f32x4 c = *(const f32x4*)(CS + pos * 32 + i0 + 4 * n), s = *(const f32x4*)(CS + 2048 + pos * 32 + i0 + 4 * n);
                            const f32x4 x1 = V[0][n], x2 = V[1][n]; o1[n] = x1 * c - x2 * s; o2[n] = x1 * s + x2 * c; } }
                    if (!isq && ctx) { float* oc = out + OUT_K + (((r >> 8) * 4 + l) * 256 + (r & 255)) * 256 + ncol; *(f32x4*)oc = o1[0]; *(f32x4*)(oc + 4) = o1[1]; *(f32x4*)(oc + 32) = o2[0]; *(f32x4*)(oc + 36) = o2[1]; }
                    st8bf(O + r * ld + cb + ncol, o1[0] * qs, o1[1] * qs); st8bf(O + r * ld + cb + ncol + 32, o2[0] * qs, o2[1] * qs); }
        } else if (t == 28) {
            bf16* O = (bf16*)(ws + WS_VC) + (size_t)l * MKV * 256;
#pragma unroll
            for (int ai = 0; ai < 2; ++ai)
#pragma unroll
                for (int m = 0; m < 4; ++m) { asm volatile("" ::: "memory"); const unsigned r = (unsigned)(row0 + ai * 128 + m * 16); ROWV();
#pragma unroll
                    for (int bj = 0; bj < 2; ++bj) { st8bf(O + r * 256 + bj * 128 + cl, V[bj][0], V[bj][1]);
                        if (ctx) { float* oc = out + OUT_V + (((r >> 8) * 4 + l) * 256 + (r & 255)) * 256 + bj * 128 + cl; *(f32x4*)oc = V[bj][0]; *(f32x4*)(oc + 4) = V[bj][1]; } } }
        } else if (t < 53) {
            unsigned char* O = ws + WS_GT;
#pragma unroll
            for (int ai = 0; ai < 2; ++ai)
#pragma unroll
                for (int m = 0; m < 4; ++m) { asm volatile("" ::: "memory"); const unsigned r = (unsigned)(row0 + ai * 128 + m * 16); ROWV();
                    u32x4 w4 = (u32x4){0u, 0u, 0u, 0u};
#pragma unroll
                    for (int bj = 0; bj < 2; ++bj) { f32x4 v0 = V[bj][0], v1 = V[bj][1];
#pragma unroll
                        for (int e = 0; e < 4; ++e) { v0[e] = 255.f * sigmoidf_(v0[e]); v1[e] = 255.f * sigmoidf_(v1[e]); }
                        unsigned wx = 0u, wy = 0u;
#pragma unroll
                        for (int e = 0; e < 4; ++e) { wx = __builtin_amdgcn_cvt_pk_u8_f32(v0[e], e, wx); wy = __builtin_amdgcn_cvt_pk_u8_f32(v1[e], e, wy); }
                        if (bj == 0) { w4.x = wx; w4.y = wy; } else { w4.z = wx; w4.w = wy; } }
                    *(u32x4*)(O + r * 6144 + (t - 29) * 256 + 2 * cl) = w4; }
        } else {
            if (wc == 0) {
                const float* CS = (const float*)(ws + WS_ROPE) + 4096;
                const int part = fq >> 1, i0 = 8 * (fq & 1); const int ncol = part * 32 + i0;
                bf16* O = (bf16*)(ws + WS_KR) + (size_t)l * MKV * 64;
#pragma unroll
                for (int ai = 0; ai < 2; ++ai)
#pragma unroll
                    for (int m = 0; m < 4; ++m) { asm volatile("" ::: "memory"); const unsigned r = (unsigned)(row0 + ai * 128 + m * 16); ROWV();
                        f32x4 o1[2], o2[2];
                        if (ctx) { o1[0] = V[0][0]; o1[1] = V[0][1]; o2[0] = V[1][0]; o2[1] = V[1][1]; }
                        else { const int tt = ((int)r - MC) & 1023; const int pos = part ? (tt & 63) : (tt >> 6);
#pragma unroll
                            for (int n = 0; n < 2; ++n) { const f32x4 c = *(const f32x4*)(CS + pos * 16 + i0 + 4 * n), s = *(const f32x4*)(CS + 1024 + pos * 16 + i0 + 4 * n);
                                const f32x4 x1 = V[0][n], x2 = V[1][n]; o1[n] = x1 * c - x2 * s; o2[n] = x1 * s + x2 * c; } }
                        if (ctx) { float* oc = out + OUT_KR + (((r >> 8) * 4 + l) * 256 + (r & 255)) * 64 + ncol; *(f32x4*)oc = o1[0]; *(f32x4*)(oc + 4) = o1[1]; *(f32x4*)(oc + 16) = o2[0]; *(f32x4*)(oc + 20) = o2[1]; }
                        st8bf(O + r * 64 + ncol, o1[0], o1[1]); st8bf(O + r * 64 + ncol + 16, o2[0], o2[1]); }
            }
        }
    }
};

struct EpiUq {
    static constexpr bool AFTER_DRAIN = false; static constexpr int CHAIN = 1;
    unsigned char* ws;
    __device__ __forceinline__ void operator()(const f32x4 (&acc)[2][2][4][2], const Unit& u, int wr, int wc, int fr, int fq) const {
        { int ln_; asm volatile("v_mbcnt_lo_u32_b32 %0, -1, 0\n\tv_mbcnt_hi_u32_b32 %0, -1, %0" : "=v"(ln_)); fr = ln_ & 15; fq = ln_ >> 4; }
        const int t = u.pn, row0 = u.pm * 256 + wr * 64 + fr, cl = wc * 32 + 8 * fq; const bool ctx = u.pm < 16;
        const float* SS = (const float*)(ws + WS_SSQQ); bf16* O = (bf16*)(ws + WS_QF);
        const float* CS = (const float*)(ws + WS_ROPE) + 4096;
        float rsv[2][4];
#pragma unroll
        for (int ai = 0; ai < 2; ++ai)
#pragma unroll
            for (int m = 0; m < 4; ++m) { const unsigned r = (unsigned)(row0 + ai * 128 + m * 16); const f32x4 s0 = *(const f32x4*)(SS + r * 8), s1 = *(const f32x4*)(SS + r * 8 + 4);
                rsv[ai][m] = (SCALE_B * 1.4426950408889634f) * rsq_(((s0.x + s0.y) + (s0.z + s0.w) + (s1.x + s1.y) + (s1.z + s1.w)) * (1.f / 512.f) + EPS); }
#pragma unroll
        for (int ai = 0; ai < 2; ++ai)
#pragma unroll
            for (int m = 0; m < 4; ++m) { asm volatile("" ::: "memory"); const unsigned r = (unsigned)(row0 + ai * 128 + m * 16);
                const float rs = rsv[ai][m];
                if (t < 4) {
#pragma unroll
                    for (int bj = 0; bj < 2; ++bj) { const int hd = t * 2 + bj; st8bf(O + r * 1536 + hd * 192 + cl, acc[ai][bj][m][0] * rs, acc[ai][bj][m][1] * rs); }
                } else {
                    const int hd = (t - 4) * 4 + wc, part = fq >> 1, i0 = 8 * (fq & 1); const int ncol = hd * 192 + 128 + part * 32 + i0;
                    f32x4 o1[2], o2[2];
                    if (ctx) { o1[0] = acc[ai][0][m][0]; o1[1] = acc[ai][0][m][1]; o2[0] = acc[ai][1][m][0]; o2[1] = acc[ai][1][m][1]; }
                    else { const int tt = ((int)r - MC) & 1023; const int pos = part ? (tt & 63) : (tt >> 6);
#pragma unroll
                        for (int n = 0; n < 2; ++n) { const f32x4 c = *(const f32x4*)(CS + pos * 16 + i0 + 4 * n), s = *(const f32x4*)(CS + 1024 + pos * 16 + i0 + 4 * n);
                            const f32x4 x1 = acc[ai][0][m][n], x2 = acc[ai][1][m][n]; o1[n] = x1 * c - x2 * s; o2[n] = x1 * s + x2 * c; } }
                    st8bf(O + r * 1536 + ncol, o1[0] * rs, o1[1] * rs); st8bf(O + r * 1536 + ncol + 16, o2[0] * rs, o2[1] * rs);
                }
            }
    }
};

struct EpiKv {
    static constexpr bool AFTER_DRAIN = false; static constexpr int CHAIN = 1;
    unsigned char* ws;
    __device__ __forceinline__ void operator()(const f32x4 (&acc)[2][2][4][2], const Unit& u, int wr, int wc, int fr, int fq) const {
        { int ln_; asm volatile("v_mbcnt_lo_u32_b32 %0, -1, 0\n\tv_mbcnt_hi_u32_b32 %0, -1, %0" : "=v"(ln_)); fr = ln_ & 15; fq = ln_ >> 4; }
        const int row0 = u.pm * 256 + wr * 64 + fr, cl = wc * 32 + 8 * fq;
        const float* SS = (const float*)(ws + WS_SSQKV); bf16* O = (bf16*)(ws + WS_KV);
        float rsv[2][4];
#pragma unroll
        for (int ai = 0; ai < 2; ++ai)
#pragma unroll
            for (int m = 0; m < 4; ++m) { const unsigned r = (unsigned)(row0 + ai * 128 + m * 16); const f32x4 s0 = *(const f32x4*)(SS + r * 4);
                rsv[ai][m] = rsq_(((s0.x + s0.y) + (s0.z + s0.w)) * (1.f / 256.f) + EPS); }
#pragma unroll
        for (int ai = 0; ai < 2; ++ai)
#pragma unroll
            for (int m = 0; m < 4; ++m) { asm volatile("" ::: "memory"); const unsigned r = (unsigned)(row0 + ai * 128 + m * 16);
                const float rs = rsv[ai][m];
#pragma unroll
                for (int bj = 0; bj < 2; ++bj) st8bf(O + r * 2048 + u.pn * 256 + bj * 128 + cl, acc[ai][bj][m][0] * rs, acc[ai][bj][m][1] * rs); }
    }
};

struct EpiBranch {
    static constexpr bool AFTER_DRAIN = false; static constexpr int CHAIN = 3;
    unsigned char* ws;
    __device__ __forceinline__ void operator()(f32x4 (&acc)[2][2][4][2], const Unit& u, int wr, int wc, int fr, int fq) const {
        { int ln_; asm volatile("v_mbcnt_lo_u32_b32 %0, -1, 0\n\tv_mbcnt_hi_u32_b32 %0, -1, %0" : "=v"(ln_)); fr = ln_ & 15; fq = ln_ >> 4; }
        const int row0 = u.pm * 256 + wr * 64 + fr, cl = wc * 32 + 8 * fq;
        const unsigned char* G = ws + WS_GT; bf16* O = (bf16*)(ws + WS_MG);
        const int sub = u.sub;
        u32x4 gaa[2][4], gbb[2][4];
#pragma unroll
        for (int ai = 0; ai < 2; ++ai)
#pragma unroll
            for (int m = 0; m < 4; ++m) { const unsigned r = (unsigned)(row0 + ai * 128 + m * 16); const int c16 = u.pn * 256 + 2 * cl;
                gaa[ai][m] = *(const u32x4*)(G + r * 6144 + sub * 2048 + c16);
                gbb[ai][m] = (sub < 2) ? *(const u32x4*)(G + r * 6144 + (sub + 1) * 2048 + c16) : (u32x4){0u, 0u, 0u, 0u}; }
#pragma unroll
        for (int ai = 0; ai < 2; ++ai) {
            u32x4 ga4[4], gb4[4];
#pragma unroll
            for (int m = 0; m < 4; ++m) { ga4[m] = gaa[ai][m]; gb4[m] = gbb[ai][m]; }
#pragma unroll
            for (int m = 0; m < 0; ++m) { const unsigned r = (unsigned)(row0 + ai * 128 + m * 16); const int c16 = u.pn * 256 + 2 * cl;
                ga4[m] = *(const u32x4*)(G + r * 6144 + sub * 2048 + c16);
                gb4[m] = (sub < 2) ? *(const u32x4*)(G + r * 6144 + (sub + 1) * 2048 + c16) : (u32x4){0u, 0u, 0u, 0u}; }
#pragma unroll
            for (int m = 0; m < 4; ++m)
#pragma unroll
                for (int bj = 0; bj < 2; ++bj) { const unsigned r = (unsigned)(row0 + ai * 128 + m * 16); const int c = u.pn * 256 + bj * 128 + cl;
                    const u32x2 a4 = bj ? (u32x2){ga4[m].z, ga4[m].w} : (u32x2){ga4[m].x, ga4[m].y}, b4 = bj ? (u32x2){gb4[m].z, gb4[m].w} : (u32x2){gb4[m].x, gb4[m].y};
#define UB_(w, k) ((float)(((w) >> (8 * (k))) & 0xffu))
                    float s[8] = {UB_(a4.x, 0), UB_(a4.x, 1), UB_(a4.x, 2), UB_(a4.x, 3), UB_(a4.y, 0), UB_(a4.y, 1), UB_(a4.y, 2), UB_(a4.y, 3)};
#pragma unroll
                    for (int e = 0; e < 8; ++e) s[e] = fmaxf(s[e], 255e-6f);
                    if (sub < 2) { const float d[8] = {UB_(b4.x, 0), UB_(b4.x, 1), UB_(b4.x, 2), UB_(b4.x, 3), UB_(b4.y, 0), UB_(b4.y, 1), UB_(b4.y, 2), UB_(b4.y, 3)};
#pragma unroll
                        for (int e = 0; e < 8; ++e) s[e] *= __builtin_amdgcn_rcpf(fmaxf(d[e], 255e-6f)); }
                    else {
#pragma unroll
                        for (int e = 0; e < 8; ++e) s[e] *= (1.f / 255.f); }
#undef UB_
                    f32x4 v0 = acc[ai][bj][m][0], v1 = acc[ai][bj][m][1];
                    v0.x *= s[0]; v0.y *= s[1]; v0.z *= s[2]; v0.w *= s[3]; v1.x *= s[4]; v1.y *= s[5]; v1.z *= s[6]; v1.w *= s[7];
                    if (sub < 2) { acc[ai][bj][m][0] = v0; acc[ai][bj][m][1] = v1; }
                    else st8bf(O + r * 2048 + c, v0, v1); } }
    }
};

struct EpiF32 {
    static constexpr bool AFTER_DRAIN = false; static constexpr int CHAIN = 1;
    float* O; int ld;
    __device__ __forceinline__ void operator()(const f32x4 (&acc)[2][2][4][2], const Unit& u, int wr, int wc, int fr, int fq) const {
        { int ln_; asm volatile("v_mbcnt_lo_u32_b32 %0, -1, 0\n\tv_mbcnt_hi_u32_b32 %0, -1, %0" : "=v"(ln_)); fr = ln_ & 15; fq = ln_ >> 4; }
        const int row0 = u.pm * 256 + wr * 64 + fr, cl = wc * 32 + 8 * fq;
#pragma unroll
        for (int ai = 0; ai < 2; ++ai)
#pragma unroll
            for (int m = 0; m < 4; ++m) { asm volatile("" ::: "memory"); const unsigned r = (unsigned)(row0 + ai * 128 + m * 16);
#pragma unroll
                for (int bj = 0; bj < 2; ++bj) { float* p = O + r * ld + u.pn * 256 + bj * 128 + cl; *(f32x4*)p = acc[ai][bj][m][0]; *(f32x4*)(p + 4) = acc[ai][bj][m][1]; } }
    }
};
struct EpiBf {
    static constexpr bool AFTER_DRAIN = false; static constexpr int CHAIN = 1;
    bf16* O; int ld;
    __device__ __forceinline__ void operator()(const f32x4 (&acc)[2][2][4][2], const Unit& u, int wr, int wc, int fr, int fq) const {
        { int ln_; asm volatile("v_mbcnt_lo_u32_b32 %0, -1, 0\n\tv_mbcnt_hi_u32_b32 %0, -1, %0" : "=v"(ln_)); fr = ln_ & 15; fq = ln_ >> 4; }
        const int row0 = u.pm * 256 + wr * 64 + fr, cl = wc * 32 + 8 * fq;
#pragma unroll
        for (int ai = 0; ai < 2; ++ai)
#pragma unroll
            for (int m = 0; m < 4; ++m) { asm volatile("" ::: "memory"); const unsigned r = (unsigned)(row0 + ai * 128 + m * 16);
#pragma unroll
                for (int bj = 0; bj < 2; ++bj) st8bf(O + r * ld + u.pn * 256 + bj * 128 + cl, acc[ai][bj][m][0], acc[ai][bj][m][1]); }
    }
};

__device__ __forceinline__ float dpp_prev(float x) { return __builtin_bit_cast(float, __builtin_amdgcn_update_dpp(0, __builtin_bit_cast(int, x), 0x121, 0xf, 0xf, false)); }
__device__ __forceinline__ float dpp_next(float x) { return __builtin_bit_cast(float, __builtin_amdgcn_update_dpp(0, __builtin_bit_cast(int, x), 0x12f, 0xf, 0xf, false)); }
__device__ __forceinline__ float dpp_up(float e, float x) { return __builtin_bit_cast(float, __builtin_amdgcn_update_dpp(__builtin_bit_cast(int, e), __builtin_bit_cast(int, x), 0x111, 0xf, 0xf, false)); }
__device__ __forceinline__ float dpp_dn(float e, float x) { return __builtin_bit_cast(float, __builtin_amdgcn_update_dpp(__builtin_bit_cast(int, e), __builtin_bit_cast(int, x), 0x101, 0xf, 0xf, false)); }
struct EpiUp {
    static constexpr bool AFTER_DRAIN = false; static constexpr int CHAIN = 1;
    unsigned char* ws; const float* cw; LAS unsigned char* hl; int l;
    __device__ __forceinline__ void put_partial(const f32x4 (&acc)[2][2][4][2], const Unit& u, int wave) const {
        const int tid = tid_now(wave), j = (u.sub - 1) >> 1;
        float* P = (float*)(ws + WS_SPL) + (size_t)j * 65536 + tid * 4;
#pragma unroll
        for (int ai = 0; ai < 2; ++ai)
#pragma unroll
            for (int bj = 0; bj < 2; ++bj)
#pragma unroll
                for (int m = 0; m < 4; ++m)
#pragma unroll
                    for (int n = 0; n < 2; ++n) *(f32x4*)(P + (((ai * 2 + bj) * 4 + m) * 2 + n) * 2048) = acc[ai][bj][m][n];
        asm volatile("s_waitcnt vmcnt(0)" ::: "memory");
        __syncthreads();
        if (tid == 0) { __builtin_amdgcn_fence(__ATOMIC_RELEASE, "agent"); asm volatile("s_waitcnt vmcnt(0)" ::: "memory"); __hip_atomic_store((unsigned*)ws + CW_SPL + l * 128 + j, 1u, RLX_AGENT); }
    }
    __device__ __forceinline__ void get_partial(f32x4 (&acc)[2][2][4][2], const Unit& u, int wave) const {
        const int tid = tid_now(wave), j = (u.sub - 1) >> 1;
        if (tid == 0) { unsigned* f = (unsigned*)ws + CW_SPL + l * 128 + j; unsigned sp = 0; while (__hip_atomic_load(f, RLX_AGENT) == 0u) { __builtin_amdgcn_s_sleep(1); if (++sp > (1u << 22)) break; }
            __builtin_amdgcn_fence(__ATOMIC_ACQUIRE, "agent"); asm volatile("s_waitcnt vmcnt(0)" ::: "memory"); }
        __syncthreads();
        const float* P = (const float*)(ws + WS_SPL) + (size_t)j * 65536 + tid * 4;
#pragma unroll
        for (int ai = 0; ai < 2; ++ai) { f32x4 p[2][4][2];
#pragma unroll
            for (int bj = 0; bj < 2; ++bj)
#pragma unroll
                for (int m = 0; m < 4; ++m)
#pragma unroll
                    for (int n = 0; n < 2; ++n) p[bj][m][n] = *(const f32x4*)(P + (((ai * 2 + bj) * 4 + m) * 2 + n) * 2048);
#pragma unroll
            for (int bj = 0; bj < 2; ++bj)
#pragma unroll
                for (int m = 0; m < 4; ++m)
#pragma unroll
                    for (int n = 0; n < 2; ++n) acc[ai][bj][m][n] += p[bj][m][n]; }
    }
    __device__ __forceinline__ void operator()(const f32x4 (&acc)[2][2][4][2], const Unit& u, int wr, int wc, int fr, int fq) const {
        { int ln_; asm volatile("v_mbcnt_lo_u32_b32 %0, -1, 0\n\tv_mbcnt_hi_u32_b32 %0, -1, %0" : "=v"(ln_)); fr = ln_ & 15; fq = ln_ >> 4; }
        const int cl = wc * 32 + 8 * fq;
        LAS f32x4* HL = (LAS f32x4*)hl;
#pragma unroll
        for (int ai = 0; ai < 2; ++ai) {
            if (fr == 0) {
#pragma unroll
                for (int bj = 0; bj < 2; ++bj)
#pragma unroll
                    for (int n = 0; n < 2; ++n) HL[((((ai * 2 + wr) * 4 + wc) * 2 + 0) * 4 + fq) * 4 + bj * 2 + n] = acc[ai][bj][0][n]; }
            if (fr == 15) {
#pragma unroll
                for (int bj = 0; bj < 2; ++bj)
#pragma unroll
                    for (int n = 0; n < 2; ++n) HL[((((ai * 2 + wr) * 4 + wc) * 2 + 1) * 4 + fq) * 4 + bj * 2 + n] = acc[ai][bj][3][n]; }
        }
        if (u.pm >= 16) {
            bf16* HU = (bf16*)(ws + WS_HALO) + (size_t)(u.pm - 16) * 4 * NUP + u.pn * 256 + cl;
            if (wr == 0 && fr < 2) {
#pragma unroll
                for (int bj = 0; bj < 2; ++bj) st8bf(HU + (size_t)fr * NUP + bj * 128, acc[0][bj][0][0], acc[0][bj][0][1]); }
            if (wr == 1 && fr >= 14) {
#pragma unroll
                for (int bj = 0; bj < 2; ++bj) st8bf(HU + (size_t)(fr - 12) * NUP + bj * 128, acc[1][bj][3][0], acc[1][bj][3][1]); }
        }
        asm volatile("s_waitcnt lgkmcnt(0)" ::: "memory");
        __builtin_amdgcn_s_barrier();
        bf16* ACT = (bf16*)(ws + WS_ACT);
        LAS u32x2* KEEP = (LAS u32x2*)(hl - HALO_OFF + 3 * 16384) + (wr * 4 + wc) * 64 + (fq * 16 + fr);
#pragma unroll
        for (int ai = 0; ai < 2; ++ai) {
#pragma unroll
            for (int n = 0; n < 2; ++n) { asm volatile("" ::: "memory");
                f32x4 wa[3], wg[3];
#pragma unroll
                for (int tap = 0; tap < 3; ++tap) { const float* p = cw + tap * NUP + u.pn * 128 + cl + 4 * n; wa[tap] = *(const f32x4*)p; wg[tap] = *(const f32x4*)(p + DFF); }
                f32x4 top[2], bot[2];
#pragma unroll
                for (int bj = 0; bj < 2; ++bj) {
                    const int tsrc = (wr == 1) ? (ai * 2 + 0) : 1;
                    const int bsrc = (wr == 0) ? (ai * 2 + 1) : 2;
                    const f32x4 tv = HL[(((tsrc * 4 + wc) * 2 + 1) * 4 + fq) * 4 + bj * 2 + n], bv = HL[(((bsrc * 4 + wc) * 2 + 0) * 4 + fq) * 4 + bj * 2 + n];
                    top[bj] = (wr == 1 || ai == 1) ? tv : (f32x4){0.f, 0.f, 0.f, 0.f};
                    bot[bj] = (wr == 0 || ai == 0) ? bv : (f32x4){0.f, 0.f, 0.f, 0.f}; }
#pragma unroll
                for (int m = 0; m < 4; ++m) { asm volatile("" ::: "memory");
                    const unsigned r = (unsigned)(u.pm * 256 + ai * 128 + wr * 64 + m * 16 + fr);
                    f32x4 res;
#pragma unroll
                    for (int e = 0; e < 4; ++e) {
                        float v[2];
#pragma unroll
                        for (int bj = 0; bj < 2; ++bj) {
                            const float x = acc[ai][bj][m][n][e];
                            const float pe_ = (m == 0) ? top[bj][e] : dpp_prev(acc[ai][bj][m == 0 ? 0 : m - 1][n][e]);
                            const float ne_ = (m == 3) ? bot[bj][e] : dpp_next(acc[ai][bj][m == 3 ? 3 : m + 1][n][e]);
                            const float up = dpp_up(pe_, x), dn = dpp_dn(ne_, x);
                            const float w0 = bj ? wg[0][e] : wa[0][e], w1 = bj ? wg[1][e] : wa[1][e], w2 = bj ? wg[2][e] : wa[2][e];
                            v[bj] = w0 * up + w1 * x + w2 * dn; }
                        res[e] = v[0] * gelu_tanh(v[1]); }
                    u32x2 o; o.x = cvtpk_p(res.x, res.y); o.y = cvtpk_p(res.z, res.w);
                    if (n == 0) KEEP[m * 512] = o;
                    else { const u32x2 k0 = KEEP[m * 512]; const u32x4 o4 = (u32x4){k0.x, k0.y, o.x, o.y}; *(u32x4*)(ACT + r * DFF + u.pn * 128 + cl) = o4; } }
            }
        }
        __builtin_amdgcn_s_barrier();
    }
};
__device__ __forceinline__ void conv_fixup(ArgP a, int l, int pm, int wave) {
    if (pm < 16) return;
    const int tid = tid_now(wave); const int tl = pm - 16;
    const bf16* HU = (const bf16*)(a->ws + WS_HALO); bf16* ACT = (bf16*)(a->ws + WS_ACT); const float* CW = a->in[28] + (size_t)l * 3 * NUP;
    for (int it = tid; it < 2 * (DFF / 8); it += 512) {
        const int which = it / (DFF / 8), c = (it % (DFF / 8)) * 8; const int j = c >> 7, i = c & 127;
        if (which == 0 ? ((tl & 3) == 0) : ((tl & 3) == 3)) continue;
        const bf16* r0 = which == 0 ? HU + ((size_t)(tl - 1) * 4 + 3) * NUP : HU + ((size_t)tl * 4 + 2) * NUP;
        const bf16* r1 = which == 0 ? HU + ((size_t)tl * 4 + 0) * NUP : HU + ((size_t)tl * 4 + 3) * NUP;
        const bf16* r2 = which == 0 ? HU + ((size_t)tl * 4 + 1) * NUP : HU + ((size_t)(tl + 1) * 4 + 0) * NUP;
        const bf16* rr[3] = {r0, r1, r2};
        f32x4 ra0 = (f32x4){0.f, 0.f, 0.f, 0.f}, ra1 = ra0, rg0 = ra0, rg1 = ra0;
#pragma unroll
        for (int tap = 0; tap < 3; ++tap) { const u32x4 xa = *(const u32x4*)(rr[tap] + 256 * j + i), xg = *(const u32x4*)(rr[tap] + 256 * j + i + 128);
            const float* p = CW + tap * NUP + c; const f32x4 wa0 = *(const f32x4*)p, wa1 = *(const f32x4*)(p + 4), wg0 = *(const f32x4*)(p + DFF), wg1 = *(const f32x4*)(p + DFF + 4);
            ra0 += wa0 * (f32x4){bf_lo(xa.x), bf_hi(xa.x), bf_lo(xa.y), bf_hi(xa.y)}; ra1 += wa1 * (f32x4){bf_lo(xa.z), bf_hi(xa.z), bf_lo(xa.w), bf_hi(xa.w)};
            rg0 += wg0 * (f32x4){bf_lo(xg.x), bf_hi(xg.x), bf_lo(xg.y), bf_hi(xg.y)}; rg1 += wg1 * (f32x4){bf_lo(xg.z), bf_hi(xg.z), bf_lo(xg.w), bf_hi(xg.w)}; }
        u32x4 o; o.x = pk2(ra0.x * gelu_tanh(rg0.x), ra0.y * gelu_tanh(rg0.y)); o.y = pk2(ra0.z * gelu_tanh(rg0.z), ra0.w * gelu_tanh(rg0.w));
        o.z = pk2(ra1.x * gelu_tanh(rg1.x), ra1.y * gelu_tanh(rg1.y)); o.w = pk2(ra1.z * gelu_tanh(rg1.z), ra1.w * gelu_tanh(rg1.w));
        *(u32x4*)(ACT + (size_t)(pm * 256 + (which ? 255 : 0)) * DFF + c) = o;
    }
    asm volatile("s_waitcnt vmcnt(0)" ::: "memory");
    __syncthreads();
}

#define RLX_AG __ATOMIC_RELAXED, __HIP_MEMORY_SCOPE_AGENT
__device__ __forceinline__ void panel_exchange(LAS float* P, LAS float* R, unsigned* X, unsigned* cnt, int pm, int pn, int tid) {
    if (tid < 256) { const f32x4 p = *(const LAS f32x4*)(P + tid * 4); const float tot = (p.x + p.y) + (p.z + p.w);
        __hip_atomic_store(X + ((size_t)(pm * 256 + tid)) * 8 + pn, __builtin_bit_cast(unsigned, tot), RLX_AG); }
    asm volatile("s_waitcnt vmcnt(0)" ::: "memory");
    __syncthreads();
    if (tid == 0) { (void)__hip_atomic_fetch_add(cnt, 1u, RLX_AG);
        unsigned sp = 0; while (__hip_atomic_load(cnt, RLX_AG) < 8u) { __builtin_amdgcn_s_sleep(1); if (++sp > (1u << 22)) break; } }
    __syncthreads();
    if (tid < 256) { float tot = 0.f;
#pragma unroll
        for (int j = 0; j < 8; ++j) tot += __builtin_bit_cast(float, __hip_atomic_load(X + ((size_t)(pm * 256 + tid)) * 8 + j, RLX_AG));
        R[tid] = rsq_(tot * (1.f / D) + EPS); }
    __syncthreads();
}
template <int WHICH, bool XF32>
struct EpiResid {
    static constexpr bool AFTER_DRAIN = true; static constexpr int CHAIN = 1;
    unsigned char* ws; float* out; const float* xin0; const float* xin1; const float* npost; const float* nnext; int l; int mk_next;
    __device__ __forceinline__ void operator()(const f32x4 (&acc)[2][2][4][2], const Unit& u, int wr, int wc, int fr, int fq) const {}
    __device__ __forceinline__ void fused(f32x4 (&acc)[2][2][4][2], const Unit& u, int wr, int wc, int fr, int fq, LAS unsigned char* lds, int tid) const {
        { int ln_; asm volatile("v_mbcnt_lo_u32_b32 %0, -1, 0\n\tv_mbcnt_hi_u32_b32 %0, -1, %0" : "=v"(ln_)); fr = ln_ & 15; fq = ln_ >> 4; tid = (wr * 4 + wc) * 64 + ln_; }
        LAS float* P = (LAS float*)lds; LAS float* R = (LAS float*)(lds + 4096);
        const int lr0 = wr * 64 + fr, cl = wc * 32 + 8 * fq, ln = fq * 16 + fr;
#pragma unroll
        for (int ai = 0; ai < 2; ++ai)
#pragma unroll
            for (int m = 0; m < 4; ++m) { float sq = 0.f;
#pragma unroll
                for (int bj = 0; bj < 2; ++bj)
#pragma unroll
                    for (int n = 0; n < 2; ++n) { const f32x4 v = acc[ai][bj][m][n]; sq += (v.x * v.x + v.y * v.y) + (v.z * v.z + v.w * v.w); }
                sq += shx(sq, 16, ln); sq += shx(sq, 32, ln);
                if (fq == 0) P[(ai * 128 + lr0 + m * 16) * 4 + wc] = sq; }
        __syncthreads();
        unsigned* X = (unsigned*)(ws + WS_XCH) + (size_t)(WHICH * 2) * MT * 8;
        unsigned* cnt = (unsigned*)(ws + WS_CTL) + CW_CNT + (((l * 2 + WHICH) * 2) * 32 + u.pm) * 64;
        const int sel = (u.pm < 16) ? 0 : 1 + ((u.pm - 16) >> 2);
        const float* MODL = (const float*)(ws + WS_MOD) + (size_t)(l * 5 + sel) * 12288;
        const unsigned cb = (unsigned)(u.pn * 256 + cl);
        const bf16* XB = (const bf16*)(ws + WS_XB);
        u32x4 xraw[4][2];
#pragma unroll
        for (int m = 0; m < 4; ++m)
#pragma unroll
            for (int bj = 0; bj < 2; ++bj) xraw[m][bj] = (u32x4){0u, 0u, 0u, 0u};
        if constexpr (!XF32) {
#pragma unroll
            for (int m = 0; m < 4; ++m) { const unsigned r = (unsigned)(u.pm * 256 + lr0 + m * 16);
#pragma unroll
                for (int bj = 0; bj < 2; ++bj) xraw[m][bj] = *(const u32x4*)(XB + r * D + cb + bj * 128); } }
        panel_exchange(P, R, X, cnt, u.pm, u.pn, tid);
        {
        f32x4 gw[2][2];
#pragma unroll
        for (int bj = 0; bj < 2; ++bj)
#pragma unroll
            for (int n = 0; n < 2; ++n) gw[bj][n] = *(const f32x4*)(MODL + (WHICH ? 5 : 2) * D + cb + (bj * 128 + 4 * n)) * *(const f32x4*)(npost + cb + (bj * 128 + 4 * n));
#pragma unroll
        for (int ai = 0; ai < 2; ++ai) { asm volatile("" ::: "memory");
            f32x4 xa[4][2][2];
            if constexpr (XF32) {
#pragma unroll
                for (int m = 0; m < 4; ++m) { const size_t r = (size_t)u.pm * 256 + ai * 128 + lr0 + m * 16; const float* xr = ((r < (size_t)MC) ? xin0 + r * D : xin1 + (r - MC) * D) + cb;
#pragma unroll
                    for (int bj = 0; bj < 2; ++bj)
#pragma unroll
                        for (int n = 0; n < 2; ++n) xa[m][bj][n] = *(const f32x4*)(xr + (bj * 128 + 4 * n)); }
            } else {
                if (ai == 1) {
#pragma unroll
                    for (int m = 0; m < 4; ++m) { const unsigned r = (unsigned)(u.pm * 256 + 128 + lr0 + m * 16);
#pragma unroll
                        for (int bj = 0; bj < 2; ++bj) xraw[m][bj] = *(const u32x4*)(XB + r * D + cb + bj * 128); } }
#pragma unroll
                for (int m = 0; m < 4; ++m)
#pragma unroll
                    for (int bj = 0; bj < 2; ++bj) { const u32x4 w = xraw[m][bj];
                        xa[m][bj][0] = (f32x4){bf_lo(w.x), bf_hi(w.x), bf_lo(w.y), bf_hi(w.y)}; xa[m][bj][1] = (f32x4){bf_lo(w.z), bf_hi(w.z), bf_lo(w.w), bf_hi(w.w)}; } }
#pragma unroll
            for (int m = 0; m < 4; ++m) { const int lr = ai * 128 + lr0 + m * 16; const float rs = R[lr]; float sq = 0.f;
#pragma unroll
                for (int bj = 0; bj < 2; ++bj)
#pragma unroll
                    for (int n = 0; n < 2; ++n) { const f32x4 xn = xa[m][bj][n] + gw[bj][n] * (acc[ai][bj][m][n] * rs); acc[ai][bj][m][n] = xn;
                        sq += (xn.x * xn.x + xn.y * xn.y) + (xn.z * xn.z + xn.w * xn.w); }
                sq += shx(sq, 16, ln); sq += shx(sq, 32, ln);
                if (fq == 0) P[lr * 4 + wc] = sq; } }
        }
        if (!mk_next) {
#pragma unroll
            for (int ai = 0; ai < 2; ++ai)
#pragma unroll
                for (int m = 0; m < 4; ++m) { const size_t r = (size_t)u.pm * 256 + ai * 128 + lr0 + m * 16; float* orow = out + r * D + cb;
#pragma unroll
                    for (int bj = 0; bj < 2; ++bj)
#pragma unroll
                        for (int n = 0; n < 2; ++n) *(f32x4*)(orow + (bj * 128 + 4 * n)) = acc[ai][bj][m][n]; }
            return; }
        const float* MODN = (const float*)(ws + WS_MOD) + (size_t)((WHICH ? l + 1 : l) * 5 + sel) * 12288;
        f32x4 va[2][2], vb[2][2], sh[2][2];
#pragma unroll
        for (int bj = 0; bj < 2; ++bj)
#pragma unroll
            for (int n = 0; n < 2; ++n) { const unsigned c = cb + (unsigned)(bj * 128 + 4 * n);
                va[bj][n] = *(const f32x4*)(nnext + c); vb[bj][n] = *(const f32x4*)(MODN + (WHICH ? 1 : 4) * D + c); sh[bj][n] = *(const f32x4*)(MODN + (WHICH ? 0 : 3) * D + c); }
        __syncthreads();
        panel_exchange(P, R, X + (size_t)MT * 8, cnt + 32 * 64, u.pm, u.pn, tid);
        f32x4 vv[2][2];
#pragma unroll
        for (int bj = 0; bj < 2; ++bj)
#pragma unroll
            for (int n = 0; n < 2; ++n) vv[bj][n] = va[bj][n] * (vb[bj][n] + 1.f);
        bf16* H = (bf16*)(ws + WS_H); bf16* XO = (bf16*)(ws + WS_XB);
#pragma unroll
        for (int ai = 0; ai < 2; ++ai)
#pragma unroll
            for (int m = 0; m < 4; ++m) { const int lr = ai * 128 + lr0 + m * 16; const unsigned r = (unsigned)(u.pm * 256 + lr); const float rs = R[lr];
#pragma unroll
                for (int bj = 0; bj < 2; ++bj) {
                    st8bf(XO + r * D + cb + bj * 128, acc[ai][bj][m][0], acc[ai][bj][m][1]);
                    st8bf(H + r * D + cb + bj * 128, (acc[ai][bj][m][0] * rs) * vv[bj][0] + sh[bj][0], (acc[ai][bj][m][1] * rs) * vv[bj][1] + sh[bj][1]); } }
        __syncthreads();
    }
};

__device__ __forceinline__ void job_ckv_norm(ArgP a, int l, int wave) {
    const int tidn = tid_now(wave), lane = tidn & 63;
    const int gw = blockIdx.x * 8 + wave, NGW = gridDim.x * 8;
    const float* SS = (const float*)(a->ws + WS_SSQKV);
    const f32x4 g = *(const f32x4*)(a->in[20] + l * 256 + lane * 4);
    for (int m = gw; m < MC; m += NGW) {
        const f32x4 s0 = *(const f32x4*)(SS + (size_t)m * 4); const float rs = rsq_(((s0.x + s0.y) + (s0.z + s0.w)) * (1.f / 256.f) + EPS);
        float* p = a->out + OUT_CKV + ((size_t)((m >> 8) * 4 + l) * 256 + (m & 255)) * 256 + lane * 4;
        *(f32x4*)p = *(const f32x4*)p * rs * g;
    }
}

typedef short s16x4 __attribute__((ext_vector_type(4)));
typedef short v4i16_t __attribute__((ext_vector_type(4)));
constexpr float LOG2E = 1.4426950408889634f;
__device__ __forceinline__ unsigned k_swz(unsigned ob) { return ob ^ (((ob >> 9) & 1u) << 5); }
__device__ __forceinline__ unsigned offb(unsigned row, unsigned ch) { return 256u * row + 16u * (ch ^ (((row & 3u) << 2) | ((row >> 2) & 3u))); }
__device__ __forceinline__ unsigned cvtpk(float lo, float hi) { return pk2(lo, hi); }

template <int DK>
__device__ __forceinline__ void attn_stage_load(u32x4 (&kr)[DK / 64], u32x4 (&vr)[2], const bf16* K1, int ldk1, const bf16* K2, int ldk2, const bf16* V, int ldv, int row0, int tid) {
#pragma unroll
    for (int i = 0; i < DK / 64; ++i) { const int c = tid + 512 * i, key = c / (DK / 8), ch = c % (DK / 8);
        if (DK == 128 || ch < 16) kr[i] = *(const u32x4*)(K1 + (unsigned)((row0 + key) * ldk1 + ch * 8)); else kr[i] = *(const u32x4*)(K2 + (unsigned)((row0 + key) * ldk2 + (ch - 16) * 8)); }
#pragma unroll
    for (int i = 0; i < 2; ++i) { const int c = tid + 512 * i, row = c >> 4, ch = c & 15; vr[i] = *(const u32x4*)(V + (unsigned)((row0 + row) * ldv + ch * 8)); }
}
template <int DK>
__device__ __forceinline__ void attn_stage_store(LAS unsigned char* kb, LAS unsigned char* vb, const u32x4 (&kr)[DK / 64], const u32x4 (&vr)[2], int tid) {
#pragma unroll
    for (int i = 0; i < DK / 64; ++i) { const int c = tid + 512 * i, key = c / (DK / 8), ch = c % (DK / 8);
        const int w = key & 31, lr = (key & 32) + ((w >> 2) & 1) * 16 + (w >> 3) * 4 + (w & 3);
        *(LAS u32x4*)(kb + ((lr >> 4) * (DK / 32) + (ch >> 2)) * 1024 + k_swz((unsigned)((lr & 15) * 64 + (ch & 3) * 16))) = kr[i]; }
#pragma unroll
    for (int i = 0; i < 2; ++i) { const int c = tid + 512 * i, row = c >> 4, ch = c & 15; *(LAS u32x4*)(vb + offb((unsigned)row, (unsigned)ch)) = vr[i]; }
}
template <int DK>
__device__ __forceinline__ void attn_unit(LAS unsigned char* lds, int wave, int tid, const bf16* Q, int ldq, const bf16* K1, int ldk1, const bf16* K2, int ldk2, const bf16* V, int ldv,
                                          int s0_row, int s0_tiles, int s1_row, int s1_tiles, bool masked, int qpos0, int kpos0, float sink2, bool has_sink, bf16* O, int ldo) {
    constexpr int KS = DK / 32, KBYTES = 64 * DK * 2, BUF = KBYTES + 16384;
    const int lane = tid & 63, g = lane >> 4, i = lane & 15, q = i >> 2, p = i & 3;
    bf16x8 qf[KS];
    { const bf16* qp = Q + (size_t)(16 * wave + i) * ldq + g * 8;
#pragma unroll
      for (int ks = 0; ks < KS; ++ks) qf[ks] = *(const bf16x8*)(qp + ks * 32); }
    const unsigned koff = k_swz((unsigned)(i * 64 + g * 16));
    unsigned voff[2], vsw[2];
#pragma unroll
    for (int h = 0; h < 2; ++h) { voff[h] = 256u * (unsigned)(8 * g + 4 * h + q) + 8u * (unsigned)(p & 1); vsw[h] = (unsigned)((q << 2) | ((2 * g + h) & 3)); }
    f32x4 o[8];
#pragma unroll
    for (int d = 0; d < 8; ++d) o[d] = (f32x4){0.f, 0.f, 0.f, 0.f};
    float mrun = has_sink ? sink2 : -1e30f, lsum = (has_sink && g == 0) ? 1.f : 0.f;
    const int nt = s0_tiles + s1_tiles, tq = qpos0 + 16 * wave + i;
    u32x4 kr[2][DK / 64], vr[2][2];
    attn_stage_load<DK>(kr[0], vr[0], K1, ldk1, K2, ldk2, V, ldv, s0_row, tid);
    attn_stage_store<DK>(lds, lds + KBYTES, kr[0], vr[0], tid);
    { const int rown = 1 < s0_tiles ? s0_row + 64 : s1_row + 64 * (1 - s0_tiles); attn_stage_load<DK>(kr[1], vr[1], K1, ldk1, K2, ldk2, V, ldv, rown, tid); }
    asm volatile("s_waitcnt lgkmcnt(0)" ::: "memory"); __builtin_amdgcn_s_barrier();
    for (int t2 = 0; t2 < nt; t2 += 2) {
#pragma unroll
      for (int par = 0; par < 2; ++par) {
        const int t = t2 + par;
        if (t + 2 < nt) { const int tn = t + 2; const int rown = tn < s0_tiles ? s0_row + 64 * tn : s1_row + 64 * (tn - s0_tiles); attn_stage_load<DK>(kr[par], vr[par], K1, ldk1, K2, ldk2, V, ldv, rown, tid); }
        LAS unsigned char* kb = lds + par * BUF; LAS unsigned char* vb = kb + KBYTES;
        f32x4 s[2][2];
        constexpr int KQB = (KS <= 4) ? 2 : 1;
        bf16x8 kq[KQB][KS];
#define ATT_LOADK(blk, dst) _Pragma("unroll") for (int ks = 0; ks < KS; ++ks) dst[ks] = *(const LAS bf16x8*)(kb + ((blk) * KS + ks) * 1024 + koff)
        if (KQB == 2) { ATT_LOADK(0, kq[0]); }
#pragma unroll
        for (int bq = 0; bq < 4; ++bq) {
            if (KQB == 2) { if (bq < 3) { ATT_LOADK(bq + 1, kq[(bq + 1) & (KQB - 1)]); } } else { ATT_LOADK(bq, kq[0]); }
            __builtin_amdgcn_sched_barrier(0);
            f32x4 acc = (f32x4){0.f, 0.f, 0.f, 0.f};
#pragma unroll
            for (int ks = 0; ks < KS; ++ks) acc = __builtin_amdgcn_mfma_f32_16x16x32_bf16(kq[bq & (KQB - 1)][ks], qf[ks], acc, 0, 0, 0);
            s[bq >> 1][bq & 1] = acc;
            __builtin_amdgcn_sched_barrier(0);
        }
#undef ATT_LOADK
        bf16x8 vq[1][8];
#define ATT_LOADV(kh_, dst) _Pragma("unroll") for (int d = 0; d < 8; ++d) { \
            const s16x4 v0_ = __builtin_bit_cast(s16x4, __builtin_amdgcn_ds_read_tr16_b64_v4i16((LAS v4i16_t*)(vb + (kh_) * 8192 + voff[0] + 16u * ((unsigned)(2 * d + (p >> 1)) ^ vsw[0])))); \
            const s16x4 v1_ = __builtin_bit_cast(s16x4, __builtin_amdgcn_ds_read_tr16_b64_v4i16((LAS v4i16_t*)(vb + (kh_) * 8192 + voff[1] + 16u * ((unsigned)(2 * d + (p >> 1)) ^ vsw[1])))); \
            dst[d] = (bf16x8){v0_.x, v0_.y, v0_.z, v0_.w, v1_.x, v1_.y, v1_.z, v1_.w}; }
        if (KS <= 4) { ATT_LOADV(0, vq[0]); }
        __builtin_amdgcn_sched_barrier(0);
        if (masked && t < s0_tiles) { const int kp = kpos0 + 64 * t + 8 * g;
#pragma unroll
            for (int kh = 0; kh < 2; ++kh)
#pragma unroll
                for (int hi = 0; hi < 2; ++hi)
#pragma unroll
                    for (int e = 0; e < 4; ++e) { const int d = tq - (kp + 32 * kh + 4 * hi + e); if (d > 128 || d < -128) s[kh][hi][e] = -1e30f; } }
        float tm = fmaxf(fmaxf(fmaxf(s[0][0].x, s[0][0].y), fmaxf(s[0][0].z, s[0][0].w)), fmaxf(fmaxf(s[0][1].x, s[0][1].y), fmaxf(s[0][1].z, s[0][1].w)));
        tm = fmaxf(tm, fmaxf(fmaxf(fmaxf(s[1][0].x, s[1][0].y), fmaxf(s[1][0].z, s[1][0].w)), fmaxf(fmaxf(s[1][1].x, s[1][1].y), fmaxf(s[1][1].z, s[1][1].w))));
        tm = fmaxf(tm, shx(tm, 16, lane)); tm = fmaxf(tm, shx(tm, 32, lane));
        const float mnew = fmaxf(mrun, tm), alpha = __builtin_amdgcn_exp2f(mrun - mnew); mrun = mnew;
        float ps = 0.f; bf16x8 pf[2];
#pragma unroll
        for (int kh = 0; kh < 2; ++kh) { float pv[8];
#pragma unroll
            for (int hi = 0; hi < 2; ++hi)
#pragma unroll
                for (int e = 0; e < 4; ++e) { const float pe = __builtin_amdgcn_exp2f(s[kh][hi][e] - mnew); pv[hi * 4 + e] = pe; ps += pe; }
            u32x4 w; w.x = cvtpk(pv[0], pv[1]); w.y = cvtpk(pv[2], pv[3]); w.z = cvtpk(pv[4], pv[5]); w.w = cvtpk(pv[6], pv[7]); pf[kh] = __builtin_bit_cast(bf16x8, w); }
        lsum = lsum * alpha + ps;
#pragma unroll
        for (int d = 0; d < 8; ++d) o[d] = o[d] * alpha;
        if (KS > 4) { ATT_LOADV(0, vq[0]); __builtin_amdgcn_sched_barrier(0); }
#pragma unroll
        for (int d = 0; d < 8; ++d) o[d] = __builtin_amdgcn_mfma_f32_16x16x32_bf16(vq[0][d], pf[0], o[d], 0, 0, 0);
        __builtin_amdgcn_sched_barrier(0);
        ATT_LOADV(1, vq[0]);
        __builtin_amdgcn_sched_barrier(0);
#pragma unroll
        for (int d = 0; d < 8; ++d) o[d] = __builtin_amdgcn_mfma_f32_16x16x32_bf16(vq[0][d], pf[1], o[d], 0, 0, 0);
#undef ATT_LOADV
        if (t + 1 < nt) attn_stage_store<DK>(lds + (1 - par) * BUF, lds + (1 - par) * BUF + KBYTES, kr[1 - par], vr[1 - par], tid);
        asm volatile("s_waitcnt lgkmcnt(0)" ::: "memory"); __builtin_amdgcn_s_barrier();
      }
    }
    lsum += shx(lsum, 16, lane); lsum += shx(lsum, 32, lane);
    const float inv = 1.f / lsum;
    const int lane_e = tid_now(wave) & 63;
    bf16* op = O + (unsigned)((16 * wave + (lane_e & 15)) * ldo + 4 * (lane_e >> 4));
#pragma unroll
    for (int d = 0; d < 8; ++d) { u32x2 w; w.x = cvtpk(o[d].x * inv, o[d].y * inv); w.y = cvtpk(o[d].z * inv, o[d].w * inv); *(u32x2*)(op + 16 * d) = w; }
}
__device__ __forceinline__ void job_attn_c(ArgP a, int l, LAS unsigned char* lds, int wave, int u_first, int u_end, int u_stride) {
    const int tid = tid_now(wave); unsigned char* ws = a->ws;
    const bf16* Q = (const bf16*)(ws + WS_QC); const bf16* K = (const bf16*)(ws + WS_KC) + (size_t)l * MKV * 256; const bf16* V = (const bf16*)(ws + WS_VC) + (size_t)l * MKV * 256;
    bf16* O = (bf16*)(ws + WS_OC);
    for (int u = u_first; u < u_end; u += u_stride) {
        int h, m0, s0r, s0t, s1r, s1t, qp, kp; bool mk;
        if (u < 256) { const int b = u >> 6, qb = u & 7; h = (u >> 3) & 7; const int lo = qb * 128 - 128 < 0 ? 0 : qb * 128 - 128, hi = qb * 128 + 256 > 1024 ? 1024 : qb * 128 + 256;
            m0 = MC + b * 1024 + qb * 128; s0r = MC + b * 1024 + lo; s0t = (hi - lo) >> 6; s1r = MT + b * 256; s1t = 4; mk = true; qp = qb * 128; kp = lo; }
        else { const int v = u - 256, b = v >> 4, qb = v & 1; h = (v >> 1) & 7; m0 = b * 256 + qb * 128; s0r = b * 256; s0t = 4; s1r = 0; s1t = 0; mk = false; qp = 0; kp = 0; }
        const int kg = h >> 2;
        attn_unit<128>(lds, wave, tid, Q + (size_t)m0 * 1024 + h * 128, 1024, K + kg * 128, 256, nullptr, 0, V + kg * 128, 256, s0r, s0t, s1r, s1t, mk, qp, kp,
                       a->in[22][l * 8 + h] * LOG2E, true, O + (size_t)m0 * 1024 + h * 128, 1024);
    }
}
__device__ __forceinline__ void job_attn_b(ArgP a, int l, LAS unsigned char* lds, int wave) {
    const int tid = tid_now(wave); unsigned char* ws = a->ws;
    const bf16* Q = (const bf16*)(ws + WS_QF); const bf16* KV = (const bf16*)(ws + WS_KV); const bf16* KR = (const bf16*)(ws + WS_KR) + (size_t)l * MKV * 64;
    bf16* O = (bf16*)(ws + WS_OBB);
    for (int u = blockIdx.x; u < 512; u += gridDim.x) {
        int h, m0, s0r, s0t, s1r, s1t;
        if (u < 256) { const int b = u >> 6, qb = u & 7; h = (u >> 3) & 7; m0 = MC + b * 1024 + qb * 128; s0r = MC + b * 1024; s0t = 16; s1r = MT + b * 256; s1t = 4; }
        else { const int v = u - 256, b = v >> 4, qb = v & 1; h = (v >> 1) & 7; m0 = b * 256 + qb * 128; s0r = b * 256; s0t = 4; s1r = 0; s1t = 0; }
        attn_unit<192>(lds, wave, tid, Q + (size_t)m0 * 1536 + h * 192, 1536, KV + h * 128, 2048, KR, 64, KV + 1024 + h * 128, 2048, s0r, s0t, s1r, s1t, false, 0, 0, 0.f, false,
                       O + (size_t)m0 * 1024 + h * 128, 1024);
    }
}
constexpr int SC_QG = 0, SC_KG = 8192, SC_KD = 16384, SC_VV = 24576, SC_EL = 32768, SC_SEG = 33280, SC_BUF = 38912;
__device__ __forceinline__ bf16x8 tr2(LAS unsigned char* p0, LAS unsigned char* p1) {
    const s16x4 v0 = __builtin_bit_cast(s16x4, __builtin_amdgcn_ds_read_tr16_b64_v4i16((LAS v4i16_t*)p0));
    const s16x4 v1 = __builtin_bit_cast(s16x4, __builtin_amdgcn_ds_read_tr16_b64_v4i16((LAS v4i16_t*)p1));
    return (bf16x8){v0.x, v0.y, v0.z, v0.w, v1.x, v1.y, v1.z, v1.w};
}
struct ScanRegs { unsigned lg[4]; unsigned qv[4]; u32x4 vv; };
__device__ __forceinline__ void scan_stage_load(ScanRegs& R, const bf16* LG, const bf16* KK, const bf16* QA, const bf16* VA, int m0, int n, int dir, int h, int c, int wave, int lane, int tid) {
#pragma unroll
    for (int tt = 0; tt < 4; ++tt) { const int j = 32 * c + 4 * wave + tt; const size_t m = m0 + (dir ? n - 1 - j : j);
        R.lg[tt] = *(const unsigned*)(LG + m * 2048 + dir * 1024 + h * 128 + 2 * lane);
        R.qv[tt] = *(const unsigned*)(QA + m * 1024 + h * 128 + 2 * lane); }
    { const int j = 32 * c + (tid >> 4); const size_t m = m0 + (dir ? n - 1 - j : j); R.vv = *(const u32x4*)(VA + m * 1024 + h * 128 + (tid & 15) * 8); }
}
__device__ __forceinline__ void scan_stage_finish(const ScanRegs& R, LAS unsigned char* buf, int wave, int lane, int tid) {
    f32x2 cs[4]; cs[0] = (f32x2){bf_lo(R.lg[0]), bf_hi(R.lg[0])}; cs[1] = cs[0] + (f32x2){bf_lo(R.lg[1]), bf_hi(R.lg[1])}; cs[2] = cs[1] + (f32x2){bf_lo(R.lg[2]), bf_hi(R.lg[2])}; cs[3] = cs[2] + (f32x2){bf_lo(R.lg[3]), bf_hi(R.lg[3])};
    LAS f32x2* SEG = (LAS f32x2*)(buf + SC_SEG);
    SEG[wave * 64 + lane] = cs[3];
    asm volatile("s_waitcnt lgkmcnt(0)" ::: "memory"); __builtin_amdgcn_s_barrier();
    f32x2 pre = (f32x2){0.f, 0.f}, tot = (f32x2){0.f, 0.f};
#pragma unroll
    for (int s = 0; s < 8; ++s) { const f32x2 v = SEG[s * 64 + lane]; tot += v; if (s < wave) pre += v; }
#pragma unroll
    for (int tt = 0; tt < 4; ++tt) { const int j = 4 * wave + tt; const f32x2 G = pre + cs[tt];
        const float e0 = __expf(G.x), e1 = __expf(G.y), i0 = __expf(fminf(-G.x, 80.f)), i1 = __expf(fminf(-G.y, 80.f)), d0 = __expf(tot.x - G.x), d1 = __expf(tot.y - G.y);
        const float k0 = 1.f - __expf(bf_lo(R.lg[tt])), k1 = 1.f - __expf(bf_hi(R.lg[tt])), q0 = bf_lo(R.qv[tt]), q1 = bf_hi(R.qv[tt]);
        const unsigned o = offb((unsigned)j, (unsigned)(lane >> 2)) + 4u * (unsigned)(lane & 3);
        *(LAS unsigned*)(buf + SC_QG + o) = cvtpk(q0 * e0, q1 * e1);
        *(LAS unsigned*)(buf + SC_KG + o) = cvtpk(k0 * i0, k1 * i1);
        *(LAS unsigned*)(buf + SC_KD + o) = cvtpk(k0 * d0, k1 * d1); }
    *(LAS u32x4*)(buf + SC_VV + offb((unsigned)(tid >> 4), (unsigned)(tid & 15))) = R.vv;
    if (wave == 0) ((LAS f32x2*)(buf + SC_EL))[lane] = (f32x2){__expf(tot.x), __expf(tot.y)};
    asm volatile("s_waitcnt lgkmcnt(0)" ::: "memory"); __builtin_amdgcn_s_barrier();
}
__device__ __forceinline__ void scan_item(ArgP a, int l, int item, LAS unsigned char* lds, int wave, int tid) {
    const int lane = tid & 63, g = lane >> 4, i = lane & 15, q = i >> 2, p = i & 3;
    const int dir = item & 1, h = (item >> 1) & 7, sq = item >> 4;
    const bool lat = sq >= 16; const int n = lat ? 1024 : 256; const int m0 = lat ? MC + (sq - 16) * 1024 : sq * 256; const int nc = n >> 5;
    unsigned char* ws = a->ws;
    const bf16* QA = (const bf16*)(ws + WS_QA); const bf16* KK = (const bf16*)(ws + WS_KK); const bf16* VA = (const bf16*)(ws + WS_VA); const bf16* LG = (const bf16*)(ws + WS_LG);
    bf16* OO = (bf16*)(ws + (dir ? WS_OB : WS_OF));
    f32x4 S[8];
    if (lat) { const float* s0 = a->in[2] + ((((size_t)(sq - 16) * 4 + l) * 2 + dir) * 8 + h) * 16384 + 16 * wave + i;
#pragma unroll
        for (int aa = 0; aa < 8; ++aa)
#pragma unroll
            for (int e = 0; e < 4; ++e) S[aa][e] = s0[(16 * aa + 4 * g + e) * 128]; }
    else {
#pragma unroll
        for (int aa = 0; aa < 8; ++aa) S[aa] = (f32x4){0.f, 0.f, 0.f, 0.f}; }
    ScanRegs R0, R1;
    scan_stage_load(R0, LG, KK, QA, VA, m0, n, dir, h, 0, wave, lane, tid);
    scan_stage_load(R1, LG, KK, QA, VA, m0, n, dir, h, 1, wave, lane, tid);
    scan_stage_finish(R0, lds, wave, lane, tid);
    unsigned rro[2][4];
#pragma unroll
    for (int b = 0; b < 2; ++b)
#pragma unroll
        for (int ks = 0; ks < 4; ++ks) rro[b][ks] = offb((unsigned)(16 * b + i), (unsigned)(4 * ks + g));
    for (int c2 = 0; c2 < nc; c2 += 2) {
#pragma unroll
      for (int par = 0; par < 2; ++par) {
        const int c = c2 + par;
        const bool more = c + 1 < nc;
        if (c + 2 < nc) { if (par == 0) scan_stage_load(R0, LG, KK, QA, VA, m0, n, dir, h, c + 2, wave, lane, tid); else scan_stage_load(R1, LG, KK, QA, VA, m0, n, dir, h, c + 2, wave, lane, tid); }
        LAS unsigned char* buf = lds + par * SC_BUF;
        f32x4 at[2][2];
#pragma unroll
        for (int sb = 0; sb < 2; ++sb)
#pragma unroll
            for (int tb = 0; tb < 2; ++tb) at[sb][tb] = (f32x4){0.f, 0.f, 0.f, 0.f};
        { bf16x8 kf[4][2], qf[4][2];
#pragma unroll
          for (int ks = 0; ks < 4; ++ks)
#pragma unroll
              for (int b = 0; b < 2; ++b) { kf[ks][b] = *(const LAS bf16x8*)(buf + SC_KG + rro[b][ks]); qf[ks][b] = *(const LAS bf16x8*)(buf + SC_QG + rro[b][ks]); }
          __builtin_amdgcn_sched_barrier(0);
#pragma unroll
          for (int ks = 0; ks < 4; ++ks)
#pragma unroll
              for (int sb = 0; sb < 2; ++sb)
#pragma unroll
                  for (int tb = 0; tb < 2; ++tb) at[sb][tb] = __builtin_amdgcn_mfma_f32_16x16x32_bf16(kf[ks][sb], qf[ks][tb], at[sb][tb], 0, 0, 0); }
        bf16x8 pb[2];
#pragma unroll
        for (int tb = 0; tb < 2; ++tb) { float v[8];
#pragma unroll
            for (int sb = 0; sb < 2; ++sb)
#pragma unroll
                for (int e = 0; e < 4; ++e) v[sb * 4 + e] = (16 * sb + 4 * g + e > 16 * tb + i) ? 0.f : at[sb][tb][e];
            u32x4 w; w.x = cvtpk(v[0], v[1]); w.y = cvtpk(v[2], v[3]); w.z = cvtpk(v[4], v[5]); w.w = cvtpk(v[6], v[7]); pb[tb] = __builtin_bit_cast(bf16x8, w); }
        f32x4 ot[2];
        u32x4 qb[4][2];
        const bf16x8 vfi = tr2(buf + SC_VV + offb((unsigned)(4 * g + q), (unsigned)(2 * wave + (p >> 1))) + 8 * (p & 1), buf + SC_VV + offb((unsigned)(16 + 4 * g + q), (unsigned)(2 * wave + (p >> 1))) + 8 * (p & 1));
#pragma unroll
        for (int ks = 0; ks < 4; ++ks)
#pragma unroll
            for (int tb = 0; tb < 2; ++tb) {
                const u32x2 b0 = *(const LAS u32x2*)(buf + SC_QG + offb((unsigned)(16 * tb + i), (unsigned)(4 * ks + (g >> 1))) + 8 * (g & 1));
                const u32x2 b1 = *(const LAS u32x2*)(buf + SC_QG + offb((unsigned)(16 * tb + i), (unsigned)(4 * ks + 2 + (g >> 1))) + 8 * (g & 1));
                qb[ks][tb] = (u32x4){b0.x, b0.y, b1.x, b1.y}; }
        __builtin_amdgcn_sched_barrier(0);
#pragma unroll
        for (int tb = 0; tb < 2; ++tb) ot[tb] = __builtin_amdgcn_mfma_f32_16x16x32_bf16(vfi, pb[tb], (f32x4){0.f, 0.f, 0.f, 0.f}, 0, 0, 0);
#pragma unroll
        for (int ks = 0; ks < 4; ++ks) {
            u32x4 w; w.x = cvtpk(S[2 * ks].x, S[2 * ks].y); w.y = cvtpk(S[2 * ks].z, S[2 * ks].w); w.z = cvtpk(S[2 * ks + 1].x, S[2 * ks + 1].y); w.w = cvtpk(S[2 * ks + 1].z, S[2 * ks + 1].w);
            const bf16x8 sa = __builtin_bit_cast(bf16x8, w);
#pragma unroll
            for (int tb = 0; tb < 2; ++tb) ot[tb] = __builtin_amdgcn_mfma_f32_16x16x32_bf16(sa, __builtin_bit_cast(bf16x8, qb[ks][tb]), ot[tb], 0, 0, 0); }
        bf16x8 kdf[8]; f32x4 el[8];
        const bf16x8 vfu = tr2(buf + SC_VV + offb((unsigned)(8 * g + q), (unsigned)(2 * wave + (p >> 1))) + 8 * (p & 1), buf + SC_VV + offb((unsigned)(8 * g + 4 + q), (unsigned)(2 * wave + (p >> 1))) + 8 * (p & 1));
#pragma unroll
        for (int aa = 0; aa < 8; ++aa) { el[aa] = *(const LAS f32x4*)(buf + SC_EL + (16 * aa + 4 * g) * 4);
            kdf[aa] = tr2(buf + SC_KD + offb((unsigned)(8 * g + q), (unsigned)(2 * aa + (p >> 1))) + 8 * (p & 1), buf + SC_KD + offb((unsigned)(8 * g + 4 + q), (unsigned)(2 * aa + (p >> 1))) + 8 * (p & 1)); }
        __builtin_amdgcn_sched_barrier(0);
#pragma unroll
        for (int tb = 0; tb < 2; ++tb) { const int j = 32 * c + 16 * tb + i; const size_t m = m0 + (dir ? n - 1 - j : j);
            u32x2 w2; w2.x = cvtpk(ot[tb].x, ot[tb].y); w2.y = cvtpk(ot[tb].z, ot[tb].w); *(u32x2*)(OO + m * 1024 + h * 128 + 16 * wave + 4 * g) = w2; }
#pragma unroll
        for (int aa = 0; aa < 8; ++aa) S[aa] = __builtin_amdgcn_mfma_f32_16x16x32_bf16(kdf[aa], vfu, S[aa] * el[aa], 0, 0, 0);
        if (more) { if (par == 0) scan_stage_finish(R1, lds + SC_BUF, wave, lane, tid); else scan_stage_finish(R0, lds, wave, lane, tid); }
      }
    }
    if (!lat) { float* so = a->out + OUT_ST + ((((size_t)sq * 4 + l) * 2 + dir) * 8 + h) * 16384 + 16 * wave + i;
#pragma unroll
        for (int aa = 0; aa < 8; ++aa)
#pragma unroll
            for (int e = 0; e < 4; ++e) so[(16 * aa + 4 * g + e) * 128] = S[aa][e]; }
    __syncthreads();
}
__device__ __forceinline__ void job_oa_post(ArgP a, int l, int wave) {
    const int tidn = tid_now(wave), lane = tidn & 63;
    const int gw = blockIdx.x * 8 + wave, NGW = gridDim.x * 8;
    const bf16* OF = (const bf16*)(a->ws + WS_OF); const bf16* OB = (const bf16*)(a->ws + WS_OB); const bf16* AG = (const bf16*)(a->ws + WS_AG); bf16* O = (bf16*)(a->ws + WS_OA);
    const float* gn = a->in[17] + l * 128 + (lane & 7) * 16;
    for (int m = gw; m < MT; m += NGW) {
        const size_t o = (size_t)m * 1024 + lane * 16; f32x4 v[4]; float s = 0.f;
#pragma unroll
        for (int j = 0; j < 4; ++j) { const u32x2 fa = *(const u32x2*)(OF + o + 4 * j), fb = *(const u32x2*)(OB + o + 4 * j); v[j] = (f32x4){bf_lo(fa.x) + bf_lo(fb.x), bf_hi(fa.x) + bf_hi(fb.x), bf_lo(fa.y) + bf_lo(fb.y), bf_hi(fa.y) + bf_hi(fb.y)}; s += (v[j].x * v[j].x + v[j].y * v[j].y) + (v[j].z * v[j].z + v[j].w * v[j].w); }
        s += shx(s, 1, lane); s += shx(s, 2, lane); s += shx(s, 4, lane);
        const float rs = rsq_(s * (1.f / 128.f) + EPS);
        const u32x4 g0 = *(const u32x4*)(AG + o), g1 = *(const u32x4*)(AG + o + 8);
        const unsigned gg[8] = {g0.x, g0.y, g0.z, g0.w, g1.x, g1.y, g1.z, g1.w};
        unsigned ow[8];
#pragma unroll
        for (int j = 0; j < 4; ++j) { const f32x4 w = *(const f32x4*)(gn + 4 * j); const f32x4 r = v[j] * rs * w;
            ow[2 * j] = pk2(r.x * bf_lo(gg[2 * j]), r.y * bf_hi(gg[2 * j])); ow[2 * j + 1] = pk2(r.z * bf_lo(gg[2 * j + 1]), r.w * bf_hi(gg[2 * j + 1])); }
        *(u32x4*)(O + o) = (u32x4){ow[0], ow[1], ow[2], ow[3]}; *(u32x4*)(O + o + 8) = (u32x4){ow[4], ow[5], ow[6], ow[7]};
    }
}
constexpr int PH_PER_LAYER = 7, PH_PRE = 3, PH_TOTAL = PH_PRE + NL * PH_PER_LAYER;
__global__ void __launch_bounds__(512, 2) mega(Args args) {
    extern __shared__ __attribute__((aligned(16))) unsigned char lds_raw[];
    LAS unsigned char* lds = (LAS unsigned char*)lds_raw;
    const int tid = threadIdx.x, lane = tid & 63, wave = __builtin_amdgcn_readfirstlane(tid >> 6);
    volatile LAS unsigned* MISC = (volatile LAS unsigned*)(lds + MISC_OFF);
    for (int u = tid; u < (LDS_BYTES - LDSCTL_OFF) / 4; u += 512) ((LAS unsigned*)(lds + LDSCTL_OFF))[u] = 0u;
    __syncthreads();
    unsigned* barw = (unsigned*)(args.ws + WS_CTL) + CW_BAR;
    XcdBarrier bar; bar.bar = barw; bar.x = 0; bar.st = nullptr;
    if (args.use_bar) bar = xcd_barrier_post(barw, MISC + 8);
    const int lo = args.ph_lo, hi = args.ph_hi;
#ifndef PHMASK
#define PHMASK 0xFFFF
#endif
#define EN(j) ((PHMASK >> (j)) & 1)
#ifndef P2MASK
#define P2MASK 0xFF
#endif
#define P2EN(j) ((P2MASK >> (j)) & 1)
#ifndef DUPMASK
#define DUPMASK 0
#endif
#define REP(j) for (int rep_ = 0; rep_ < 1 + ((DUPMASK >> (j)) & 1); ++rep_)
#define IN(k) (lo <= (k) && (k) < hi)
#define SEAM(k) do { if (IN((k) + 1)) xcd_barrier(bar); } while (0)
    const int G = gridDim.x, bx = blockIdx.x;
#define LAUNDER(p) asm volatile("" : "+s"(p))

    if (EN(0) && IN(0)) { ArgP ap = (ArgP)__builtin_amdgcn_kernarg_segment_ptr(); LAUNDER(ap); REP(0) { phase_prologue(ap, lds, wave); } SEAM(0); }
    if (EN(1) && IN(1)) { ArgP ap = (ArgP)__builtin_amdgcn_kernarg_segment_ptr(); LAUNDER(ap); REP(1) { phase_modreduce(ap, wave); } SEAM(1); }
    if (EN(2) && IN(2)) { ArgP ap = (ArgP)__builtin_amdgcn_kernarg_segment_ptr(); LAUNDER(ap); REP(2) { phase_h0(ap, wave); } SEAM(2); }

    for (int l = 0; l < NL; ++l) {
        const int pb = PH_PRE + l * PH_PER_LAYER;
        if (EN(3) && IN(pb + 0)) { ArgP ap = (ArgP)__builtin_amdgcn_kernarg_segment_ptr(); LAUNDER(ap); unsigned char* ws = ap->ws; unsigned char* wl = ws + WS_W + (size_t)l * WL_STRIDE; float* outp = ap->out; REP(3) {
            pg8::Gemm g{(const bf16*)(ws + WS_H), (const bf16*)(wl + WO_IN), MT, NINP, D, D, nullptr, nullptr, nullptr, nullptr}; int bxl = bx, Gl = G; asm volatile("" : "+s"(bxl), "+s"(Gl)); pg8::StaticOrder S; S.init(MT, NINP, Gl, bxl);
            EpiWin E{ws, outp, l}; pg8::gemm_phase(lds, g, S, E, wave);
            }
            SEAM(pb + 0);
        }
        if (EN(4) && IN(pb + 1)) { ArgP ap = (ArgP)__builtin_amdgcn_kernarg_segment_ptr(); LAUNDER(ap); unsigned char* ws = ap->ws; unsigned char* wl = ws + WS_W + (size_t)l * WL_STRIDE; float* outp = ap->out; REP(4) {
            if (bx >= 64) { const int cb = bx - 64, GB = G - 64;
                if (P2EN(0)) { pg8::Gemm g{(const bf16*)(ws + WS_BQ), (const bf16*)(wl + WO_UQ), MT, 1536, 512, 512, nullptr, nullptr, nullptr, nullptr}; pg8::StaticOrder S; S.init(MT, 1536, GB, cb); EpiUq E{ws}; pg8::gemm_phase(lds, g, S, E, wave); }
                LAUNDER(ap); ws = ap->ws; wl = ws + WS_W + (size_t)l * WL_STRIDE;
                if (P2EN(1)) { pg8::Gemm g{(const bf16*)(ws + WS_BKV) + (size_t)l * MKV * 256, (const bf16*)(wl + WO_UKV), MKV, 2048, 256, 256, nullptr, nullptr, nullptr, nullptr}; pg8::StaticOrder S; S.init(MKV, 2048, GB, cb); EpiKv E{ws}; pg8::gemm_phase(lds, g, S, E, wave); }
                __syncthreads();
                LAUNDER(ap);
                if (P2EN(3)) { scan_item(ap, l, cb, lds, wave, tid_now(wave)); if (cb >= 96 && cb < 160) scan_item(ap, l, 192 + (cb - 96), lds, wave, tid_now(wave)); }
                __syncthreads();
                LAUNDER(ap);
            } else {
                if (P2EN(3)) scan_item(ap, l, 256 + bx, lds, wave, tid_now(wave));
            }
            __syncthreads();
            LAUNDER(ap);
            if (P2EN(2) && rep_ == 0) job_ckv_norm(ap, l, wave);
            }
            SEAM(pb + 1);
        }
        if (EN(5) && IN(pb + 2)) { ArgP ap = (ArgP)__builtin_amdgcn_kernarg_segment_ptr(); LAUNDER(ap); unsigned char* ws = ap->ws; unsigned char* wl = ws + WS_W + (size_t)l * WL_STRIDE; float* outp = ap->out; REP(5) {
            job_attn_c(ap, l, lds, wave, bx, 512, G);
            LAUNDER(ap);
            job_attn_b(ap, l, lds, wave);
            LAUNDER(ap);
            job_oa_post(ap, l, wave);
            }
            SEAM(pb + 2);
        }
        if (EN(6) && IN(pb + 3)) { ArgP ap = (ArgP)__builtin_amdgcn_kernarg_segment_ptr(); LAUNDER(ap); unsigned char* ws = ap->ws; unsigned char* wl = ws + WS_W + (size_t)l * WL_STRIDE; float* outp = ap->out; REP(6) {
            pg8::StaticOrder S; S.init(MT, D, G, bx);
            { pg8::Gemm g{(const bf16*)(ws + WS_OA), (const bf16*)(wl + WO_A), MT, D, 1024, 1024, (const bf16*)(ws + WS_OBB), (const bf16*)(wl + WO_B), (const bf16*)(ws + WS_OC), (const bf16*)(wl + WO_C)}; EpiBranch E{ws}; pg8::gemm_phase(lds, g, S, E, wave); }
            }
            SEAM(pb + 3);
        }
        if (EN(7) && IN(pb + 4)) { ArgP ap = (ArgP)__builtin_amdgcn_kernarg_segment_ptr(); LAUNDER(ap); unsigned char* ws = ap->ws; unsigned char* wl = ws + WS_W + (size_t)l * WL_STRIDE; float* outp = ap->out;
            pg8::Gemm g{(const bf16*)(ws + WS_MG), (const bf16*)(wl + WO_O), MT, D, D, D, nullptr, nullptr, nullptr, nullptr}; pg8::StaticOrder S; S.init(MT, D, G, bx);
            const float* x0 = (l == 0) ? ap->in[0] : outp; const float* x1 = (l == 0) ? ap->in[1] : outp + (size_t)MC * D;
            if (l == 0) { EpiResid<0, true> E{ws, outp, x0, x1, ap->in[12] + l * D, ap->in[13] + l * D, l, 1}; pg8::gemm_phase(lds, g, S, E, wave); }
            else { EpiResid<0, false> E{ws, outp, x0, x1, ap->in[12] + l * D, ap->in[13] + l * D, l, 1}; pg8::gemm_phase(lds, g, S, E, wave); }
            SEAM(pb + 4);
        }
        if (EN(9) && IN(pb + 5)) { ArgP ap = (ArgP)__builtin_amdgcn_kernarg_segment_ptr(); LAUNDER(ap); unsigned char* ws = ap->ws; unsigned char* wl = ws + WS_W + (size_t)l * WL_STRIDE; float* outp = ap->out; REP(9) {
            pg8::Gemm g{(const bf16*)(ws + WS_H), (const bf16*)(wl + WO_UP), MT, NUP, D, D, nullptr, nullptr, nullptr, nullptr}; pg8::SplitOrder S; S.init(MT, NUP, G, bx);
            EpiUp E{ws, ap->in[28] + (size_t)l * 3 * NUP, lds + HALO_OFF, l}; pg8::gemm_phase(lds, g, S, E, wave);
            }
            SEAM(pb + 5);
        }
        if (EN(11) && IN(pb + 6)) { ArgP ap = (ArgP)__builtin_amdgcn_kernarg_segment_ptr(); LAUNDER(ap); unsigned char* ws = ap->ws; unsigned char* wl = ws + WS_W + (size_t)l * WL_STRIDE; float* outp = ap->out;
            pg8::Gemm g{(const bf16*)(ws + WS_ACT), (const bf16*)(wl + WO_DN), MT, D, DFF, DFF, nullptr, nullptr, nullptr, nullptr}; pg8::StaticOrder S; S.init(MT, D, G, bx);
            { Unit u0; if (S.next(0, u0)) conv_fixup(ap, l, u0.pm, wave); }
            LAUNDER(ap); ws = ap->ws; wl = ws + WS_W + (size_t)l * WL_STRIDE; outp = ap->out;
            const int nx = (l < NL - 1) ? 1 : 0;
            EpiResid<1, false> E{ws, outp, outp, outp + (size_t)MC * D, ap->in[14] + l * D, ap->in[11] + (nx ? l + 1 : l) * D, l, nx}; pg8::gemm_phase(lds, g, S, E, wave);
            if (l < NL - 1) SEAM(pb + 6);
        }
    }
#undef IN
#undef SEAM
}

extern "C" void kernel_launch(void* const* d_in, const int* in_sizes, int n_in, void* d_out, int out_size, void* d_ws, size_t ws_size, hipStream_t stream) {
    static int grid = 0;
    if (grid == 0) {
        if (n_in != 30 || (size_t)out_size != OUT_END || ws_size < WS_END) { fprintf(stderr, "kernel_launch: unexpected sizes n_in %d out %d ws %zu\n", n_in, out_size, ws_size); grid = -1; return; }
        int dev = 0, cus = 0, per_cu = 0;
        if (hipGetDevice(&dev) != hipSuccess || hipDeviceGetAttribute(&cus, hipDeviceAttributeMultiprocessorCount, dev) != hipSuccess) { grid = -1; return; }
        if (hipFuncSetAttribute((const void*)mega, hipFuncAttributeMaxDynamicSharedMemorySize, LDS_BYTES) != hipSuccess) { fprintf(stderr, "kernel_launch: hipFuncSetAttribute failed\n"); grid = -1; return; }
        if (hipOccupancyMaxActiveBlocksPerMultiprocessor(&per_cu, (const void*)mega, 512, LDS_BYTES) != hipSuccess || per_cu < 1) fprintf(stderr, "kernel_launch: occupancy query reports %d\n", per_cu);
        (void)hipGetLastError();
        grid = cus;
    }
    if (grid < 0) return;
    (void)hipMemsetAsync((char*)d_ws + WS_CTL, 0, CTL_ZERO_BYTES, stream);
    Args a{};
    for (int i = 0; i < 30; ++i) a.in[i] = (const float*)d_in[i];
    a.out = (float*)d_out; a.ws = (unsigned char*)d_ws; a.pad = 0;
#if MK_ONE_LAUNCH
    a.ph_lo = 0; a.ph_hi = PH_TOTAL; a.use_bar = 1;
    hipLaunchKernelGGL(mega, dim3(grid), dim3(512), LDS_BYTES, stream, a);
#else
    a.use_bar = 0;
    for (int p = 0; p < PH_TOTAL; ++p) { a.ph_lo = p; a.ph_hi = p + 1; hipLaunchKernelGGL(mega, dim3(grid), dim3(512), LDS_BYTES, stream, a); }
#endif
}
```
